# Optimizing an MI355X kernel written in HIP

```python
import math
import jax
import jax.numpy as jnp
from jax import lax
import numpy as np


D_MODEL = 1024
BATCH = 16
SEQ = 2048
DEPTH = 1

CHUNK = 64
Q_BLOCK = 128
D_RNN = D_MODEL
RNN_BLOCKS = 16
RNN_BLOCK_W = D_RNN // RNN_BLOCKS
CONV_W = 4
LRU_C = 8.0
HEAD_DIM = 64
N_HEADS = D_MODEL // (2 * HEAD_DIM)
ATTN_W = N_HEADS * 2 * HEAD_DIM
D_FF = 4 * D_MODEL
ROPE_THETA = 10000.0
NORM_EPS = 1e-6
SUBLN_EPS = 1e-5
MASK_VALUE = -1e30
N_IN = 2 * D_RNN + 3 * ATTN_W + 2 * D_MODEL

kernel_name = "hybrid_rglru_diffattn_block"


def rms_norm(x, g, eps=NORM_EPS):
    x32 = x.astype(jnp.float32)
    y = x32 * lax.rsqrt(jnp.mean(x32 * x32, axis=-1, keepdims=True) + eps)
    return (y * g.astype(jnp.float32)).astype(x.dtype)


def rope(x):
    s, d = x.shape[1], x.shape[-1]
    half = d // 2
    inv_freq = ROPE_THETA ** (-jnp.arange(half, dtype=jnp.float32) * 2.0 / d)
    ang = jnp.arange(s, dtype=jnp.float32)[:, None] * inv_freq[None, :]
    cos = jnp.cos(ang)[None, :, None, :]
    sin = jnp.sin(ang)[None, :, None, :]
    x32 = x.astype(jnp.float32)
    x1, x2 = x32[..., :half], x32[..., half:]
    return jnp.concatenate([x1 * cos - x2 * sin, x2 * cos + x1 * sin], axis=-1).astype(x.dtype)


def causal_depthwise_conv(x, w, b):
    s = x.shape[1]
    xp = jnp.pad(x, ((0, 0), (CONV_W - 1, 0), (0, 0)))
    y = xp[:, 0:s] * w[0]
    for j in range(1, CONV_W):
        y = y + xp[:, j:j + s] * w[j]
    return y + b


def rg_lru(x, w_a, b_a, w_x, b_x, lam):
    bsz, s, _ = x.shape
    xb = x.reshape(bsz, s, RNN_BLOCKS, RNN_BLOCK_W)
    r = jax.nn.sigmoid((jnp.einsum('bsni,nij->bsnj', xb, w_a) + b_a).astype(jnp.float32)).reshape(bsz, s, D_RNN)
    i = jax.nn.sigmoid((jnp.einsum('bsni,nij->bsnj', xb, w_x) + b_x).astype(jnp.float32)).reshape(bsz, s, D_RNN)
    log_a = -LRU_C * r * jax.nn.softplus(-lam.astype(jnp.float32))
    a = jnp.exp(log_a)
    mult = jnp.sqrt(-jnp.expm1(2.0 * log_a))
    u = mult * i * x.astype(jnp.float32)

    def combine(left, right):
        a_l, h_l = left
        a_r, h_r = right
        return a_l * a_r, a_r * h_l + h_r

    _, h = lax.associative_scan(combine, (a, u), axis=1)
    return h.astype(x.dtype)


def diff_attention(q, k, v, lam, lam_init, subln_g):
    bsz, s = q.shape[0], q.shape[1]
    scale = HEAD_DIM ** -0.5
    chunk_id = jnp.arange(s) // CHUNK
    outs = []
    for q0 in range(0, s, Q_BLOCK):
        k_end = q0 + Q_BLOCK
        qb = q[:, q0:k_end]
        kb = k[:, :k_end]
        vb = v[:, :k_end]
        sc = jnp.einsum('bqhmd,bkhmd->bhmqk', qb, kb).astype(jnp.float32) * scale
        mask = chunk_id[None, :k_end] <= chunk_id[q0:k_end, None]
        sc = jnp.where(mask, sc, MASK_VALUE)
        p = jax.nn.softmax(sc, axis=-1)
        pd = p[:, :, 0] - lam * p[:, :, 1]
        outs.append(jnp.einsum('bhqk,bkhe->bqhe', pd.astype(v.dtype), vb))
    o = jnp.concatenate(outs, axis=1)
    o = rms_norm(o, subln_g, SUBLN_EPS) * (1.0 - lam_init)
    return o.reshape(bsz, s, ATTN_W)


def setup_inputs(seed: int = 0) -> dict:
    key = jax.random.key(seed)
    ks = jax.random.split(key, 24)

    def nrm(k, shape, fan_in):
        return jax.random.normal(k, shape, jnp.float32) * (fan_in ** -0.5)

    def gain(k, shape):
        return 1.0 + 0.01 * jax.random.normal(k, shape, jnp.float32)

    u = jax.random.uniform(ks[9], (DEPTH, D_RNN), jnp.float32, minval=0.9, maxval=0.999)
    root = u ** (1.0 / LRU_C)
    lru_lambda = jnp.log(root) - jnp.log1p(-root)
    return {
        "x": jax.random.normal(ks[0], (BATCH, SEQ, D_MODEL), jnp.float32),
        "norm1_g": gain(ks[1], (DEPTH, D_MODEL)),
        "w_in": nrm(ks[2], (DEPTH, D_MODEL, N_IN), D_MODEL),
        "conv_w": nrm(ks[3], (DEPTH, CONV_W, D_RNN), CONV_W),
        "conv_b": 0.01 * jax.random.normal(ks[4], (DEPTH, D_RNN), jnp.float32),
        "rg_a_w": nrm(ks[5], (DEPTH, RNN_BLOCKS, RNN_BLOCK_W, RNN_BLOCK_W), RNN_BLOCK_W),
        "rg_a_b": 0.01 * jax.random.normal(ks[6], (DEPTH, RNN_BLOCKS, RNN_BLOCK_W), jnp.float32),
        "rg_x_w": nrm(ks[7], (DEPTH, RNN_BLOCKS, RNN_BLOCK_W, RNN_BLOCK_W), RNN_BLOCK_W),
        "rg_x_b": 0.01 * jax.random.normal(ks[8], (DEPTH, RNN_BLOCKS, RNN_BLOCK_W), jnp.float32),
        "lru_lambda": lru_lambda,
        "lambda_q1": 0.1 * jax.random.normal(ks[10], (DEPTH, HEAD_DIM), jnp.float32),
        "lambda_k1": 0.1 * jax.random.normal(ks[11], (DEPTH, HEAD_DIM), jnp.float32),
        "lambda_q2": 0.1 * jax.random.normal(ks[12], (DEPTH, HEAD_DIM), jnp.float32),
        "lambda_k2": 0.1 * jax.random.normal(ks[13], (DEPTH, HEAD_DIM), jnp.float32),
        "subln_g": gain(ks[14], (DEPTH, 2 * HEAD_DIM)),
        "w_br_rnn": nrm(ks[15], (DEPTH, D_RNN, D_MODEL), D_RNN),
        "w_br_attn": nrm(ks[16], (DEPTH, ATTN_W, D_MODEL), ATTN_W),
        "w_out": nrm(ks[17], (DEPTH, D_MODEL, D_MODEL), D_MODEL),
        "norm2_g": gain(ks[18], (DEPTH, D_MODEL)),
        "w_mlp1": nrm(ks[19], (DEPTH, D_MODEL, D_FF), D_MODEL),
        "w_mlp2": nrm(ks[20], (DEPTH, D_FF, D_MODEL), D_FF),
        "normf_g": gain(ks[21], (D_MODEL,)),
    }


def reference(x, norm1_g, w_in, conv_w, conv_b, rg_a_w, rg_a_b, rg_x_w, rg_x_b, lru_lambda,
              lambda_q1, lambda_k1, lambda_q2, lambda_k2, subln_g, w_br_rnn, w_br_attn,
              w_out, norm2_g, w_mlp1, w_mlp2, normf_g):
    bsz, s = x.shape[0], x.shape[1]
    sizes = (D_RNN, D_RNN, ATTN_W, ATTN_W, ATTN_W, D_MODEL, D_MODEL)
    cuts = []
    acc = 0
    for w in sizes[:-1]:
        acc += w
        cuts.append(acc)
    for l in range(DEPTH):
        lam_init = 0.8 - 0.6 * math.exp(-0.3 * l)
        h = rms_norm(x, norm1_g[l])
        proj = h @ w_in[l]
        u_x, u_g, q, k, v, g_r, g_a = jnp.split(proj, cuts, axis=-1)
        xr = causal_depthwise_conv(u_x, conv_w[l], conv_b[l])
        y_rnn = rg_lru(xr, rg_a_w[l], rg_a_b[l], rg_x_w[l], rg_x_b[l], lru_lambda[l]) * jax.nn.gelu(u_g)
        q = rope(q.reshape(bsz, s, 2 * N_HEADS, HEAD_DIM)).reshape(bsz, s, N_HEADS, 2, HEAD_DIM)
        k = rope(k.reshape(bsz, s, 2 * N_HEADS, HEAD_DIM)).reshape(bsz, s, N_HEADS, 2, HEAD_DIM)
        v = v.reshape(bsz, s, N_HEADS, 2 * HEAD_DIM)
        f32 = jnp.float32
        lam = (jnp.exp(jnp.sum(lambda_q1[l].astype(f32) * lambda_k1[l].astype(f32)))
               - jnp.exp(jnp.sum(lambda_q2[l].astype(f32) * lambda_k2[l].astype(f32)))
               + lam_init)
        y_attn = diff_attention(q, k, v, lam, lam_init, subln_g[l])
        merged = (jax.nn.sigmoid(g_r) * (y_rnn @ w_br_rnn[l])
                  + jax.nn.sigmoid(g_a) * (y_attn @ w_br_attn[l]))
        x = x + merged @ w_out[l]
        h2 = rms_norm(x, norm2_g[l])
        x = x + jnp.square(jax.nn.relu(h2 @ w_mlp1[l])) @ w_mlp2[l]
    return rms_norm(x, normf_g)
```

```cpp
#include <hip/hip_runtime.h>
#include <hip/hip_cooperative_groups.h>
#include <cstdio>
#include <cstdint>
namespace cg = cooperative_groups;

#ifndef MK_N_LAUNCHES
#define MK_N_LAUNCHES 0
#endif
#ifndef USE_PG8
#define USE_PG8 1
#endif

namespace pg8 {
#define PG8_LAS __attribute__((address_space(3)))
typedef unsigned short bf16_t;
typedef short bf16x8 __attribute__((ext_vector_type(8)));
typedef float f32x4 __attribute__((ext_vector_type(4)));
typedef unsigned u32x4 __attribute__((ext_vector_type(4)));
constexpr int BM = 256, BK = 64, HALF = 128, HTB = HALF * BK * 2  , STAGE_BYTES = 8 * HTB, NXCD = 8, WGM = 8;

__host__ __device__ __forceinline__ int lds_byte(int r, int c) { const int st = (r >> 4) * 2 + (c >> 5), rr = r & 15, cc = c & 31, ob = rr * 64 + cc * 2; return st * 1024 + (ob ^ (((ob >> 9) & 1) << 5)); }
__host__ __device__ __forceinline__ void stage_rc(int b, int& R, int& C) { const int st = b / 1024, sb = b % 1024, swz = sb ^ (((sb >> 9) & 1) << 5); R = (st >> 1) * 16 + swz / 64; C = (st & 1) * 32 + (swz % 64) / 2; }
__host__ __device__ __forceinline__ int perm32(int rho) { const int n = rho >> 4, i = rho & 15; return 8 * (i >> 2) + 4 * n + (i & 3); }

struct Unit { int pm, pn; };
struct Gemm { const bf16_t* A; const bf16_t* Bt; int M, N, K; };

struct StaticOrder {
    int nM, nN, nwg, G, c;
    __host__ __device__ __forceinline__ void init(int M, int N, int G_, int c_) { nM = M / BM; nN = N / BM; nwg = nM * nN; G = G_; c = c_; }
    __host__ __device__ __forceinline__ bool next(int i, Unit& u) const {
        const long L = (long)i * G + c; if (L >= nwg) return false;
        int wgid = (int)L; { const int q = nwg / NXCD, r = nwg % NXCD, xcd = wgid % NXCD, off = wgid / NXCD; wgid = (xcd < r ? xcd * (q + 1) : r * (q + 1) + (xcd - r) * q) + off; }
        const int nig = WGM * nN, gid = wgid / nig, fm = gid * WGM, gsz = (nM - fm) < WGM ? (nM - fm) : WGM;
        u.pm = fm + ((wgid % nig) % gsz); u.pn = (wgid % nig) / gsz; return true;
    }
    __device__ __forceinline__ void a_ready(const Unit&) const {}
    __device__ __forceinline__ void done(const Unit&) const {}
};
template <class Epi, class Sched, bool ALIGN_EPI = false, bool SP2 = false>
__device__ __forceinline__ void gemm_phase(PG8_LAS unsigned char* lds, const Gemm g, const Sched& S, const Epi& E) {
    const int tid = threadIdx.x, wid = __builtin_amdgcn_readfirstlane(tid >> 6), lane = tid & 63, wr = wid >> 2, wc = wid & 3, fr = lane & 15, fq = lane >> 4;
    const int K = g.K, nt = K / BK;
    unsigned voffA[2], voffB[2];
#pragma unroll
    for (int i = 0; i < 2; ++i) { int R, C; stage_rc(tid * 16 + i * 8192, R, C); const int Rb = Epi::PERM ? ((R & ~31) + perm32(R & 31)) : R;
        voffA[i] = (unsigned)(R * K + C) * 2u; voffB[i] = (unsigned)(Rb * K + C) * 2u; }
    const size_t kstep = (size_t)(BK * 2);
    const size_t hstep = (size_t)HALF * K * 2;
    const size_t tstep = 2 * hstep;
    const unsigned ldsw = (unsigned)wid * 1024u;
    const int aoff = lds_byte(wr * 64 + fr, fq * 8), boff = lds_byte(wc * 32 + fr, fq * 8);
#define PG8_SA(b, h) (((b) * 2 + (h)) * HTB)
#define PG8_SB(b, h) ((4 + (b) * 2 + (h)) * HTB)
#define PG8_STAGE(bufoff, gbase, voff) do { _Pragma("unroll") for (int _i = 0; _i < 2; ++_i) \
        __builtin_amdgcn_global_load_lds((const unsigned*)((const char*)(gbase) + (voff)[_i]), (PG8_LAS unsigned*)(lds + (bufoff) + ldsw + _i * 8192), 16, 0, 0); } while (0)
#define PG8_LDA(dst, b, h) do { _Pragma("unroll") for (int m = 0; m < 4; ++m) _Pragma("unroll") for (int k = 0; k < 2; ++k) dst[m][k] = *(const PG8_LAS bf16x8*)(lds + PG8_SA(b, h) + aoff + m * 2048 + k * 1024); } while (0)
#define PG8_LDB(dst, b, h) do { _Pragma("unroll") for (int n = 0; n < 2; ++n) _Pragma("unroll") for (int k = 0; k < 2; ++k) dst[n][k] = *(const PG8_LAS bf16x8*)(lds + PG8_SB(b, h) + boff + n * 2048 + k * 1024); } while (0)
#define PG8_MMA(ai, bj, At, Bt) do { __builtin_amdgcn_s_setprio(1); _Pragma("unroll") for (int m = 0; m < 4; ++m) _Pragma("unroll") for (int n = 0; n < 2; ++n) _Pragma("unroll") for (int k = 0; k < 2; ++k) \
        acc[ai][bj][m][n] = __builtin_amdgcn_mfma_f32_16x16x32_bf16(Bt[n][k], At[m][k], acc[ai][bj][m][n], 0, 0, 0); __builtin_amdgcn_s_setprio(0); } while (0)
#define PG8_WAIT_V(n) asm volatile("s_waitcnt vmcnt(" #n ")" ::: "memory")
#define PG8_WAIT_L(n) asm volatile("s_waitcnt lgkmcnt(" #n ")" ::: "memory")
#define PG8_BAR __builtin_amdgcn_s_barrier()
#define PG8_SCHED __builtin_amdgcn_sched_barrier(0)
    Unit cur, nxt; int ui = 0;
    if (!S.next(0, cur)) return;
    f32x4 acc[2][2][4][2];
#pragma unroll
    for (int a = 0; a < 2; ++a)
#pragma unroll
        for (int b = 0; b < 2; ++b)
#pragma unroll
            for (int m = 0; m < 4; ++m)
#pragma unroll
                for (int n = 0; n < 2; ++n) acc[a][b][m][n] = (f32x4){0.f, 0.f, 0.f, 0.f};
    bf16x8 At[4][2], B0[2][2], B1[2][2];
    const char* cA = (const char*)g.A + (size_t)cur.pm * tstep; const char* cB = (const char*)g.Bt + (size_t)cur.pn * tstep;
    S.a_ready(cur);
    if constexpr (SP2) {
        PG8_STAGE(PG8_SB(0, 0), cB, voffB); PG8_STAGE(PG8_SB(0, 1), cB + hstep, voffB); PG8_STAGE(PG8_SA(0, 0), cA, voffA); PG8_STAGE(PG8_SA(0, 1), cA + hstep, voffA);
        if (wr == 1) PG8_BAR;
        PG8_WAIT_V(2); PG8_BAR;
        PG8_STAGE(PG8_SB(1, 0), cB + kstep, voffB); PG8_STAGE(PG8_SA(1, 0), cA + kstep, voffA); PG8_STAGE(PG8_SB(1, 1), cB + hstep + kstep, voffB);
        PG8_WAIT_V(6); PG8_BAR;
    } else {
        PG8_STAGE(PG8_SB(0, 0), cB, voffB); PG8_STAGE(PG8_SA(0, 0), cA, voffA); PG8_STAGE(PG8_SB(0, 1), cB + hstep, voffB); PG8_STAGE(PG8_SA(0, 1), cA + hstep, voffA);
        if (wr == 1) PG8_BAR;
        PG8_WAIT_V(4); PG8_BAR;
        PG8_STAGE(PG8_SB(1, 0), cB + kstep, voffB); PG8_STAGE(PG8_SA(1, 0), cA + kstep, voffA); PG8_STAGE(PG8_SB(1, 1), cB + hstep + kstep, voffB);
        PG8_WAIT_V(6); PG8_BAR;
    }
    for (;;) {
        const bool has_next = S.next(ui + 1, nxt);
        const char* nA = has_next ? (const char*)g.A + (size_t)nxt.pm * tstep : cA; const char* nB = has_next ? (const char*)g.Bt + (size_t)nxt.pn * tstep : cB;
        for (int t = 0; t < nt; t += 2) {
            const bool last = (t == nt - 2);
            const char* a1 = cA + (size_t)(t + 1) * kstep;
            const char* a2 = last ? nA : cA + (size_t)(t + 2) * kstep; const char* b2 = last ? nB : cB + (size_t)(t + 2) * kstep;
            const char* a3 = a2 + kstep; const char* b3 = b2 + kstep;
            if (last && has_next) S.a_ready(nxt);
            if constexpr (SP2) {
            PG8_LDB(B0, 0, 0); PG8_LDB(B1, 0, 1); PG8_SCHED; PG8_LDA(At, 0, 0); PG8_STAGE(PG8_SA(1, 1), a1 + hstep, voffA);
            PG8_WAIT_V(8); PG8_WAIT_L(0); PG8_BAR; PG8_MMA(0, 0, At, B0); PG8_MMA(0, 1, At, B1); PG8_BAR; PG8_SCHED;
            PG8_LDA(At, 0, 1); PG8_STAGE(PG8_SB(0, 0), b2, voffB); PG8_STAGE(PG8_SB(0, 1), b2 + hstep, voffB); PG8_STAGE(PG8_SA(0, 0), a2, voffA);
            PG8_WAIT_V(8); PG8_WAIT_L(0); PG8_BAR; PG8_MMA(1, 0, At, B0); PG8_MMA(1, 1, At, B1); PG8_BAR; PG8_SCHED;
            PG8_LDB(B0, 1, 0); PG8_LDB(B1, 1, 1); PG8_SCHED; PG8_LDA(At, 1, 0); PG8_STAGE(PG8_SA(0, 1), a2 + hstep, voffA);
            PG8_WAIT_V(8); PG8_WAIT_L(0); PG8_BAR; PG8_MMA(0, 0, At, B0); PG8_MMA(0, 1, At, B1); PG8_BAR; PG8_SCHED;
            PG8_LDA(At, 1, 1); PG8_STAGE(PG8_SB(1, 0), b3, voffB); PG8_STAGE(PG8_SB(1, 1), b3 + hstep, voffB); PG8_STAGE(PG8_SA(1, 0), a3, voffA);
            PG8_WAIT_V(8); PG8_WAIT_L(0); PG8_BAR; PG8_MMA(1, 0, At, B0); PG8_MMA(1, 1, At, B1); PG8_BAR; PG8_SCHED;
            } else {
            PG8_LDB(B0, 0, 0); PG8_SCHED; PG8_LDA(At, 0, 0); PG8_STAGE(PG8_SA(1, 1), a1 + hstep, voffA);
            PG8_WAIT_L(8); PG8_BAR; PG8_WAIT_L(0); PG8_MMA(0, 0, At, B0); PG8_BAR; PG8_SCHED;
            PG8_LDB(B1, 0, 1); PG8_STAGE(PG8_SB(0, 0), b2, voffB);
            PG8_BAR; PG8_WAIT_L(0); PG8_MMA(0, 1, At, B1); PG8_BAR;
            PG8_LDA(At, 0, 1); PG8_STAGE(PG8_SA(0, 0), a2, voffA);
            PG8_BAR; PG8_WAIT_L(0); PG8_MMA(1, 0, At, B0); PG8_BAR; PG8_SCHED;
            PG8_STAGE(PG8_SB(0, 1), b2 + hstep, voffB);
            PG8_WAIT_V(6); PG8_BAR; PG8_MMA(1, 1, At, B1); PG8_BAR;
            PG8_LDB(B0, 1, 0); PG8_SCHED; PG8_LDA(At, 1, 0); PG8_STAGE(PG8_SA(0, 1), a2 + hstep, voffA);
            PG8_WAIT_L(8); PG8_BAR; PG8_WAIT_L(0); PG8_MMA(0, 0, At, B0); PG8_BAR; PG8_SCHED;
            PG8_LDB(B1, 1, 1); PG8_STAGE(PG8_SB(1, 0), b3, voffB);
            PG8_BAR; PG8_WAIT_L(0); PG8_MMA(0, 1, At, B1); PG8_BAR;
            PG8_LDA(At, 1, 1); PG8_STAGE(PG8_SA(1, 0), a3, voffA);
            PG8_BAR; PG8_WAIT_L(0); PG8_MMA(1, 0, At, B0); PG8_BAR; PG8_SCHED;
            PG8_STAGE(PG8_SB(1, 1), b3 + hstep, voffB);
            PG8_WAIT_V(6); PG8_BAR; PG8_MMA(1, 1, At, B1); PG8_BAR;
            }
        }
        if constexpr (ALIGN_EPI) { if (wr == 0) PG8_BAR; }
        if constexpr (!Epi::AFTER_DRAIN) { E(acc, cur, wr, wc, fr, fq); S.done(cur); }
        if (!has_next) break;
#pragma unroll
        for (int a = 0; a < 2; ++a)
#pragma unroll
            for (int b = 0; b < 2; ++b)
#pragma unroll
                for (int m = 0; m < 4; ++m)
#pragma unroll
                    for (int n = 0; n < 2; ++n) acc[a][b][m][n] = (f32x4){0.f, 0.f, 0.f, 0.f};
        cur = nxt; cA = nA; cB = nB; ++ui;
        if constexpr (ALIGN_EPI) { if (wr == 1) PG8_BAR; }
    }
    PG8_WAIT_V(0);
    if constexpr (!ALIGN_EPI) { if (wr == 0) PG8_BAR; }
    PG8_BAR;
    if constexpr (Epi::AFTER_DRAIN) { E.fused(acc, cur, wr, wc, fr, fq, lds, wid, lane); S.done(cur); }
#undef PG8_SA
#undef PG8_SB
#undef PG8_STAGE
#undef PG8_LDA
#undef PG8_LDB
#undef PG8_MMA
#undef PG8_WAIT_V
#undef PG8_WAIT_L
#undef PG8_BAR
#undef PG8_SCHED
}
}

constexpr int BATCH = 16, SEQ = 2048, D = 1024, M = BATCH * SEQ, NIN = 7168, DFF = 4096;
constexpr int NWAVES = 8, NTHREADS = 512;
constexpr float NORM_EPS = 1e-6f, SUBLN_EPS = 1e-5f;
constexpr float LOG2E = 1.4426950408889634f;
constexpr float QSCALE = 0.18033688011112042f;
constexpr float LAM_INIT = 0.2f;
constexpr float OUT_SCALE = 1.0f - LAM_INIT;

#define LAS __attribute__((address_space(3)))
typedef unsigned short bf16_t;
typedef short bf16x8 __attribute__((ext_vector_type(8)));
typedef float f32x4 __attribute__((ext_vector_type(4)));
typedef float f32x16 __attribute__((ext_vector_type(16)));
typedef unsigned u32x4 __attribute__((ext_vector_type(4)));
typedef unsigned u32x2 __attribute__((ext_vector_type(2)));

constexpr size_t MiB = 1u << 20;
constexpr size_t WS_CTL = 0, CTL_ZERO_BYTES = 1 * MiB;
constexpr size_t WS_SS1 = 512 * 1024;
constexpr size_t WS_ROPE = 1 * MiB;
constexpr size_t WS_WIN = 2 * MiB, WS_WBR = 16 * MiB, WS_WBA = 18 * MiB, WS_WOUT = 20 * MiB, WS_W1 = 22 * MiB, WS_W2 = 30 * MiB;
constexpr size_t WS_B0 = 48 * MiB, WS_B1 = 112 * MiB, WS_B2 = 176 * MiB, WS_B3 = 240 * MiB, WS_B4 = 304 * MiB, WS_B5 = 368 * MiB, WS_END = 432 * MiB;

struct Args { const float* in[22]; float* out; unsigned char* ws; int ph_lo, ph_hi; };

struct Bufs {
    const float* x; float* out;
    bf16_t *Win, *Wbr, *Wba, *Wout, *W1, *W2;
    bf16_t *H, *UX, *GG, *Q, *K, *V, *SR, *SA, *MG, *X1B, *HID;
    float *T, *ss1, *ropec, *ropes;
};
__device__ __forceinline__ Bufs make_bufs(const Args& a) {
    Bufs b; unsigned char* ws = a.ws;
    b.x = a.in[0]; b.out = a.out;
    b.Win = (bf16_t*)(ws + WS_WIN); b.Wbr = (bf16_t*)(ws + WS_WBR); b.Wba = (bf16_t*)(ws + WS_WBA); b.Wout = (bf16_t*)(ws + WS_WOUT); b.W1 = (bf16_t*)(ws + WS_W1); b.W2 = (bf16_t*)(ws + WS_W2);
    b.H = (bf16_t*)(ws + WS_B0); b.UX = (bf16_t*)(ws + WS_B1); b.GG = (bf16_t*)(ws + WS_B2); b.Q = (bf16_t*)(ws + WS_B3); b.K = (bf16_t*)(ws + WS_B4); b.V = (bf16_t*)(ws + WS_B5);
    b.SR = (bf16_t*)a.out; b.SA = (bf16_t*)a.out + (size_t)M * D;
    b.MG = (bf16_t*)(ws + WS_B0); b.X1B = (bf16_t*)(ws + WS_B1); b.HID = (bf16_t*)(ws + WS_B2);
    b.T = (float*)(ws + WS_B4); b.ss1 = (float*)(ws + WS_SS1); b.ropec = (float*)(ws + WS_ROPE); b.ropes = b.ropec + 2048 * 32;
    return b;
}

__device__ __forceinline__ unsigned f2bf(float f) { unsigned u = __builtin_bit_cast(unsigned, f); return (u + 0x7fffu + ((u >> 16) & 1u)) >> 16; }
__device__ __forceinline__ unsigned pk2(float lo, float hi) { return f2bf(lo) | (f2bf(hi) << 16); }
__device__ __forceinline__ float bf2f(unsigned b) { return __builtin_bit_cast(float, b << 16); }
__device__ __forceinline__ float fexp2(float x) { return __builtin_amdgcn_exp2f(x); }
__device__ __forceinline__ float sigmoid_f(float v) { return 1.0f / (1.0f + fexp2(-v * LOG2E)); }
__device__ __forceinline__ float gelu_tanh_f(float v) { const float y = 0.7978845608028654f * (v + 0.044715f * v * v * v); return v / (1.0f + fexp2(-2.0f * LOG2E * y)); }
__device__ __forceinline__ float wave_sum(float v) {
#pragma unroll
    for (int o = 1; o < 64; o <<= 1) v += __shfl_xor(v, o);
    return v;
}
__device__ __forceinline__ float wave_max(float v) {
#pragma unroll
    for (int o = 1; o < 64; o <<= 1) v = fmaxf(v, __shfl_xor(v, o));
    return v;
}
#define LDS_WAIT() asm volatile("s_waitcnt lgkmcnt(0)" ::: "memory")

__device__ __forceinline__ void transpose_item(const float* W, int K, int N, bf16_t* WT, int item, LAS float* scr, int lane, bool permqk, const float* kscale) {
    const int nblk = N / 32, kb = item / nblk, nb = item % nblk, k0 = 64 * kb, n0 = 32 * nb;
    int s0 = n0;
    if (permqk && n0 >= 2048 && n0 < 4096) { const int l = n0 & 255, bj = l >> 7, wc = (l >> 5) & 3; s0 = (n0 & ~255) + 64 * wc + 32 * bj; }
#pragma unroll 8
    for (int i = 0; i < 32; ++i) { const int kk = 2 * i + (lane >> 5); float v = W[(size_t)(k0 + kk) * N + s0 + (lane & 31)]; if (kscale) v *= kscale[k0 + kk]; scr[kk * 33 + (lane & 31)] = v; }
    LDS_WAIT();
    const int c = lane & 7;
#pragma unroll
    for (int j = 0; j < 4; ++j) { const int n = (lane >> 3) + 8 * j; const LAS float* s = scr + (8 * c) * 33 + n;
        u32x4 o; o.x = pk2(s[0 * 33], s[1 * 33]); o.y = pk2(s[2 * 33], s[3 * 33]); o.z = pk2(s[4 * 33], s[5 * 33]); o.w = pk2(s[6 * 33], s[7 * 33]);
        *(u32x4*)(WT + (size_t)(n0 + n) * K + k0 + 8 * c) = o; }
    LDS_WAIT();
}
__constant__ double ROPE_INVF[32] = {1.0, 0.7498942093324559, 0.5623413251903491, 0.4216965034285822, 0.31622776601683794, 0.23713737056616552, 0.1778279410038923, 0.1333521432163324, 0.1, 0.07498942093324558,
    0.05623413251903491, 0.042169650342858224, 0.03162277660168379, 0.023713737056616554, 0.01778279410038923, 0.01333521432163324, 0.01, 0.007498942093324558, 0.005623413251903491, 0.004216965034285823,
    0.0031622776601683794, 0.0023713737056616554, 0.0017782794100389228, 0.001333521432163324, 0.001, 0.0007498942093324559, 0.0005623413251903491, 0.00042169650342858224, 0.00031622776601683794,
    0.00023713737056616554, 0.00017782794100389227, 0.0001333521432163324};
__device__ __forceinline__ void sincos_f64(double a, double& s, double& c) {
    const double k = __builtin_rint(a * 6.36619772367581382433e-01);
    double r = a - k * 1.57079632673412561417e+00; r = r - k * 6.07710050650619224932e-11;
    const double z = r * r;
    const double ps = r + r * z * (-1.66666666666666324348e-01 + z * (8.33333333332248946124e-03 + z * (-1.98412698298579493134e-04 + z * (2.75573137070700676789e-06 + z * (-2.50507602534068634195e-08 + z * 1.58969099521155010221e-10)))));
    const double pc = 1.0 - 0.5 * z + z * z * (4.16666666666666019037e-02 + z * (-1.38888888888741095749e-03 + z * (2.48015872894767294178e-05 + z * (-2.75573143513906633035e-07 + z * (2.08757232129817482790e-09 + z * -1.13596475577881948265e-11)))));
    const int q = (int)k & 3;
    s = (q == 0) ? ps : (q == 1) ? pc : (q == 2) ? -ps : -pc;
    c = (q == 0) ? pc : (q == 1) ? -ps : (q == 2) ? -pc : ps;
}
__device__ __forceinline__ void phase_prep(const Args& a, const Bufs& B, LAS unsigned char* lds) {
    const int tid = threadIdx.x, lane = tid & 63, wave = __builtin_amdgcn_readfirstlane(tid >> 6);
    LAS float* scr = (LAS float*)(lds + wave * 16384);
    const int gw = blockIdx.x * NWAVES + wave, NGW = gridDim.x * NWAVES;
    constexpr int I_IN = (D / 64) * (NIN / 32), I_SQ = (D / 64) * (D / 32), I_1 = (D / 64) * (DFF / 32), I_2 = (DFF / 64) * (D / 32);
    constexpr int NITEMS = I_IN + 3 * I_SQ + I_1 + I_2;
    for (int it = gw; it < NITEMS; it += NGW) {
        int r = it;
        if (r < I_IN) { transpose_item(a.in[2], D, NIN, B.Win, r, scr, lane, true, nullptr); continue; } r -= I_IN;
        if (r < I_SQ) { transpose_item(a.in[15], D, D, B.Wbr, r, scr, lane, false, nullptr); continue; } r -= I_SQ;
        if (r < I_SQ) { transpose_item(a.in[16], D, D, B.Wba, r, scr, lane, false, nullptr); continue; } r -= I_SQ;
        if (r < I_SQ) { transpose_item(a.in[17], D, D, B.Wout, r, scr, lane, false, nullptr); continue; } r -= I_SQ;
        if (r < I_1) { transpose_item(a.in[19], D, DFF, B.W1, r, scr, lane, false, a.in[18]); continue; } r -= I_1;
        transpose_item(a.in[20], DFF, D, B.W2, r, scr, lane, false, nullptr);
    }
    const f32x4* g4 = (const f32x4*)a.in[1];
    for (int m = gw; m < M; m += NGW) {
        const f32x4* xr = (const f32x4*)(B.x + (size_t)m * D) + lane;
        f32x4 v[4]; float s = 0.f;
#pragma unroll
        for (int j = 0; j < 4; ++j) { v[j] = xr[64 * j]; s += (v[j].x * v[j].x + v[j].y * v[j].y) + (v[j].z * v[j].z + v[j].w * v[j].w); }
        const float rs = 1.0f / sqrtf(wave_sum(s) * (1.0f / D) + NORM_EPS);
        u32x2* o = (u32x2*)(B.H + (size_t)m * D) + lane;
#pragma unroll
        for (int j = 0; j < 4; ++j) { const f32x4 g = g4[lane + 64 * j]; u32x2 w; w.x = pk2(v[j].x * rs * g.x, v[j].y * rs * g.y); w.y = pk2(v[j].z * rs * g.z, v[j].w * rs * g.w); o[64 * j] = w; }
    }
    for (int idx = blockIdx.x * NTHREADS + tid; idx < 2048 * 32; idx += gridDim.x * NTHREADS) {
        const int pos = idx >> 5, j = idx & 31; double s, c; sincos_f64((double)pos * ROPE_INVF[j], s, c);
        B.ropec[idx] = (float)c; B.ropes[idx] = (float)s;
    }
}

__device__ __forceinline__ int qk_logical(int c) { return (c & ~255) + 64 * ((c >> 5) & 3) + 32 * ((c >> 7) & 1) + (c & 31); }
struct FInProj {
    Bufs B;
    __device__ __forceinline__ void elem(int row, int col, float v) const {
        const int seg = col >> 10, cc = col & 1023; const size_t o = (size_t)row * D;
        if (seg == 0) B.UX[o + cc] = (bf16_t)f2bf(v);
        else if (seg == 1) B.GG[o + cc] = (bf16_t)f2bf(gelu_tanh_f(v));
        else if (seg == 2) B.Q[o + qk_logical(cc)] = (bf16_t)f2bf(v);
        else if (seg == 3) B.K[o + qk_logical(cc)] = (bf16_t)f2bf(v);
        else if (seg == 4) B.V[o + cc] = (bf16_t)f2bf(v);
        else if (seg == 5) B.SR[o + cc] = (bf16_t)f2bf(sigmoid_f(v));
        else B.SA[o + cc] = (bf16_t)f2bf(sigmoid_f(v));
    }
};
struct FBrA { Bufs B; __device__ __forceinline__ void elem(int row, int col, float v) const { const size_t o = (size_t)row * D + col; B.T[o] = bf2f(B.SR[o]) * v; } };
struct FBrB { Bufs B; __device__ __forceinline__ void elem(int row, int col, float v) const { const size_t o = (size_t)row * D + col; B.MG[o] = (bf16_t)f2bf(B.T[o] + bf2f(B.SA[o]) * v); } };
struct FOut { Bufs B; __device__ __forceinline__ void elem(int row, int col, float v) const { const size_t o = (size_t)row * D + col; const float x1 = B.x[o] + v; B.out[o] = x1; B.X1B[o] = (bf16_t)f2bf(x1); } };
struct FMlp1 { Bufs B; __device__ __forceinline__ void elem(int row, int col, float v) const { const float rs = 1.0f / sqrtf(B.ss1[row] * (1.0f / D) + NORM_EPS); const float t = fmaxf(v * rs, 0.f); B.HID[(size_t)row * DFF + col] = (bf16_t)f2bf(t * t); } };
struct FMlp2 { Bufs B; __device__ __forceinline__ void elem(int row, int col, float v) const { const size_t o = (size_t)row * D + col; B.out[o] = B.out[o] + v; } };

template <class F> struct EpiElem {
    static constexpr bool PERM = false, AFTER_DRAIN = false; F f;
    __device__ __forceinline__ void operator()(const pg8::f32x4 (&acc)[2][2][4][2], const pg8::Unit& u, int wr, int wc, int fr, int fq) const {
#pragma unroll
        for (int ai = 0; ai < 2; ++ai)
#pragma unroll
            for (int m = 0; m < 4; ++m) { const int row = u.pm * 256 + ai * 128 + wr * 64 + m * 16 + fr;
#pragma unroll
                for (int bj = 0; bj < 2; ++bj)
#pragma unroll
                    for (int n = 0; n < 2; ++n) { const int col = u.pn * 256 + bj * 128 + wc * 32 + n * 16 + fq * 4;
#pragma unroll
                        for (int e = 0; e < 4; ++e) f.elem(row, col + e, acc[ai][bj][m][n][e]); } }
    }
};

template <class F> __device__ __forceinline__ void gemm_naive(const bf16_t* A, const bf16_t* Bt, int Mr, int N, int K, const F& f) {
    const int tid = threadIdx.x, lane = tid & 63, wid = tid >> 6, r32 = lane & 31, hi = lane >> 5, wm = wid >> 1, wn = wid & 1;
    const int nTn = N / 128, nUnits = (Mr / 256) * nTn;
    for (int u = blockIdx.x; u < nUnits; u += gridDim.x) {
        const int row0 = (u / nTn) * 256 + wm * 64, col0 = (u % nTn) * 128 + wn * 64;
        f32x16 acc[2][2];
#pragma unroll
        for (int i = 0; i < 2; ++i)
#pragma unroll
            for (int j = 0; j < 2; ++j)
#pragma unroll
                for (int r = 0; r < 16; ++r) acc[i][j][r] = 0.f;
        const bf16_t* ap = A + (size_t)(row0 + r32) * K + 8 * hi; const bf16_t* bp = Bt + (size_t)(col0 + r32) * K + 8 * hi;
        for (int k0 = 0; k0 < K; k0 += 16) {
            bf16x8 av[2], bv[2];
#pragma unroll
            for (int i = 0; i < 2; ++i) { av[i] = *(const bf16x8*)(ap + (size_t)(32 * i) * K + k0); bv[i] = *(const bf16x8*)(bp + (size_t)(32 * i) * K + k0); }
#pragma unroll
            for (int i = 0; i < 2; ++i)
#pragma unroll
                for (int j = 0; j < 2; ++j) acc[i][j] = __builtin_amdgcn_mfma_f32_32x32x16_bf16(av[i], bv[j], acc[i][j], 0, 0, 0);
        }
#pragma unroll
        for (int i = 0; i < 2; ++i)
#pragma unroll
            for (int j = 0; j < 2; ++j)
#pragma unroll
                for (int r = 0; r < 16; ++r) f.elem(row0 + 32 * i + (r & 3) + 8 * (r >> 2) + 4 * hi, col0 + 32 * j + r32, acc[i][j][r]);
    }
}
template <class F> __device__ __forceinline__ void gemm_any(LAS unsigned char* lds, const bf16_t* A, const bf16_t* Bt, int Mr, int N, int K, const F& f) {
#if USE_PG8
    pg8::Gemm g{A, Bt, Mr, N, K}; pg8::StaticOrder S; S.init(Mr, N, (int)gridDim.x, (int)blockIdx.x);
    EpiElem<F> E{f};
    pg8::gemm_phase<EpiElem<F>, pg8::StaticOrder, false, true>(lds, g, S, E);
#else
    gemm_naive(A, Bt, Mr, N, K, f);
#endif
}

__device__ __forceinline__ void phase_rope(const Bufs& B) {
    const size_t total = (size_t)M * 16 * 32;
    for (size_t idx = (size_t)blockIdx.x * NTHREADS + threadIdx.x; idx < total; idx += (size_t)gridDim.x * NTHREADS) {
        const int j = (int)(idx & 31), sh = (int)((idx >> 5) & 15), row = (int)(idx >> 9), pos = row & (SEQ - 1);
        const float c = B.ropec[pos * 32 + j], s = B.ropes[pos * 32 + j];
        const size_t o = (size_t)row * D + sh * 64 + j;
        { const float x1 = bf2f(B.Q[o]), x2 = bf2f(B.Q[o + 32]); B.Q[o] = (bf16_t)f2bf((x1 * c - x2 * s) * QSCALE); B.Q[o + 32] = (bf16_t)f2bf((x2 * c + x1 * s) * QSCALE); }
        { const float x1 = bf2f(B.K[o]), x2 = bf2f(B.K[o + 32]); B.K[o] = (bf16_t)f2bf(x1 * c - x2 * s); B.K[o + 32] = (bf16_t)f2bf(x2 * c + x1 * s); }
    }
}

__device__ __forceinline__ void phase_rnn_naive(const Args& a, const Bufs& B) {
    const int lane = threadIdx.x & 63, wave = __builtin_amdgcn_readfirstlane(threadIdx.x >> 6);
    for (int it = wave * gridDim.x + blockIdx.x; it < BATCH * 16; it += gridDim.x * NWAVES) {
        const int b = it >> 4, blk = it & 15, c = blk * 64 + lane;
        float wa[64], wx[64];
#pragma unroll
        for (int i = 0; i < 64; ++i) { wa[i] = a.in[5][(blk * 64 + i) * 64 + lane]; wx[i] = a.in[7][(blk * 64 + i) * 64 + lane]; }
        const float ba = a.in[6][c], bx = a.in[8][c], cw0 = a.in[3][c], cw1 = a.in[3][D + c], cw2 = a.in[3][2 * D + c], cw3 = a.in[3][3 * D + c], cb = a.in[4][c];
        const float c8sp = 8.0f * log1pf(expf(-a.in[9][c]));
        float h = 0.f, xm1 = 0.f, xm2 = 0.f, xm3 = 0.f;
        const size_t base = (size_t)b * SEQ * D + c;
        for (int t0 = 0; t0 < SEQ; t0 += 16) {
            float ux[16], gg[16];
#pragma unroll
            for (int tt = 0; tt < 16; ++tt) { ux[tt] = bf2f(B.UX[base + (size_t)(t0 + tt) * D]); gg[tt] = bf2f(B.GG[base + (size_t)(t0 + tt) * D]); }
#pragma unroll
            for (int tt = 0; tt < 16; ++tt) {
                const float xr = cw0 * xm3 + cw1 * xm2 + cw2 * xm1 + cw3 * ux[tt] + cb;
                xm3 = xm2; xm2 = xm1; xm1 = ux[tt];
                float pa = ba, px = bx;
#pragma unroll
                for (int i = 0; i < 64; ++i) { const float xi = __builtin_bit_cast(float, __builtin_amdgcn_readlane(__builtin_bit_cast(int, xr), i)); pa += xi * wa[i]; px += xi * wx[i]; }
                const float r = sigmoid_f(pa), ig = sigmoid_f(px);
                const float la = -c8sp * r, av = expf(la), mult = sqrtf(-expm1f(2.0f * la));
                h = av * h + mult * ig * xr;
                B.GG[base + (size_t)(t0 + tt) * D] = (bf16_t)f2bf(h * gg[tt]);
            }
        }
    }
}

__device__ __forceinline__ void phase_attn_naive(const Args& a, const Bufs& B, LAS unsigned char* lds) {
    const int lane = threadIdx.x & 63, wave = __builtin_amdgcn_readfirstlane(threadIdx.x >> 6);
    LAS float* sc = (LAS float*)(lds + wave * 16384);
    LAS float* qs = (LAS float*)(lds + 131072 + wave * 512);
    const float lam = expf(wave_sum(a.in[10][lane] * a.in[11][lane])) - expf(wave_sum(a.in[12][lane] * a.in[13][lane])) + LAM_INIT;
    const float g0 = a.in[14][2 * lane], g1 = a.in[14][2 * lane + 1];
    const int gw = blockIdx.x * NWAVES + wave, NGW = gridDim.x * NWAVES;
    for (int it = gw; it < M * 8; it += NGW) {
        const int h = it & 7, m = it >> 3, pos = m & (SEQ - 1), b0 = m - pos, nk = ((pos >> 6) + 1) * 64;
        const bf16_t* qp = B.Q + (size_t)m * D + h * 128;
        qs[lane] = bf2f(qp[lane]); qs[64 + lane] = bf2f(qp[64 + lane]);
        LDS_WAIT();
        float m1 = -3.0e38f, m2 = -3.0e38f;
        for (int key = lane; key < nk; key += 64) {
            const bf16x8* kp = (const bf16x8*)(B.K + (size_t)(b0 + key) * D + h * 128);
            float s1 = 0.f, s2 = 0.f;
#pragma unroll
            for (int d8 = 0; d8 < 8; ++d8) { const bf16x8 k1 = kp[d8], k2 = kp[8 + d8];
#pragma unroll
                for (int e = 0; e < 8; ++e) { s1 += qs[d8 * 8 + e] * bf2f((unsigned short)k1[e]); s2 += qs[64 + d8 * 8 + e] * bf2f((unsigned short)k2[e]); } }
            sc[key] = s1; sc[2048 + key] = s2; m1 = fmaxf(m1, s1); m2 = fmaxf(m2, s2);
        }
        m1 = wave_max(m1); m2 = wave_max(m2);
        float l1 = 0.f, l2 = 0.f;
        for (int key = lane; key < nk; key += 64) { const float e1 = fexp2(sc[key] - m1), e2 = fexp2(sc[2048 + key] - m2); sc[key] = e1; sc[2048 + key] = e2; l1 += e1; l2 += e2; }
        l1 = wave_sum(l1); l2 = wave_sum(l2);
        const float i1 = 1.0f / l1, i2 = lam / l2;
        for (int key = lane; key < nk; key += 64) sc[key] = sc[key] * i1 - sc[2048 + key] * i2;
        LDS_WAIT();
        float o0 = 0.f, o1 = 0.f;
        const bf16_t* vp = B.V + (size_t)b0 * D + h * 128 + 2 * lane;
#pragma unroll 8
        for (int key = 0; key < nk; ++key) { const unsigned vv = *(const unsigned*)(vp + (size_t)key * D); const float p = sc[key]; o0 += p * bf2f(vv & 0xffffu); o1 += p * bf2f(vv >> 16); }
        const float ss = wave_sum(o0 * o0 + o1 * o1);
        const float rn = (1.0f / sqrtf(ss * (1.0f / 128.0f) + SUBLN_EPS)) * OUT_SCALE;
        *(unsigned*)(B.Q + (size_t)m * D + h * 128 + 2 * lane) = pk2(o0 * rn * g0, o1 * rn * g1);
        LDS_WAIT();
    }
}

__device__ __forceinline__ void phase_rowss(const Bufs& B) {
    const int lane = threadIdx.x & 63, wave = threadIdx.x >> 6;
    for (int m = blockIdx.x * NWAVES + wave; m < M; m += gridDim.x * NWAVES) {
        const f32x4* xr = (const f32x4*)(B.out + (size_t)m * D) + lane; float s = 0.f;
#pragma unroll
        for (int j = 0; j < 4; ++j) { const f32x4 v = xr[64 * j]; s += (v.x * v.x + v.y * v.y) + (v.z * v.z + v.w * v.w); }
        s = wave_sum(s); if (lane == 0) B.ss1[m] = s;
    }
}
__device__ __forceinline__ void phase_final(const Args& a, const Bufs& B) {
    const int lane = threadIdx.x & 63, wave = threadIdx.x >> 6;
    const f32x4* g4 = (const f32x4*)a.in[21];
    for (int m = blockIdx.x * NWAVES + wave; m < M; m += gridDim.x * NWAVES) {
        f32x4* xr = (f32x4*)(B.out + (size_t)m * D) + lane; f32x4 v[4]; float s = 0.f;
#pragma unroll
        for (int j = 0; j < 4; ++j) { v[j] = xr[64 * j]; s += (v[j].x * v[j].x + v[j].y * v[j].y) + (v[j].z * v[j].z + v[j].w * v[j].w); }
        const float rs = 1.0f / sqrtf(wave_sum(s) * (1.0f / D) + NORM_EPS);
#pragma unroll
        for (int j = 0; j < 4; ++j) { const f32x4 g = g4[lane + 64 * j]; xr[64 * j] = (f32x4){v[j].x * rs * g.x, v[j].y * rs * g.y, v[j].z * rs * g.z, v[j].w * rs * g.w}; }
    }
}

constexpr int LDS_BYTES = 147456;
constexpr int N_PHASES = 11;
__global__ void __launch_bounds__(NTHREADS, 2) fwd_kernel(Args a) {
    extern __shared__ __attribute__((aligned(16))) unsigned char lds_raw[];
    LAS unsigned char* lds = (LAS unsigned char*)lds_raw;
    cg::grid_group grid = cg::this_grid();
    const Bufs B = make_bufs(a);
    const int lo = a.ph_lo, hi = a.ph_hi;
#define IN(k) (lo <= (k) && (k) < hi)
#define SEAM(k) do { if (IN(k) && IN((k) + 1)) grid.sync(); } while (0)
    if (IN(0)) { phase_prep(a, B, lds); } SEAM(0);
    if (IN(1)) { FInProj f{B}; gemm_any(lds, B.H, B.Win, M, NIN, D, f); } SEAM(1);
    if (IN(2)) { phase_rope(B); } SEAM(2);
    if (IN(3)) { phase_rnn_naive(a, B); phase_attn_naive(a, B, lds); } SEAM(3);
    if (IN(4)) { FBrA f{B}; gemm_any(lds, B.GG, B.Wbr, M, D, D, f); } SEAM(4);
    if (IN(5)) { FBrB f{B}; gemm_any(lds, B.Q, B.Wba, M, D, D, f); } SEAM(5);
    if (IN(6)) { FOut f{B}; gemm_any(lds, B.MG, B.Wout, M, D, D, f); } SEAM(6);
    if (IN(7)) { phase_rowss(B); } SEAM(7);
    if (IN(8)) { FMlp1 f{B}; gemm_any(lds, B.X1B, B.W1, M, DFF, D, f); } SEAM(8);
    if (IN(9)) { FMlp2 f{B}; gemm_any(lds, B.HID, B.W2, M, D, DFF, f); } SEAM(9);
    if (IN(10)) { phase_final(a, B); }
#undef IN
#undef SEAM
}

extern "C" void kernel_launch(void* const* d_in, const int* in_sizes, int n_in, void* d_out, int out_size, void* d_ws, size_t ws_size, hipStream_t stream) {
    static int grid = 0;
    if (grid == 0) {
        if (n_in != 22 || in_sizes[0] != M * D || out_size != M * D || ws_size < WS_END) { fprintf(stderr, "kernel_launch: unexpected shapes (n_in %d, in0 %d, out %d, ws %zu); nothing launched\n", n_in, n_in > 0 ? in_sizes[0] : -1, out_size, ws_size); grid = -1; return; }
        int dev = 0, cus = 0, per_cu = 0;
        if (hipGetDevice(&dev) != hipSuccess || hipDeviceGetAttribute(&cus, hipDeviceAttributeMultiprocessorCount, dev) != hipSuccess) { grid = -1; return; }
        if (hipFuncSetAttribute((const void*)fwd_kernel, hipFuncAttributeMaxDynamicSharedMemorySize, LDS_BYTES) != hipSuccess) { fprintf(stderr, "kernel_launch: hipFuncSetAttribute failed\n"); grid = -1; return; }
        if (hipOccupancyMaxActiveBlocksPerMultiprocessor(&per_cu, (const void*)fwd_kernel, NTHREADS, LDS_BYTES) != hipSuccess || per_cu < 1) { fprintf(stderr, "kernel_launch: occupancy query says %d blocks per CU\n", per_cu); (void)hipGetLastError(); per_cu = 1; }
        grid = cus;
    }
    if (grid < 0) return;
    (void)hipMemsetAsync((char*)d_ws + WS_CTL, 0, CTL_ZERO_BYTES, stream);
    Args a{};
    for (int i = 0; i < 22; ++i) a.in[i] = (const float*)d_in[i];
    a.out = (float*)d_out; a.ws = (unsigned char*)d_ws;
#if MK_N_LAUNCHES == 1
    a.ph_lo = 0; a.ph_hi = N_PHASES;
    void* args[] = {&a};
    hipError_t e = hipLaunchCooperativeKernel((const void*)fwd_kernel, dim3(grid), dim3(NTHREADS), args, LDS_BYTES, stream);
    if (e != hipSuccess) fprintf(stderr, "kernel_launch: cooperative launch failed: %s (grid %d)\n", hipGetErrorString(e), grid);
#else
    for (int p = 0; p < N_PHASES; ++p) { a.ph_lo = p; a.ph_hi = p + 1; hipLaunchKernelGGL(fwd_kernel, dim3(grid), dim3(NTHREADS), LDS_BYTES, stream, a); }
#endif
}
```

```cpp
#include <hip/hip_runtime.h>
#include <cstdio>
#include <cstdint>

#ifndef MK_N_LAUNCHES
#define MK_N_LAUNCHES 1
#endif

namespace pg8 {
#define PG8_LAS __attribute__((address_space(3)))
typedef unsigned short bf16_t;
typedef short bf16x8 __attribute__((ext_vector_type(8)));
typedef float f32x4 __attribute__((ext_vector_type(4)));
typedef unsigned u32x4 __attribute__((ext_vector_type(4)));
constexpr int BM = 256, BK = 64, HALF = 128, HTB = HALF * BK * 2  , STAGE_BYTES = 8 * HTB, NXCD = 8, WGM = 8;

__host__ __device__ __forceinline__ int lds_byte(int r, int c) { const int st = (r >> 4) * 2 + (c >> 5), rr = r & 15, cc = c & 31, ob = rr * 64 + cc * 2; return st * 1024 + (ob ^ (((ob >> 9) & 1) << 5)); }
__host__ __device__ __forceinline__ void stage_rc(int b, int& R, int& C) { const int st = b / 1024, sb = b % 1024, swz = sb ^ (((sb >> 9) & 1) << 5); R = (st >> 1) * 16 + swz / 64; C = (st & 1) * 32 + (swz % 64) / 2; }
__host__ __device__ __forceinline__ int perm32(int rho) { const int n = rho >> 4, i = rho & 15; return 8 * (i >> 2) + 4 * n + (i & 3); }

struct Unit { int pm, pn; };
struct Gemm { const bf16_t* A; const bf16_t* Bt; int M, N, K; };

struct StaticOrder {
    int nM, nN, nwg, G, c;
    __host__ __device__ __forceinline__ void init(int M, int N, int G_, int c_) { nM = M / BM; nN = N / BM; nwg = nM * nN; G = G_; c = c_; }
    __host__ __device__ __forceinline__ bool next(int i, Unit& u) const {
        const long L = (long)i * G + c; if (L >= nwg) return false;
        int wgid = (int)L; { const int q = nwg / NXCD, r = nwg % NXCD, xcd = wgid % NXCD, off = wgid / NXCD; wgid = (xcd < r ? xcd * (q + 1) : r * (q + 1) + (xcd - r) * q) + off; }
        const int nig = WGM * nN, gid = wgid / nig, fm = gid * WGM, gsz = (nM - fm) < WGM ? (nM - fm) : WGM;
        u.pm = fm + ((wgid % nig) % gsz); u.pn = (wgid % nig) / gsz; return true;
    }
    __device__ __forceinline__ void a_ready(const Unit&) const {}
    __device__ __forceinline__ void done(const Unit&) const {}
};
template <class Epi, class Sched, bool ALIGN_EPI = false, bool SP2 = false>
__device__ __forceinline__ void gemm_phase(PG8_LAS unsigned char* lds, const Gemm g, const Sched& S, const Epi& E) {
    const int tid = threadIdx.x, wid = __builtin_amdgcn_readfirstlane(tid >> 6), lane = tid & 63, wr = wid >> 2, wc = wid & 3, fr = lane & 15, fq = lane >> 4;
    const int K = g.K, nt = K / BK;
    unsigned voffA[2], voffB[2];
#pragma unroll
    for (int i = 0; i < 2; ++i) { int R, C; stage_rc(tid * 16 + i * 8192, R, C); const int Rb = Epi::PERM ? ((R & ~31) + perm32(R & 31)) : R;
        voffA[i] = (unsigned)(R * K + C) * 2u; voffB[i] = (unsigned)(Rb * K + C) * 2u; }
    const size_t kstep = (size_t)(BK * 2);
    const size_t hstep = (size_t)HALF * K * 2;
    const size_t tstep = 2 * hstep;
    const unsigned ldsw = (unsigned)wid * 1024u;
    const int aoff = lds_byte(wr * 64 + fr, fq * 8), boff = lds_byte(wc * 32 + fr, fq * 8);
#define PG8_SA(b, h) (((b) * 2 + (h)) * HTB)
#define PG8_SB(b, h) ((4 + (b) * 2 + (h)) * HTB)
#define PG8_STAGE(bufoff, gbase, voff) do { _Pragma("unroll") for (int _i = 0; _i < 2; ++_i) \
        __builtin_amdgcn_global_load_lds((const unsigned*)((const char*)(gbase) + (voff)[_i]), (PG8_LAS unsigned*)(lds + (bufoff) + ldsw + _i * 8192), 16, 0, 0); } while (0)
#define PG8_LDA(dst, b, h) do { _Pragma("unroll") for (int m = 0; m < 4; ++m) _Pragma("unroll") for (int k = 0; k < 2; ++k) dst[m][k] = *(const PG8_LAS bf16x8*)(lds + PG8_SA(b, h) + aoff + m * 2048 + k * 1024); } while (0)
#define PG8_LDB(dst, b, h) do { _Pragma("unroll") for (int n = 0; n < 2; ++n) _Pragma("unroll") for (int k = 0; k < 2; ++k) dst[n][k] = *(const PG8_LAS bf16x8*)(lds + PG8_SB(b, h) + boff + n * 2048 + k * 1024); } while (0)
#define PG8_MMA(ai, bj, At, Bt) do { __builtin_amdgcn_s_setprio(1); _Pragma("unroll") for (int m = 0; m < 4; ++m) _Pragma("unroll") for (int n = 0; n < 2; ++n) _Pragma("unroll") for (int k = 0; k < 2; ++k) \
        acc[ai][bj][m][n] = __builtin_amdgcn_mfma_f32_16x16x32_bf16(Bt[n][k], At[m][k], acc[ai][bj][m][n], 0, 0, 0); __builtin_amdgcn_s_setprio(0); } while (0)
#define PG8_WAIT_V(n) asm volatile("s_waitcnt vmcnt(" #n ")" ::: "memory")
#define PG8_WAIT_L(n) asm volatile("s_waitcnt lgkmcnt(" #n ")" ::: "memory")
#define PG8_BAR __builtin_amdgcn_s_barrier()
#define PG8_SCHED __builtin_amdgcn_sched_barrier(0)
    Unit cur, nxt; int ui = 0;
    if (!S.next(0, cur)) return;
    f32x4 acc[2][2][4][2];
#pragma unroll
    for (int a = 0; a < 2; ++a)
#pragma unroll
        for (int b = 0; b < 2; ++b)
#pragma unroll
            for (int m = 0; m < 4; ++m)
#pragma unroll
                for (int n = 0; n < 2; ++n) acc[a][b][m][n] = (f32x4){0.f, 0.f, 0.f, 0.f};
    bf16x8 At[4][2], B0[2][2], B1[2][2];
    const char* cA = (const char*)g.A + (size_t)cur.pm * tstep; const char* cB = (const char*)g.Bt + (size_t)cur.pn * tstep;
    S.a_ready(cur);
    if constexpr (SP2) {
        PG8_STAGE(PG8_SB(0, 0), cB, voffB); PG8_STAGE(PG8_SB(0, 1), cB + hstep, voffB); PG8_STAGE(PG8_SA(0, 0), cA, voffA); PG8_STAGE(PG8_SA(0, 1), cA + hstep, voffA);
        if (wr == 1) PG8_BAR;
        PG8_WAIT_V(2); PG8_BAR;
        PG8_STAGE(PG8_SB(1, 0), cB + kstep, voffB); PG8_STAGE(PG8_SA(1, 0), cA + kstep, voffA); PG8_STAGE(PG8_SB(1, 1), cB + hstep + kstep, voffB);
        PG8_WAIT_V(6); PG8_BAR;
    } else {
        PG8_STAGE(PG8_SB(0, 0), cB, voffB); PG8_STAGE(PG8_SA(0, 0), cA, voffA); PG8_STAGE(PG8_SB(0, 1), cB + hstep, voffB); PG8_STAGE(PG8_SA(0, 1), cA + hstep, voffA);
        if (wr == 1) PG8_BAR;
        PG8_WAIT_V(4); PG8_BAR;
        PG8_STAGE(PG8_SB(1, 0), cB + kstep, voffB); PG8_STAGE(PG8_SA(1, 0), cA + kstep, voffA); PG8_STAGE(PG8_SB(1, 1), cB + hstep + kstep, voffB);
        PG8_WAIT_V(6); PG8_BAR;
    }
    for (;;) {
        const bool has_next = S.next(ui + 1, nxt);
        const char* nA = has_next ? (const char*)g.A + (size_t)nxt.pm * tstep : cA; const char* nB = has_next ? (const char*)g.Bt + (size_t)nxt.pn * tstep : cB;
        for (int t = 0; t < nt; t += 2) {
            const bool last = (t == nt - 2);
            const char* a1 = cA + (size_t)(t + 1) * kstep;
            const char* a2 = last ? nA : cA + (size_t)(t + 2) * kstep; const char* b2 = last ? nB : cB + (size_t)(t + 2) * kstep;
            const char* a3 = a2 + kstep; const char* b3 = b2 + kstep;
            if (last && has_next) S.a_ready(nxt);
            if constexpr (SP2) {
            PG8_LDB(B0, 0, 0); PG8_LDB(B1, 0, 1); PG8_SCHED; PG8_LDA(At, 0, 0); PG8_STAGE(PG8_SA(1, 1), a1 + hstep, voffA);
            PG8_WAIT_V(8); PG8_WAIT_L(0); PG8_BAR; PG8_MMA(0, 0, At, B0); PG8_MMA(0, 1, At, B1); PG8_BAR; PG8_SCHED;
            PG8_LDA(At, 0, 1); PG8_STAGE(PG8_SB(0, 0), b2, voffB); PG8_STAGE(PG8_SB(0, 1), b2 + hstep, voffB); PG8_STAGE(PG8_SA(0, 0), a2, voffA);
            PG8_WAIT_V(8); PG8_WAIT_L(0); PG8_BAR; PG8_MMA(1, 0, At, B0); PG8_MMA(1, 1, At, B1); PG8_BAR; PG8_SCHED;
            PG8_LDB(B0, 1, 0); PG8_LDB(B1, 1, 1); PG8_SCHED; PG8_LDA(At, 1, 0); PG8_STAGE(PG8_SA(0, 1), a2 + hstep, voffA);
            PG8_WAIT_V(8); PG8_WAIT_L(0); PG8_BAR; PG8_MMA(0, 0, At, B0); PG8_MMA(0, 1, At, B1); PG8_BAR; PG8_SCHED;
            PG8_LDA(At, 1, 1); PG8_STAGE(PG8_SB(1, 0), b3, voffB); PG8_STAGE(PG8_SB(1, 1), b3 + hstep, voffB); PG8_STAGE(PG8_SA(1, 0), a3, voffA);
            PG8_WAIT_V(8); PG8_WAIT_L(0); PG8_BAR; PG8_MMA(1, 0, At, B0); PG8_MMA(1, 1, At, B1); PG8_BAR; PG8_SCHED;
            } else {
            PG8_LDB(B0, 0, 0); PG8_SCHED; PG8_LDA(At, 0, 0); PG8_STAGE(PG8_SA(1, 1), a1 + hstep, voffA);
            PG8_WAIT_L(8); PG8_BAR; PG8_WAIT_L(0); PG8_MMA(0, 0, At, B0); PG8_BAR; PG8_SCHED;
            PG8_LDB(B1, 0, 1); PG8_STAGE(PG8_SB(0, 0), b2, voffB);
            PG8_BAR; PG8_WAIT_L(0); PG8_MMA(0, 1, At, B1); PG8_BAR;
            PG8_LDA(At, 0, 1); PG8_STAGE(PG8_SA(0, 0), a2, voffA);
            PG8_BAR; PG8_WAIT_L(0); PG8_MMA(1, 0, At, B0); PG8_BAR; PG8_SCHED;
            PG8_STAGE(PG8_SB(0, 1), b2 + hstep, voffB);
            PG8_WAIT_V(6); PG8_BAR; PG8_MMA(1, 1, At, B1); PG8_BAR;
            PG8_LDB(B0, 1, 0); PG8_SCHED; PG8_LDA(At, 1, 0); PG8_STAGE(PG8_SA(0, 1), a2 + hstep, voffA);
            PG8_WAIT_L(8); PG8_BAR; PG8_WAIT_L(0); PG8_MMA(0, 0, At, B0); PG8_BAR; PG8_SCHED;
            PG8_LDB(B1, 1, 1); PG8_STAGE(PG8_SB(1, 0), b3, voffB);
            PG8_BAR; PG8_WAIT_L(0); PG8_MMA(0, 1, At, B1); PG8_BAR;
            PG8_LDA(At, 1, 1); PG8_STAGE(PG8_SA(1, 0), a3, voffA);
            PG8_BAR; PG8_WAIT_L(0); PG8_MMA(1, 0, At, B0); PG8_BAR; PG8_SCHED;
            PG8_STAGE(PG8_SB(1, 1), b3 + hstep, voffB);
            PG8_WAIT_V(6); PG8_BAR; PG8_MMA(1, 1, At, B1); PG8_BAR;
            }
        }
        if constexpr (ALIGN_EPI) { if (wr == 0) PG8_BAR; }
        if constexpr (!Epi::AFTER_DRAIN) { E(acc, cur, wr, wc, fr, fq); S.done(cur); }
        if (!has_next) break;
#pragma unroll
        for (int a = 0; a < 2; ++a)
#pragma unroll
            for (int b = 0; b < 2; ++b)
#pragma unroll
                for (int m = 0; m < 4; ++m)
#pragma unroll
                    for (int n = 0; n < 2; ++n) acc[a][b][m][n] = (f32x4){0.f, 0.f, 0.f, 0.f};
        cur = nxt; cA = nA; cB = nB; ++ui;
        if constexpr (ALIGN_EPI) { if (wr == 1) PG8_BAR; }
    }
    PG8_WAIT_V(0);
    if constexpr (!ALIGN_EPI) { if (wr == 0) PG8_BAR; }
    PG8_BAR;
    if constexpr (Epi::AFTER_DRAIN) { E.fused(acc, cur, wr, wc, fr, fq, lds, wid, lane); S.done(cur); }
#undef PG8_SA
#undef PG8_SB
#undef PG8_STAGE
#undef PG8_LDA
#undef PG8_LDB
#undef PG8_MMA
#undef PG8_WAIT_V
#undef PG8_WAIT_L
#undef PG8_BAR
#undef PG8_SCHED
}
}

constexpr int BATCH = 16, SEQ = 2048, D = 1024, M = BATCH * SEQ, NIN = 7168, DFF = 4096;
constexpr int NWAVES = 8, NTHREADS = 512;
constexpr float NORM_EPS = 1e-6f, SUBLN_EPS = 1e-5f;
constexpr float LOG2E = 1.4426950408889634f;
constexpr float QSCALE = 0.18033688011112042f;
constexpr float LAM_INIT = 0.2f;
constexpr float OUT_SCALE = 1.0f - LAM_INIT;

#define LAS __attribute__((address_space(3)))
typedef unsigned short bf16_t;
typedef short bf16x8 __attribute__((ext_vector_type(8)));
typedef float f32x4 __attribute__((ext_vector_type(4)));
typedef float f32x16 __attribute__((ext_vector_type(16)));
typedef unsigned u32x4 __attribute__((ext_vector_type(4)));
typedef unsigned u32x2 __attribute__((ext_vector_type(2)));

constexpr size_t MiB = 1u << 20;
constexpr size_t WS_CTL = 0, CTL_ZERO_BYTES = 64 * 1024;
constexpr size_t WS_SS1 = 512 * 1024;
constexpr size_t WS_SS2 = 640 * 1024;
constexpr int CW_PANEL = 10240;
constexpr size_t WS_ROPE = 1 * MiB;
constexpr size_t WS_WIN = 2 * MiB, WS_WBR = 16 * MiB, WS_WBA = 18 * MiB, WS_WOUT = 20 * MiB, WS_W1 = 22 * MiB, WS_W2 = 30 * MiB;
constexpr size_t WS_B0 = 48 * MiB, WS_B1 = 112 * MiB, WS_B2 = 176 * MiB, WS_B3 = 240 * MiB, WS_B4 = 304 * MiB, WS_B5 = 368 * MiB, WS_END = 432 * MiB;

struct Args { const float* in[22]; float* out; unsigned char* ws; int ph_lo, ph_hi; };

struct Bufs {
    const float* x; float* out;
    bf16_t *Win, *Wbr, *Wba, *Wout, *W1, *W2;
    bf16_t *H, *UX, *GG, *Q, *K, *V, *MG, *X1B, *HID; unsigned char *SR, *SA;
    float *ss1, *ss2, *ropec, *ropes; bf16_t* T; unsigned* pcnt;
};
__device__ __forceinline__ Bufs make_bufs(const Args& a) {
    Bufs b; unsigned char* ws = a.ws;
    b.x = a.in[0]; b.out = a.out;
    b.Win = (bf16_t*)(ws + WS_WIN); b.Wbr = (bf16_t*)(ws + WS_WBR); b.Wba = (bf16_t*)(ws + WS_WBA); b.Wout = (bf16_t*)(ws + WS_WOUT); b.W1 = (bf16_t*)(ws + WS_W1); b.W2 = (bf16_t*)(ws + WS_W2);
    b.H = (bf16_t*)(ws + WS_B0); b.UX = (bf16_t*)(ws + WS_B1); b.GG = (bf16_t*)(ws + WS_B2); b.Q = (bf16_t*)(ws + WS_B3); b.K = (bf16_t*)(ws + WS_B4); b.V = (bf16_t*)(ws + WS_B5);
    b.SR = (unsigned char*)a.out; b.SA = (unsigned char*)a.out + (size_t)M * D;
    b.MG = (bf16_t*)(ws + WS_B0); b.X1B = (bf16_t*)(ws + WS_B1); b.HID = (bf16_t*)(ws + WS_B2);
    b.T = (bf16_t*)(ws + WS_B4); b.ss1 = (float*)(ws + WS_SS1); b.ss2 = (float*)(ws + WS_SS2); b.pcnt = (unsigned*)(ws + WS_CTL) + CW_PANEL; b.ropec = (float*)(ws + WS_ROPE); b.ropes = b.ropec + 2048 * 32;
    return b;
}

__device__ __forceinline__ unsigned f2bf(float f) { unsigned u = __builtin_bit_cast(unsigned, f); return (u + 0x7fffu + ((u >> 16) & 1u)) >> 16; }
typedef float pk_f32x2_t __attribute__((ext_vector_type(2))); typedef __bf16 pk_bf16x2_t __attribute__((ext_vector_type(2)));
__device__ __forceinline__ unsigned pk2(float lo, float hi) { const pk_f32x2_t v = {lo, hi}; return __builtin_bit_cast(unsigned, __builtin_convertvector(v, pk_bf16x2_t)); }
__device__ __forceinline__ float bf2f(unsigned b) { return __builtin_bit_cast(float, b << 16); }
__device__ __forceinline__ float fexp2(float x) { return __builtin_amdgcn_exp2f(x); }
__device__ __forceinline__ float sigmoid_f(float v) { return 1.0f / (1.0f + fexp2(-v * LOG2E)); }
__device__ __forceinline__ float gelu_tanh_f(float v) { const float y = 0.7978845608028654f * (v + 0.044715f * v * v * v); return v / (1.0f + fexp2(-2.0f * LOG2E * y)); }
__device__ __forceinline__ float wave_sum(float v) {
#pragma unroll
    for (int o = 1; o < 64; o <<= 1) v += __shfl_xor(v, o);
    return v;
}
__device__ __forceinline__ float wave_max(float v) {
#pragma unroll
    for (int o = 1; o < 64; o <<= 1) v = fmaxf(v, __shfl_xor(v, o));
    return v;
}
#define LDS_WAIT() asm volatile("s_waitcnt lgkmcnt(0)" ::: "memory")

__device__ __forceinline__ void store_wt16(void* p, const u32x4& v) { asm volatile("global_store_dwordx4 %0, %1, off sc0 sc1" :: "v"(p), "v"(v) : "memory"); }
__device__ __forceinline__ void store_wt8(void* p, const u32x2& v) { asm volatile("global_store_dwordx2 %0, %1, off sc0 sc1" :: "v"(p), "v"(v) : "memory"); }
__device__ __forceinline__ void transpose_item(const float* W, int K, int N, bf16_t* WT, int item, LAS float* scr, int lane, int permqk, const float* kscale) {
    const int nblk = N / 32, kb = item / nblk, nb = item % nblk, k0 = 64 * kb, n0 = 32 * nb;
    int s0 = n0;
    int cs = 0;
    if (permqk) { const int l = n0 & 255, bj = l >> 7, wc = (l >> 5) & 3; s0 = (n0 & ~255) + 64 * wc + 32 * bj; if (permqk > 1 && n0 >= 5120) { s0 = (n0 & ~255) + 64 * wc + 8 * bj; cs = 1; } }
#pragma unroll
    for (int i = 0; i < 8; ++i) { const int kk = 8 * i + (lane >> 3), c4 = (lane & 7) * 4; f32x4 v = *(const f32x4*)(W + (size_t)(k0 + kk) * N + s0 + (cs ? 16 * (c4 >> 3) + (c4 & 7) : c4));
        if (kscale) v = v * kscale[k0 + kk];
        if (cs) v = v * -LOG2E;
        LAS float* d = scr + kk * 33 + c4; d[0] = v.x; d[1] = v.y; d[2] = v.z; d[3] = v.w; }
    LDS_WAIT();
    const int c = lane & 7;
#pragma unroll
    for (int j = 0; j < 4; ++j) { const int n = (lane >> 3) + 8 * j; const LAS float* s = scr + (8 * c) * 33 + n;
        u32x4 o; o.x = pk2(s[0 * 33], s[1 * 33]); o.y = pk2(s[2 * 33], s[3 * 33]); o.z = pk2(s[4 * 33], s[5 * 33]); o.w = pk2(s[6 * 33], s[7 * 33]);
        store_wt16(WT + (size_t)(n0 + n) * K + k0 + 8 * c, o); }
    LDS_WAIT();
}
__constant__ double ROPE_INVF[32] = {1.0, 0.7498942093324559, 0.5623413251903491, 0.4216965034285822, 0.31622776601683794, 0.23713737056616552, 0.1778279410038923, 0.1333521432163324, 0.1, 0.07498942093324558,
    0.05623413251903491, 0.042169650342858224, 0.03162277660168379, 0.023713737056616554, 0.01778279410038923, 0.01333521432163324, 0.01, 0.007498942093324558, 0.005623413251903491, 0.004216965034285823,
    0.0031622776601683794, 0.0023713737056616554, 0.0017782794100389228, 0.001333521432163324, 0.001, 0.0007498942093324559, 0.0005623413251903491, 0.00042169650342858224, 0.00031622776601683794,
    0.00023713737056616554, 0.00017782794100389227, 0.0001333521432163324};
__device__ __forceinline__ void sincos_f64(double a, double& s, double& c) {
    const double k = __builtin_rint(a * 6.36619772367581382433e-01);
    double r = a - k * 1.57079632673412561417e+00; r = r - k * 6.07710050650619224932e-11;
    const double z = r * r;
    const double ps = r + r * z * (-1.66666666666666324348e-01 + z * (8.33333333332248946124e-03 + z * (-1.98412698298579493134e-04 + z * (2.75573137070700676789e-06 + z * (-2.50507602534068634195e-08 + z * 1.58969099521155010221e-10)))));
    const double pc = 1.0 - 0.5 * z + z * z * (4.16666666666666019037e-02 + z * (-1.38888888888741095749e-03 + z * (2.48015872894767294178e-05 + z * (-2.75573143513906633035e-07 + z * (2.08757232129817482790e-09 + z * -1.13596475577881948265e-11)))));
    const int q = (int)k & 3;
    s = (q == 0) ? ps : (q == 1) ? pc : (q == 2) ? -ps : -pc;
    c = (q == 0) ? pc : (q == 1) ? -ps : (q == 2) ? -pc : ps;
}
__device__ __forceinline__ void phase_prep(const Args& a, const Bufs& B, LAS unsigned char* lds) {
    const int tid = threadIdx.x, lane = tid & 63, wave = __builtin_amdgcn_readfirstlane(tid >> 6);
    LAS float* scr = (LAS float*)(lds + wave * 16384);
    const int gw = blockIdx.x * NWAVES + wave, NGW = gridDim.x * NWAVES;
    constexpr int I_IN = (D / 64) * (NIN / 32), I_SQ = (D / 64) * (D / 32), I_1 = (D / 64) * (DFF / 32), I_2 = (DFF / 64) * (D / 32);
    constexpr int NITEMS = I_IN + 3 * I_SQ + I_1 + I_2;
    for (int it = gw; it < NITEMS; it += NGW) {
        int r = it;
        if (r < I_IN) { transpose_item(a.in[2], D, NIN, B.Win, r, scr, lane, 2, nullptr); continue; } r -= I_IN;
        if (r < I_SQ) { transpose_item(a.in[15], D, D, B.Wbr, r, scr, lane, 1, nullptr); continue; } r -= I_SQ;
        if (r < I_SQ) { transpose_item(a.in[16], D, D, B.Wba, r, scr, lane, 1, nullptr); continue; } r -= I_SQ;
        if (r < I_SQ) { transpose_item(a.in[17], D, D, B.Wout, r, scr, lane, 1, nullptr); continue; } r -= I_SQ;
        if (r < I_1) { transpose_item(a.in[19], D, DFF, B.W1, r, scr, lane, 1, a.in[18]); continue; } r -= I_1;
        transpose_item(a.in[20], DFF, D, B.W2, r, scr, lane, 1, nullptr);
    }
    const f32x4* g4 = (const f32x4*)a.in[1];
    for (int m = 2 * gw; m < M; m += 2 * NGW) {
        const f32x4* xr = (const f32x4*)(B.x + (size_t)m * D) + lane;
        f32x4 v[2][4]; float s0 = 0.f, s1 = 0.f;
#pragma unroll
        for (int j = 0; j < 4; ++j) { v[0][j] = xr[64 * j]; v[1][j] = xr[256 + 64 * j]; }
#pragma unroll
        for (int j = 0; j < 4; ++j) { s0 += (v[0][j].x * v[0][j].x + v[0][j].y * v[0][j].y) + (v[0][j].z * v[0][j].z + v[0][j].w * v[0][j].w);
                                      s1 += (v[1][j].x * v[1][j].x + v[1][j].y * v[1][j].y) + (v[1][j].z * v[1][j].z + v[1][j].w * v[1][j].w); }
        const float rs0 = 1.0f / sqrtf(wave_sum(s0) * (1.0f / D) + NORM_EPS), rs1 = 1.0f / sqrtf(wave_sum(s1) * (1.0f / D) + NORM_EPS);
        u32x2* o = (u32x2*)(B.H + (size_t)m * D) + lane;
#pragma unroll
        for (int j = 0; j < 4; ++j) { const f32x4 g = g4[lane + 64 * j]; u32x2 w;
            w.x = pk2(v[0][j].x * rs0 * g.x, v[0][j].y * rs0 * g.y); w.y = pk2(v[0][j].z * rs0 * g.z, v[0][j].w * rs0 * g.w); store_wt8(o + 64 * j, w);
            w.x = pk2(v[1][j].x * rs1 * g.x, v[1][j].y * rs1 * g.y); w.y = pk2(v[1][j].z * rs1 * g.z, v[1][j].w * rs1 * g.w); store_wt8(o + 256 + 64 * j, w); }
    }
    for (int i = blockIdx.x * NTHREADS + tid; i < M; i += gridDim.x * NTHREADS) { B.ss1[i] = 0.f; B.ss2[i] = 0.f; }
    for (int idx = blockIdx.x * NTHREADS + tid; idx < 2048 * 32; idx += gridDim.x * NTHREADS) {
        const int pos = idx >> 5, j = idx & 31; double s, c; sincos_f64((double)pos * ROPE_INVF[j], s, c);
        B.ropec[idx] = (float)c; B.ropes[idx] = (float)s;
    }
}

namespace att {
constexpr int KV_STAGE = 32768, LDS_XCH = 2 * KV_STAGE, XCH_PAIR = 17408, LDS_WSF = LDS_XCH + 4 * XCH_PAIR;
constexpr float THR = 8.0f;
typedef short v4i16_t __attribute__((ext_vector_type(4)));
typedef float f32x2_t __attribute__((ext_vector_type(2))); typedef __bf16 bf16x2_t __attribute__((ext_vector_type(2)));
__device__ __forceinline__ float max3f(float a, float b, float c) { float r; asm("v_max3_f32 %0, %1, %2, %3" : "=v"(r) : "v"(a), "v"(b), "v"(c)); return r; }
__device__ __forceinline__ int crow(int r, int hi) { return (r & 3) + 8 * (r >> 2) + 4 * hi; }
__device__ __forceinline__ unsigned cvtpk(float lo, float hi) { f32x2_t v = {lo, hi}; bf16x2_t b = __builtin_convertvector(v, bf16x2_t); return __builtin_bit_cast(unsigned, b); }
__device__ __forceinline__ v4i16_t vtr(const LAS unsigned char* p) { return __builtin_amdgcn_ds_read_tr16_b64_v4i16((LAS v4i16_t*)p); }
__device__ __forceinline__ void swap32(unsigned& a, unsigned& b) { asm volatile("s_nop 1\n\tv_permlane32_swap_b32 %0, %1\n\ts_nop 1" : "+v"(a), "+v"(b)); }
__device__ __forceinline__ float swap_max(float m) { unsigned a = __builtin_bit_cast(unsigned, m), b = a; swap32(a, b); return fmaxf(__builtin_bit_cast(float, a), __builtin_bit_cast(float, b)); }
__device__ __forceinline__ float swap_sum(float m) { unsigned a = __builtin_bit_cast(unsigned, m), b = a; swap32(a, b); return __builtin_bit_cast(float, a) + __builtin_bit_cast(float, b); }

__device__ __forceinline__ void glds16(const void* gsrc, unsigned lds_dst) { unsigned keep;
    asm volatile("s_mov_b32 %0, m0\n\ts_mov_b32 m0, %2\n\ts_nop 0\n\tglobal_load_lds_dwordx4 %1, off\n\ts_mov_b32 m0, %0" : "=&s"(keep) : "v"(gsrc), "s"(lds_dst) : "memory"); }
#define ATT_SB() __builtin_amdgcn_sched_barrier(0)
__device__ __forceinline__ unsigned scale_pk(unsigned w, float f) { return cvtpk(bf2f(w & 0xffffu) * f, bf2f(w >> 16) * f); }
__device__ __forceinline__ void pv_plain(f32x16 (&o)[4], const LAS unsigned char* vb, const u32x4 (&pw)[4]) {
#pragma unroll
    for (int d0 = 0; d0 < 4; ++d0)
#pragma unroll
        for (int ks = 0; ks < 4; ++ks) { const v4i16_t lo = vtr(vb + d0 * 4096 + ks * 1024), hh = vtr(vb + d0 * 4096 + ks * 1024 + 512);
            const bf16x8 vf = {lo[0], lo[1], lo[2], lo[3], hh[0], hh[1], hh[2], hh[3]};
            o[d0] = __builtin_amdgcn_mfma_f32_32x32x16_bf16(__builtin_bit_cast(bf16x8, pw[ks]), vf, o[d0], 0, 0, 0); }
}
constexpr int LDS_K = 0, LDS_V = 49152, LDS_X2 = 114688, LDS_WSF2 = LDS_X2 + 32768;
template <int RB, bool OWN0> __device__ __forceinline__ void attn_tail_half(f32x16 (&o)[4], LAS unsigned* XR, float lam, const float* subg, bf16_t* Orow, int lane, int r32, int hi) {
    float ssq[8];
#pragma unroll
    for (int r = 0; r < 8; ++r) ssq[r] = 0.f;
#pragma unroll
    for (int d0 = 0; d0 < 4; ++d0)
#pragma unroll
        for (int rr = 0; rr < 4; ++rr) { const unsigned w = XR[(d0 * 4 + rr) * 64 + lane]; const float b0 = bf2f(w & 0xffffu), b1 = bf2f(w >> 16);
            const float v0 = OWN0 ? o[d0][RB + 2 * rr] - lam * b0 : b0 - lam * o[d0][RB + 2 * rr], v1 = OWN0 ? o[d0][RB + 2 * rr + 1] - lam * b1 : b1 - lam * o[d0][RB + 2 * rr + 1];
            o[d0][RB + 2 * rr] = v0; o[d0][RB + 2 * rr + 1] = v1; ssq[2 * rr] += v0 * v0; ssq[2 * rr + 1] += v1 * v1; }
#define ATT_DPPF(v, ctrl) __builtin_bit_cast(float, __builtin_amdgcn_update_dpp(0, __builtin_bit_cast(int, v), ctrl, 0xF, 0xF, false))
#pragma unroll
    for (int r = 0; r < 8; ++r) { float v = ssq[r]; v += ATT_DPPF(v, 0xB1); v += ATT_DPPF(v, 0x4E); v += ATT_DPPF(v, 0x124); v += ATT_DPPF(v, 0x128); ssq[r] = v + __shfl_xor(v, 16); }
#undef ATT_DPPF
    float g[4];
#pragma unroll
    for (int d0 = 0; d0 < 4; ++d0) g[d0] = subg[32 * d0 + r32] * OUT_SCALE;
    LAS bf16_t* Xo = (LAS bf16_t*)XR + r32;
#pragma unroll
    for (int r = 0; r < 8; r += 2) {
        const float rn0 = __builtin_amdgcn_rsqf(ssq[r] * (1.0f / 128.0f) + SUBLN_EPS), rn1 = __builtin_amdgcn_rsqf(ssq[r + 1] * (1.0f / 128.0f) + SUBLN_EPS);
        LAS bf16_t* xp = Xo + ((r & 3) + 8 * (r >> 2) + 4 * hi) * 128;
#pragma unroll
        for (int d0 = 0; d0 < 4; ++d0) { const unsigned w = pk2(o[d0][RB + r] * rn0 * g[d0], o[d0][RB + r + 1] * rn1 * g[d0]); xp[32 * d0] = (bf16_t)w; xp[128 + 32 * d0] = (bf16_t)(w >> 16); } }
    LDS_WAIT();
    bf16_t* ob = Orow + (size_t)(lane >> 4) * D + (lane & 15) * 8; const LAS unsigned char* xr = (const LAS unsigned char*)XR + lane * 16;
#pragma unroll
    for (int i = 0; i < 4; ++i) *(u32x4*)(ob + (size_t)(4 * i) * D) = *(const LAS u32x4*)(xr + i * 1024);
}
constexpr int LDS_QS = LDS_V + 32768;
__device__ __forceinline__ void attn_open(int b, int h, int qb, const bf16_t* Q, const bf16_t* K, const bf16_t* V, LAS unsigned char* lds) {
    const int tid = threadIdx.x, lane = tid & 63;
    const int wid = __builtin_amdgcn_readfirstlane(tid >> 6), ch = wid >> 2, s = (wid >> 1) & 1, qh = wid & 1;
    const int q0 = qb * 128 + ch * 64 + qh * 32;
    const size_t hb = ((size_t)(b * 8 + h) * SEQ) * 128;
    const bf16_t* ksrc = K + hb + (8 * ((2 * wid) & 7) + (lane >> 3)) * 128 + (wid >> 2) * 64 + ((lane & 7) ^ (lane >> 3)) * 8;
    const bf16_t* vsrc = V + hb + (32 * (wid & 1) + (lane >> 2)) * 128 + 32 * (wid >> 1) + (lane & 3) * 8;
    const bf16_t* qsrc = Q + ((size_t)b * SEQ + q0 + (lane >> 3)) * D + h * 128 + s * 64 + ((lane & 7) ^ (lane >> 3)) * 8;
    const unsigned ldsb = (unsigned)(uintptr_t)lds;
    const unsigned kdst = (unsigned)__builtin_amdgcn_readfirstlane(ldsb + LDS_K + (wid >> 2) * 8192 + ((2 * wid) & 7) * 1024), vdst = (unsigned)__builtin_amdgcn_readfirstlane(ldsb + LDS_V + (wid >> 1) * 4096 + (2 * (wid & 1)) * 1024);
    const unsigned qdst = (unsigned)__builtin_amdgcn_readfirstlane(ldsb + LDS_QS + wid * 4096);
#pragma unroll
    for (int p = 0; p < 4; ++p) glds16(qsrc + (size_t)(8 * p) * D, qdst + p * 1024);
#pragma unroll
    for (int t = 0; t < 2; ++t) { const size_t o = (size_t)t * 64 * 128;
        glds16(ksrc + o, kdst + t * 16384); glds16(ksrc + o + 8 * 128, kdst + t * 16384 + 1024); glds16(vsrc + o, vdst + t * 16384); glds16(vsrc + o + 16 * 128, vdst + t * 16384 + 1024); }
}
__device__ __forceinline__ void attn_unit(int b, int h, int qb, const bf16_t* Q, const bf16_t* K, const bf16_t* V, bf16_t* O, LAS unsigned char* lds, float lam, const float* subg, bool has_next, int nb, int nh, int nqb) {
    const int tid = threadIdx.x, lane = tid & 63, r32 = lane & 31, hi = lane >> 5;
    const int wid = __builtin_amdgcn_readfirstlane(tid >> 6), ch = wid >> 2, s = (wid >> 1) & 1, qh = wid & 1, pair = ch * 2 + qh;
    const int NT = 2 * qb + 2, ntw = 2 * qb + 1 + ch;
    const size_t rowb = (size_t)b * SEQ;
    const int q0 = qb * 128 + ch * 64 + qh * 32;
    const size_t hb = ((size_t)(b * 8 + h) * SEQ) * 128;
    const bf16_t* ksrc = K + hb + (8 * ((2 * wid) & 7) + (lane >> 3)) * 128 + (wid >> 2) * 64 + ((lane & 7) ^ (lane >> 3)) * 8;
    const bf16_t* vsrc = V + hb + (32 * (wid & 1) + (lane >> 2)) * 128 + 32 * (wid >> 1) + (lane & 3) * 8;
    const unsigned ldsb = (unsigned)(uintptr_t)lds;
    const unsigned kdst = ldsb + LDS_K + (wid >> 2) * 8192 + ((2 * wid) & 7) * 1024, vdst = ldsb + LDS_V + (wid >> 1) * 4096 + (2 * (wid & 1)) * 1024;
#define ATT_DMA(t, ks_, vs_) do { const size_t _o = (size_t)(t) * 64 * 128; \
        glds16(ksrc + _o, (unsigned)__builtin_amdgcn_readfirstlane(kdst + (ks_))); glds16(ksrc + _o + 8 * 128, (unsigned)__builtin_amdgcn_readfirstlane(kdst + (ks_) + 1024)); \
        glds16(vsrc + _o, (unsigned)__builtin_amdgcn_readfirstlane(vdst + (vs_))); glds16(vsrc + _o + 16 * 128, (unsigned)__builtin_amdgcn_readfirstlane(vdst + (vs_) + 1024)); } while (0)
    asm volatile("s_waitcnt vmcnt(8)" ::: "memory");
    bf16x8 qr[4];
    { const LAS unsigned char* qb_ = lds + LDS_QS + wid * 4096 + r32 * 128;
#pragma unroll
      for (int k = 0; k < 4; ++k) qr[k] = *(const LAS bf16x8*)(qb_ + (((2 * k + hi) ^ (r32 & 7)) << 4)); }
    LDS_WAIT();
    f32x16 o[4];
#pragma unroll
    for (int r = 0; r < 16; ++r) { o[0][r] = 0.f; o[1][r] = 0.f; o[2][r] = 0.f; o[3][r] = 0.f; }
    f32x16 osum;
#pragma unroll
    for (int r = 0; r < 16; ++r) osum[r] = 0.f;
    bf16x8 ones; { const short one = (short)0x3F80;
#pragma unroll
        for (int e = 0; e < 8; ++e) ones[e] = one; }
    bool refset = false;
    float mhat = 0.f;
    u32x4 pw[4];
#pragma unroll
    for (int k = 0; k < 4; ++k) pw[k] = (u32x4){0u, 0u, 0u, 0u};
    LAS float* wsf = (LAS float*)(lds + LDS_WSF2) + wid * 64;
    const LAS unsigned char* kbase = lds + LDS_K + s * 8192 + r32 * 128;
    const int kx7 = r32 & 7;
    const LAS unsigned char* vbase = lds + LDS_V + ((lane >> 4) & 1) * 32 + (lane & 3) * 8 + (4 * hi + ((lane & 15) >> 2)) * 64;
    int ks_cur = 0, ks_n2 = 32768;
    int vs_prev = 49152, vs_n2 = 32768;
    for (int t = 0; t < NT; ++t) {
        if (t + 1 < NT) asm volatile("s_waitcnt vmcnt(4)" ::: "memory"); else asm volatile("s_waitcnt vmcnt(0)" ::: "memory");
        __syncthreads();
        if (t + 2 < NT) ATT_DMA(t + 2, ks_n2, vs_n2);
        if (t < ntw) {
            const LAS unsigned char* kb = kbase + ks_cur; const LAS unsigned char* vb = vbase + vs_prev;
            bf16x8 kf[8];
#pragma unroll
            for (int d0 = 0; d0 < 4; ++d0) { const int kx = ((2 * d0 + hi) ^ kx7) << 4; kf[2 * d0] = *(const LAS bf16x8*)(kb + kx); kf[2 * d0 + 1] = *(const LAS bf16x8*)(kb + kx + 4096); }
            ATT_SB();
            v4i16_t va_l[4], va_h[4], vb_l[4], vb_h[4];
#define ATT_VRD(L_, H_, off_, k0_) do { if (t > 0) { L_[k0_] = vtr(vb + (off_) + (k0_) * 1024); H_[k0_] = vtr(vb + (off_) + (k0_) * 1024 + 512); \
                L_[(k0_) + 1] = vtr(vb + (off_) + ((k0_) + 1) * 1024); H_[(k0_) + 1] = vtr(vb + (off_) + ((k0_) + 1) * 1024 + 512); } } while (0)
            f32x16 p0, p1;
            if (!refset) {
                const f32x16 z = {0.f, 0.f, 0.f, 0.f, 0.f, 0.f, 0.f, 0.f, 0.f, 0.f, 0.f, 0.f, 0.f, 0.f, 0.f, 0.f};
                p0 = __builtin_amdgcn_mfma_f32_32x32x16_bf16(kf[0], qr[0], z, 0, 0, 0); p1 = __builtin_amdgcn_mfma_f32_32x32x16_bf16(kf[1], qr[0], z, 0, 0, 0);
            } else { const float nm = -mhat;
#pragma unroll
                for (int r = 0; r < 16; ++r) { p0[r] = nm; p1[r] = nm; }
                p0 = __builtin_amdgcn_mfma_f32_32x32x16_bf16(kf[0], qr[0], p0, 0, 0, 0); p1 = __builtin_amdgcn_mfma_f32_32x32x16_bf16(kf[1], qr[0], p1, 0, 0, 0); }
            ATT_VRD(va_l, va_h, 0, 0); ATT_SB();
            p0 = __builtin_amdgcn_mfma_f32_32x32x16_bf16(kf[2], qr[1], p0, 0, 0, 0); p1 = __builtin_amdgcn_mfma_f32_32x32x16_bf16(kf[3], qr[1], p1, 0, 0, 0); ATT_VRD(va_l, va_h, 0, 2); ATT_SB();
            p0 = __builtin_amdgcn_mfma_f32_32x32x16_bf16(kf[4], qr[2], p0, 0, 0, 0); p1 = __builtin_amdgcn_mfma_f32_32x32x16_bf16(kf[5], qr[2], p1, 0, 0, 0); ATT_VRD(vb_l, vb_h, 4096, 0); ATT_SB();
            p0 = __builtin_amdgcn_mfma_f32_32x32x16_bf16(kf[6], qr[3], p0, 0, 0, 0); p1 = __builtin_amdgcn_mfma_f32_32x32x16_bf16(kf[7], qr[3], p1, 0, 0, 0); ATT_VRD(vb_l, vb_h, 4096, 2); ATT_SB();
#undef ATT_VRD
#define ATT_MF(d0_, ks_, L_, H_) do { const bf16x8 vf_ = {L_[ks_][0], L_[ks_][1], L_[ks_][2], L_[ks_][3], H_[ks_][0], H_[ks_][1], H_[ks_][2], H_[ks_][3]}; \
                o[d0_] = __builtin_amdgcn_mfma_f32_32x32x16_bf16(__builtin_bit_cast(bf16x8, pw[ks_]), vf_, o[d0_], 0, 0, 0); } while (0)
            float rm, rm2;
            if (t > 0) {
#define ATT_V2(ks_) do { va_l[ks_] = vtr(vb + 8192 + (ks_) * 1024); va_h[ks_] = vtr(vb + 8192 + (ks_) * 1024 + 512); } while (0)
#define ATT_OS(ks_) osum = __builtin_amdgcn_mfma_f32_32x32x16_bf16(__builtin_bit_cast(bf16x8, pw[ks_]), ones, osum, 0, 0, 0)
                ATT_MF(0, 0, va_l, va_h); ATT_SB(); ATT_MF(0, 1, va_l, va_h); ATT_V2(0); ATT_SB(); ATT_MF(0, 2, va_l, va_h); ATT_V2(1); ATT_SB(); ATT_MF(0, 3, va_l, va_h); ATT_V2(2); ATT_SB();
#define ATT_MX(r_) do { rm = max3f(rm, p0[r_], p1[r_]); rm2 = max3f(rm2, p0[(r_) + 1], p1[(r_) + 1]); } while (0)
                ATT_OS(0); ATT_V2(3); rm = max3f(p0[0], p1[0], p0[1]); rm2 = max3f(p1[1], p0[2], p1[2]); ATT_MX(3); ATT_SB();
                ATT_OS(1); ATT_MX(5); ATT_MX(7); ATT_SB(); ATT_OS(2); ATT_MX(9); ATT_MX(11); ATT_SB(); ATT_OS(3); ATT_MX(13); rm = max3f(rm, rm2, p0[15]); rm = max3f(rm, p1[15], p1[15]); ATT_SB();
#undef ATT_OS
#undef ATT_V2
            } else {
                rm = max3f(p0[0], p1[0], p0[1]); rm2 = max3f(p1[1], p0[2], p1[2]);
                ATT_MX(3); ATT_MX(5); ATT_MX(7); ATT_MX(9); ATT_MX(11); ATT_MX(13);
                rm = max3f(rm, rm2, p0[15]); rm = max3f(rm, p1[15], p1[15]);
            }
#undef ATT_MX
            rm = swap_max(rm);
            if (__builtin_expect(__any(rm > THR), 0)) {
                const float dl = fmaxf(rm, 0.f); mhat += dl; refset = true;
#pragma unroll
                for (int r = 0; r < 16; ++r) { p0[r] -= dl; p1[r] -= dl; }
                const float f = fexp2(-dl);
#pragma unroll
                for (int k = 0; k < 4; ++k) { pw[k].x = scale_pk(pw[k].x, f); pw[k].y = scale_pk(pw[k].y, f); pw[k].z = scale_pk(pw[k].z, f); pw[k].w = scale_pk(pw[k].w, f); }
                if (hi == 0) wsf[r32] = f;
                LDS_WAIT();
#pragma unroll
                for (int r = 0; r < 16; ++r) { const float fr = wsf[crow(r, hi)]; o[0][r] *= fr; o[1][r] *= fr; o[2][r] *= fr; o[3][r] *= fr; osum[r] *= fr; }
                LDS_WAIT();
            }
            ATT_SB();
            u32x4 pn[4];
#define ATT_GAP(i) do { const float e0_ = fexp2((i) < 8 ? p0[2 * ((i) & 7)] : p1[2 * ((i) & 7)]), e1_ = fexp2((i) < 8 ? p0[2 * ((i) & 7) + 1] : p1[2 * ((i) & 7) + 1]); \
                unsigned w_ = cvtpk(e0_, e1_); asm volatile("" : "+v"(w_)); pn[(i) >> 2][(i) & 3] = w_; } while (0)
            if (t > 0) {
#define ATT_V3(ks_) do { vb_l[ks_] = vtr(vb + 12288 + (ks_) * 1024); vb_h[ks_] = vtr(vb + 12288 + (ks_) * 1024 + 512); } while (0)
                ATT_MF(1, 0, vb_l, vb_h); ATT_GAP(0); ATT_SB(); ATT_MF(1, 1, vb_l, vb_h); ATT_GAP(1); ATT_V3(0); ATT_SB(); ATT_MF(1, 2, vb_l, vb_h); ATT_GAP(2); ATT_V3(1); ATT_SB(); ATT_MF(1, 3, vb_l, vb_h); ATT_GAP(3); ATT_V3(2); ATT_SB();
                ATT_MF(2, 0, va_l, va_h); ATT_GAP(4); ATT_GAP(5); ATT_V3(3); ATT_SB();
#undef ATT_V3
                ATT_MF(2, 1, va_l, va_h); ATT_GAP(6); ATT_SB(); ATT_MF(2, 2, va_l, va_h); ATT_GAP(7); ATT_GAP(8); ATT_SB(); ATT_MF(2, 3, va_l, va_h); ATT_GAP(9); ATT_SB();
                ATT_MF(3, 0, vb_l, vb_h); ATT_GAP(10); ATT_GAP(11); ATT_SB(); ATT_MF(3, 1, vb_l, vb_h); ATT_GAP(12); ATT_SB(); ATT_MF(3, 2, vb_l, vb_h); ATT_GAP(13); ATT_GAP(14); ATT_SB(); ATT_MF(3, 3, vb_l, vb_h); ATT_GAP(15); ATT_SB();
            } else {
                ATT_GAP(0); ATT_GAP(1); ATT_GAP(2); ATT_GAP(3); ATT_GAP(4); ATT_GAP(5); ATT_GAP(6); ATT_GAP(7);
                ATT_GAP(8); ATT_GAP(9); ATT_GAP(10); ATT_GAP(11); ATT_GAP(12); ATT_GAP(13); ATT_GAP(14); ATT_GAP(15);
            }
#undef ATT_GAP
#undef ATT_MF
#pragma unroll
            for (int k = 0; k < 4; ++k) pw[k] = pn[k];
        } else {
            pv_plain(o, vbase + vs_prev, pw); { _Pragma("unroll") for (int ks = 0; ks < 4; ++ks) osum = __builtin_amdgcn_mfma_f32_32x32x16_bf16(__builtin_bit_cast(bf16x8, pw[ks]), ones, osum, 0, 0, 0); }
        }
        ks_cur = (ks_cur == 32768) ? 0 : ks_cur + 16384; ks_n2 = (ks_n2 == 32768) ? 0 : ks_n2 + 16384;
        vs_prev = (vs_prev == 49152) ? 0 : vs_prev + 16384; vs_n2 = (vs_n2 == 49152) ? 0 : vs_n2 + 16384;
    }
    if (ntw == NT) { pv_plain(o, vbase + vs_prev, pw); _Pragma("unroll") for (int ks = 0; ks < 4; ++ks) osum = __builtin_amdgcn_mfma_f32_32x32x16_bf16(__builtin_bit_cast(bf16x8, pw[ks]), ones, osum, 0, 0, 0); }
#undef ATT_DMA
#pragma unroll
    for (int r = 0; r < 16; ++r) { const float fr = __builtin_amdgcn_rcpf(osum[r]); o[0][r] *= fr; o[1][r] *= fr; o[2][r] *= fr; o[3][r] *= fr; }
    LAS unsigned* X = (LAS unsigned*)(lds + LDS_X2 + pair * 8192);
    if (s == 0) {
#pragma unroll
        for (int d0 = 0; d0 < 4; ++d0)
#pragma unroll
            for (int rr = 0; rr < 4; ++rr) X[(d0 * 4 + rr) * 64 + lane] = cvtpk(o[d0][8 + 2 * rr], o[d0][8 + 2 * rr + 1]);
    } else {
#pragma unroll
        for (int d0 = 0; d0 < 4; ++d0)
#pragma unroll
            for (int rr = 0; rr < 4; ++rr) X[1024 + (d0 * 4 + rr) * 64 + lane] = cvtpk(o[d0][2 * rr], o[d0][2 * rr + 1]);
    }
    __syncthreads();
    if (has_next) attn_open(nb, nh, nqb, Q, K, V, lds);
    bf16_t* Ob = O + (rowb + q0) * D + h * 128;
    if (s == 0) attn_tail_half<0, true>(o, X + 1024, lam, subg, Ob, lane, r32, hi);
    else attn_tail_half<8, false>(o, X, lam, subg, Ob + (size_t)16 * D, lane, r32, hi);
}
}
__device__ __forceinline__ void phase_attn_flash(const Args& a, const Bufs& B, LAS unsigned char* lds, bf16_t* YOUT, int xmap) {
    const int lane = threadIdx.x & 63;
    const float lam = expf(wave_sum(a.in[10][lane] * a.in[11][lane])) - expf(wave_sum(a.in[12][lane] * a.in[13][lane])) + LAM_INIT;
    const int G = gridDim.x, bx = blockIdx.x;
    if (G == 256) {
        const int x = xmap & 7, j32 = xmap >> 3, half = j32 >> 4, j = j32 & 15;
        { const int bh0 = x * 16 + half; att::attn_open(bh0 >> 3, bh0 & 7, j, B.Q, B.K, B.V, lds); }
        for (int i = 0; i < 8; ++i) { const int bh = x * 16 + 2 * i + half, qb = (i & 1) ? (15 - j) : j, bhn = bh + 2, qbn = (i & 1) ? j : (15 - j);
            att::attn_unit(bh >> 3, bh & 7, qb, B.Q, B.K, B.V, YOUT, lds, lam, a.in[14], i < 7, bhn >> 3, bhn & 7, qbn); }
    } else {
        for (int u = bx; u < BATCH * 8 * 16; u += G) { att::attn_open(u >> 7, (u >> 4) & 7, u & 15, B.Q, B.K, B.V, lds); att::attn_unit(u >> 7, (u >> 4) & 7, u & 15, B.Q, B.K, B.V, YOUT, lds, lam, a.in[14], false, 0, 0, 0); }
    }
}


namespace rnn {
constexpr int XR_STRIDE = 68, TILE_BYTES = 32 * XR_STRIDE * 4 + 32 * 64 * 4  , LDS_TOT = 8 * TILE_BYTES  , LDS_CIN = LDS_TOT + 8192;
struct Consts { bf16x8 bfr[2][2][4]; float ba[2], bx[2], c8sp[2]; };
__device__ __forceinline__ void rnn_setup(const Args& a, int blk, Consts& C) {
    const int lane = threadIdx.x & 63, r32 = lane & 31, hi = lane >> 5, c0 = blk * 64;
#pragma unroll
    for (int g = 0; g < 2; ++g) { const float* W = a.in[g == 0 ? 5 : 7] + (size_t)blk * 4096;
#pragma unroll
        for (int nt = 0; nt < 2; ++nt)
#pragma unroll
            for (int ks = 0; ks < 4; ++ks) { const float* wp = W + (16 * ks + 8 * hi) * 64 + 32 * nt + r32; u32x4 pk;
                pk.x = pk2(-LOG2E * wp[0], -LOG2E * wp[64]); pk.y = pk2(-LOG2E * wp[128], -LOG2E * wp[192]); pk.z = pk2(-LOG2E * wp[256], -LOG2E * wp[320]); pk.w = pk2(-LOG2E * wp[384], -LOG2E * wp[448]);
                C.bfr[g][nt][ks] = __builtin_bit_cast(bf16x8, pk); } }
#pragma unroll
    for (int nt = 0; nt < 2; ++nt) { const int j = c0 + 32 * nt + r32; C.ba[nt] = -LOG2E * a.in[6][j]; C.bx[nt] = -LOG2E * a.in[8][j]; C.c8sp[nt] = 8.0f * log1pf(expf(-a.in[9][j])) * LOG2E; }
}
__device__ __forceinline__ void rnn_item(const Args& a, const Bufs& B, LAS unsigned char* lds, int b, int blk, bf16_t* YOUT, const Consts& C) {
    const int tid = threadIdx.x, lane = tid & 63, r32 = lane & 31, hi = lane >> 5, cg = lane & 7, tr = lane >> 3;
    const int w = __builtin_amdgcn_readfirstlane(tid >> 6), c0 = blk * 64;
    LAS float* XR = (LAS float*)(lds + w * TILE_BYTES);
    LAS float* AT = XR + 32 * XR_STRIDE;
    LAS float* TOT = (LAS float*)(lds + LDS_TOT);
    LAS float* CIN = (LAS float*)(lds + LDS_CIN) + w * 64;
    float carry = 0.f;
    const size_t rowb = (size_t)b * SEQ;
    u32x4 v[7];
#pragma unroll
    for (int k = 0; k < 7; ++k) { const int t = 32 * w + 4 * tr - 3 + k; v[k] = (u32x4){0u, 0u, 0u, 0u}; if (t >= 0) v[k] = *(const u32x4*)(B.UX + (rowb + t) * D + c0 + 8 * cg); }
    for (int it = 0; it < 8; ++it) {
        const int T0 = it * 256 + 32 * w;
        {
            const float* cwp = a.in[3]; const float* cbp = a.in[4];
            asm volatile("" : "+s"(cwp), "+s"(cbp));
            f32x4 w4[4][2], b4[2];
#pragma unroll
            for (int j = 0; j < 4; ++j) { w4[j][0] = *(const f32x4*)(cwp + j * D + c0 + 8 * cg); w4[j][1] = *(const f32x4*)(cwp + j * D + c0 + 8 * cg + 4); }
            b4[0] = *(const f32x4*)(cbp + c0 + 8 * cg); b4[1] = *(const f32x4*)(cbp + c0 + 8 * cg + 4);
#pragma unroll
            for (int i = 0; i < 4; ++i) { f32x4 xo[2] = {b4[0], b4[1]};
#pragma unroll
                for (int j = 0; j < 4; ++j) { const u32x4 q = v[i + j];
                    xo[0].x += w4[j][0].x * bf2f(q.x & 0xffffu); xo[0].y += w4[j][0].y * bf2f(q.x >> 16); xo[0].z += w4[j][0].z * bf2f(q.y & 0xffffu); xo[0].w += w4[j][0].w * bf2f(q.y >> 16);
                    xo[1].x += w4[j][1].x * bf2f(q.z & 0xffffu); xo[1].y += w4[j][1].y * bf2f(q.z >> 16); xo[1].z += w4[j][1].z * bf2f(q.w & 0xffffu); xo[1].w += w4[j][1].w * bf2f(q.w >> 16); }
                LAS f32x4* xp = (LAS f32x4*)(XR + (4 * tr + i) * XR_STRIDE + 8 * cg); xp[0] = xo[0]; xp[1] = xo[1]; }
        }
        if (it < 7) {
#pragma unroll
            for (int k = 0; k < 7; ++k) v[k] = *(const u32x4*)(B.UX + (rowb + T0 + 256 + 4 * tr - 3 + k) * D + c0 + 8 * cg);
        }
        LDS_WAIT();
        f32x16 acc[2][2];
#pragma unroll
        for (int g = 0; g < 2; ++g)
#pragma unroll
            for (int nt = 0; nt < 2; ++nt)
#pragma unroll
                for (int r = 0; r < 16; ++r) acc[g][nt][r] = 0.f;
#pragma unroll
        for (int ks = 0; ks < 4; ++ks) { const LAS f32x4* ap = (const LAS f32x4*)(XR + r32 * XR_STRIDE + 16 * ks + 8 * hi); const f32x4 x0 = ap[0], x1 = ap[1];
            u32x4 pk; pk.x = att::cvtpk(x0.x, x0.y); pk.y = att::cvtpk(x0.z, x0.w); pk.z = att::cvtpk(x1.x, x1.y); pk.w = att::cvtpk(x1.z, x1.w);
            const bf16x8 af = __builtin_bit_cast(bf16x8, pk);
#pragma unroll
            for (int g = 0; g < 2; ++g)
#pragma unroll
                for (int nt = 0; nt < 2; ++nt) acc[g][nt] = __builtin_amdgcn_mfma_f32_32x32x16_bf16(af, C.bfr[g][nt][ks], acc[g][nt], 0, 0, 0); }
#pragma unroll
        for (int nt = 0; nt < 2; ++nt)
#pragma unroll
            for (int r = 0; r < 16; ++r) { const int t = att::crow(r, hi), j = 32 * nt + r32;
                const float rg = __builtin_amdgcn_rcpf(1.0f + fexp2(acc[0][nt][r] + C.ba[nt])), ig = __builtin_amdgcn_rcpf(1.0f + fexp2(acc[1][nt][r] + C.bx[nt]));
                const float av = fexp2(-C.c8sp[nt] * rg);
                const float om = __builtin_fmaf(-av, av, 1.0f);
                const float xr = XR[t * XR_STRIDE + j];
                XR[t * XR_STRIDE + j] = __builtin_amdgcn_sqrtf(om) * ig * xr; AT[t * 64 + j] = av; }
        LDS_WAIT();
        u32x4 gv[4];
#pragma unroll
        for (int i = 0; i < 4; ++i) gv[i] = *(const u32x4*)(B.GG + (rowb + T0 + 4 * tr + i) * D + c0 + 8 * cg);
        { float h = 0.f, pc = 1.f;
#pragma unroll
            for (int tb = 0; tb < 32; tb += 8) { float av[8], uv[8];
#pragma unroll
                for (int t = 0; t < 8; ++t) { av[t] = AT[(tb + t) * 64 + lane]; uv[t] = XR[(tb + t) * XR_STRIDE + lane]; }
#pragma unroll
                for (int t = 0; t < 8; ++t) { h = av[t] * h + uv[t]; pc *= av[t]; uv[t] = h; av[t] = pc; }
#pragma unroll
                for (int t = 0; t < 8; ++t) { XR[(tb + t) * XR_STRIDE + lane] = uv[t]; AT[(tb + t) * 64 + lane] = av[t]; } }
            LAS float* tp = TOT + ((it & 1) * 8 + w) * 128; tp[lane] = pc; tp[64 + lane] = h; }
        __syncthreads();
        { float c = carry, cin = 0.f;
#pragma unroll
            for (int ww = 0; ww < 8; ++ww) { const LAS float* tp = TOT + ((it & 1) * 8 + ww) * 128; if (ww == w) cin = c; c = tp[lane] * c + tp[64 + lane]; }
            carry = c; CIN[lane] = cin; }
        LDS_WAIT();
        { const LAS f32x4* cp = (const LAS f32x4*)(CIN + 8 * cg); const f32x4 c0v = cp[0], c1v = cp[1];
#pragma unroll
            for (int i = 0; i < 4; ++i) { const int row = 4 * tr + i;
                const LAS f32x4* hp = (const LAS f32x4*)(XR + row * XR_STRIDE + 8 * cg); const LAS f32x4* pp = (const LAS f32x4*)(AT + row * 64 + 8 * cg);
                const f32x4 h0 = hp[0], h1 = hp[1], p0 = pp[0], p1 = pp[1];
                const size_t go = (rowb + T0 + row) * D + c0 + 8 * cg; const u32x4 g4 = gv[i];
                u32x4 o;
                o.x = pk2((h0.x + p0.x * c0v.x) * bf2f(g4.x & 0xffffu), (h0.y + p0.y * c0v.y) * bf2f(g4.x >> 16));
                o.y = pk2((h0.z + p0.z * c0v.z) * bf2f(g4.y & 0xffffu), (h0.w + p0.w * c0v.w) * bf2f(g4.y >> 16));
                o.z = pk2((h1.x + p1.x * c1v.x) * bf2f(g4.z & 0xffffu), (h1.y + p1.y * c1v.y) * bf2f(g4.z >> 16));
                o.w = pk2((h1.z + p1.z * c1v.z) * bf2f(g4.w & 0xffffu), (h1.w + p1.w * c1v.w) * bf2f(g4.w >> 16));
                *(u32x4*)(YOUT + go) = o; }
        }
        LDS_WAIT();
    }
}
}
__device__ __forceinline__ int rnn_batch(int xmap) { return 2 * (xmap & 7) + (xmap >> 7); }
__device__ __forceinline__ int rnn_blk(int xmap) { return (xmap >> 3) & 15; }

__device__ __forceinline__ void unpack8(const u32x4& w, f32x4& a, f32x4& b) {
    a = (f32x4){bf2f(w.x & 0xffffu), bf2f(w.x >> 16), bf2f(w.y & 0xffffu), bf2f(w.y >> 16)}; b = (f32x4){bf2f(w.z & 0xffffu), bf2f(w.z >> 16), bf2f(w.w & 0xffffu), bf2f(w.w >> 16)}; }
__device__ __forceinline__ u32x4 pack8(const f32x4& a, const f32x4& b) { u32x4 w; w.x = att::cvtpk(a.x, a.y); w.y = att::cvtpk(a.z, a.w); w.z = att::cvtpk(b.x, b.y); w.w = att::cvtpk(b.z, b.w); return w; }
__device__ __forceinline__ f32x4 unpack_u8(unsigned w) { return (f32x4){(float)(w & 0xffu), (float)((w >> 8) & 0xffu), (float)((w >> 16) & 0xffu), (float)(w >> 24)} * (1.0f / 255.0f); }
__device__ __forceinline__ float gelu_fast(float v) { constexpr float C0 = -2.0f * LOG2E * 0.7978845608028654f, C1 = C0 * 0.044715f; return v * __builtin_amdgcn_rcpf(1.0f + fexp2(v * __builtin_fmaf(v * v, C1, C0))); }
__device__ __forceinline__ float sig255_pre(float acc) { return __builtin_amdgcn_rcpf(__builtin_fmaf(fexp2(acc), 1.0f / 255.0f, 1.0f / 255.0f)); }
__device__ __forceinline__ unsigned pack_sig_u8(const f32x4& g) {
    unsigned w = __builtin_amdgcn_cvt_pk_u8_f32(sig255_pre(g.x), 0u, 0u); w = __builtin_amdgcn_cvt_pk_u8_f32(sig255_pre(g.y), 1u, w); w = __builtin_amdgcn_cvt_pk_u8_f32(sig255_pre(g.z), 2u, w); return __builtin_amdgcn_cvt_pk_u8_f32(sig255_pre(g.w), 3u, w); }
__device__ __forceinline__ f32x4 map_gelu(const f32x4& v) { return (f32x4){gelu_fast(v.x), gelu_fast(v.y), gelu_fast(v.z), gelu_fast(v.w)}; }

__device__ __forceinline__ unsigned dpp_hi(unsigned keep, unsigned src) { return (unsigned)__builtin_amdgcn_update_dpp((int)keep, (int)src, 0x128, 0xF, 0xC, false); }
__device__ __forceinline__ unsigned dpp_lo(unsigned keep, unsigned src) { return (unsigned)__builtin_amdgcn_update_dpp((int)keep, (int)src, 0x128, 0xF, 0x3, false); }
__device__ __forceinline__ void xrow8(u32x4& p0, u32x4& p1) {
    u32x4 a, b;
    a.x = dpp_hi(p0.x, p1.x); a.y = dpp_hi(p0.y, p1.y); a.z = dpp_hi(p0.z, p1.z); a.w = dpp_hi(p0.w, p1.w);
    b.x = dpp_lo(p1.x, p0.x); b.y = dpp_lo(p1.y, p0.y); b.z = dpp_lo(p1.z, p0.z); b.w = dpp_lo(p1.w, p0.w);
    p0 = a; p1 = b;
}
__device__ __forceinline__ void xrow8f(f32x4& a0, f32x4& a1, f32x4& b0, f32x4& b1) {
    u32x4 p = __builtin_bit_cast(u32x4, a0), q = __builtin_bit_cast(u32x4, b0); xrow8(p, q); a0 = __builtin_bit_cast(f32x4, p); b0 = __builtin_bit_cast(f32x4, q);
    p = __builtin_bit_cast(u32x4, a1); q = __builtin_bit_cast(u32x4, b1); xrow8(p, q); a1 = __builtin_bit_cast(f32x4, p); b1 = __builtin_bit_cast(f32x4, q);
}
struct EpiInProj {
    static constexpr bool PERM = true, AFTER_DRAIN = false; Bufs B;
    __device__ __forceinline__ void operator()(const pg8::f32x4 (&acc)[2][2][4][2], const pg8::Unit& u, int wr, int wc, int fr, int fq) const {
        const int seg = u.pn >> 2, tp = u.pn & 3, row0 = u.pm * 256 + wr * 64 + fr;
        const int rowx = u.pm * 256 + wr * 64 + (fr & 7), pc8 = 8 * (4 * (fr >> 3) + fq);
        if (seg == 2 || seg == 3) {
            const float sc = (seg == 2) ? QSCALE : 1.0f;
            const bool hm = (seg == 3);
#pragma unroll
            for (int ai = 0; ai < 2; ++ai)
#pragma unroll
                for (int m = 0; m < 4; ++m) { const int row = row0 + ai * 128 + m * 16, pos = row & (SEQ - 1), rx = rowx + ai * 128 + m * 16;
                    const f32x4* cp = (const f32x4*)(B.ropec + pos * 32 + 8 * fq); const f32x4* sp = (const f32x4*)(B.ropes + pos * 32 + 8 * fq);
                    const f32x4 c0 = cp[0], c1 = cp[1], s0 = sp[0], s1 = sp[1];
                    const f32x4 a0 = acc[ai][0][m][0], a1 = acc[ai][0][m][1], b0 = acc[ai][1][m][0], b1 = acc[ai][1][m][1];
                    const f32x4 o0 = (a0 * c0 - b0 * s0) * sc, o1 = (a1 * c1 - b1 * s1) * sc, p0 = (b0 * c0 + a0 * s0) * sc, p1 = (b1 * c1 + a1 * s1) * sc;
                    u32x4 w0 = pack8(o0, o1), w1 = pack8(p0, p1); xrow8(w0, w1);
                    bf16_t* rp = hm ? B.K + ((size_t)((rx >> 11) * 8 + 2 * tp + (wc >> 1)) * SEQ + (rx & (SEQ - 1))) * 128 + (wc & 1) * 64 + pc8 : B.Q + (size_t)rx * D + (4 * tp + wc) * 64 + pc8;
                    *(u32x4*)rp = w0; *(u32x4*)(rp + (hm ? 8 * 128 : 8 * D)) = w1; }
        } else if (seg >= 5) {
            unsigned char* gb = ((seg == 5) ? B.SR : B.SA) + tp * 256 + wc * 64 + 16 * fq;
#pragma unroll
            for (int ai = 0; ai < 2; ++ai)
#pragma unroll
                for (int m = 0; m < 4; ++m) { unsigned char* rp = gb + (size_t)(row0 + ai * 128 + m * 16) * D;
                    *(u32x4*)rp = (u32x4){pack_sig_u8(acc[ai][0][m][0]), pack_sig_u8(acc[ai][0][m][1]), pack_sig_u8(acc[ai][1][m][0]), pack_sig_u8(acc[ai][1][m][1])}; }
        } else if (seg == 4) {
#pragma unroll
            for (int ai = 0; ai < 2; ++ai)
#pragma unroll
                for (int m = 0; m < 4; ++m) { const int rx = rowx + ai * 128 + m * 16;
                    u32x4 w0 = pack8(acc[ai][0][m][0], acc[ai][0][m][1]), w1 = pack8(acc[ai][1][m][0], acc[ai][1][m][1]); xrow8(w0, w1);
                    bf16_t* rp = B.V + ((size_t)((rx >> 11) * 8 + 2 * tp + (wc >> 1)) * SEQ + (rx & (SEQ - 1))) * 128 + (wc & 1) * 64 + pc8;
                    *(u32x4*)rp = w0; *(u32x4*)(rp + 8 * 128) = w1; }
        } else {
            bf16_t* base = ((seg == 0) ? B.UX : B.GG) + tp * 256 + wc * 64 + pc8;
#pragma unroll
            for (int ai = 0; ai < 2; ++ai)
#pragma unroll
                for (int m = 0; m < 4; ++m) { bf16_t* rp = base + (size_t)(rowx + ai * 128 + m * 16) * D;
                    f32x4 a0 = acc[ai][0][m][0], a1 = acc[ai][0][m][1], b0 = acc[ai][1][m][0], b1 = acc[ai][1][m][1];
                    if (seg == 1) { a0 = map_gelu(a0); a1 = map_gelu(a1); b0 = map_gelu(b0); b1 = map_gelu(b1); }
                    u32x4 w0 = pack8(a0, a1), w1 = pack8(b0, b1); xrow8(w0, w1);
                    *(u32x4*)rp = w0; *(u32x4*)(rp + 8 * D) = w1; }
        }
    }
};
struct EpiBrA {
    static constexpr bool PERM = true, AFTER_DRAIN = false; Bufs B;
    __device__ __forceinline__ void operator()(const pg8::f32x4 (&acc)[2][2][4][2], const pg8::Unit& u, int wr, int wc, int fr, int fq) const {
        const int rowx = u.pm * 256 + wr * 64 + (fr & 7), col0 = u.pn * 256 + wc * 64 + 8 * (4 * (fr >> 3) + fq);
#pragma unroll
        for (int ai = 0; ai < 2; ++ai)
#pragma unroll
            for (int m = 0; m < 4; ++m) { const size_t o = (size_t)(rowx + ai * 128 + m * 16) * D + col0;
                const u32x2 ga = *(const u32x2*)(B.SR + o), gb = *(const u32x2*)(B.SR + o + 8 * D);
                f32x4 a0 = acc[ai][0][m][0], a1 = acc[ai][0][m][1], b0 = acc[ai][1][m][0], b1 = acc[ai][1][m][1]; xrow8f(a0, a1, b0, b1);
                *(u32x4*)(B.T + o) = pack8(unpack_u8(ga.x) * a0, unpack_u8(ga.y) * a1); *(u32x4*)(B.T + o + 8 * D) = pack8(unpack_u8(gb.x) * b0, unpack_u8(gb.y) * b1); }
    }
};
struct EpiBrB {
    static constexpr bool PERM = true, AFTER_DRAIN = false; Bufs B;
    __device__ __forceinline__ void operator()(const pg8::f32x4 (&acc)[2][2][4][2], const pg8::Unit& u, int wr, int wc, int fr, int fq) const {
        const int rowx = u.pm * 256 + wr * 64 + (fr & 7), col0 = u.pn * 256 + wc * 64 + 8 * (4 * (fr >> 3) + fq);
#pragma unroll
        for (int ai = 0; ai < 2; ++ai)
#pragma unroll
            for (int m = 0; m < 4; ++m) { const size_t o = (size_t)(rowx + ai * 128 + m * 16) * D + col0;
                const u32x2 ga = *(const u32x2*)(B.SA + o), gb = *(const u32x2*)(B.SA + o + 8 * D); const u32x4 ta = *(const u32x4*)(B.T + o), tb = *(const u32x4*)(B.T + o + 8 * D);
                f32x4 a0 = acc[ai][0][m][0], a1 = acc[ai][0][m][1], b0 = acc[ai][1][m][0], b1 = acc[ai][1][m][1]; xrow8f(a0, a1, b0, b1);
                f32x4 t0, t1; unpack8(ta, t0, t1); *(u32x4*)(B.MG + o) = pack8(t0 + unpack_u8(ga.x) * a0, t1 + unpack_u8(ga.y) * a1);
                unpack8(tb, t0, t1); *(u32x4*)(B.MG + o + 8 * D) = pack8(t0 + unpack_u8(gb.x) * b0, t1 + unpack_u8(gb.y) * b1); }
    }
};
struct EpiOut {
    static constexpr bool PERM = true, AFTER_DRAIN = false; Bufs B;
    __device__ __forceinline__ void operator()(const pg8::f32x4 (&acc)[2][2][4][2], const pg8::Unit& u, int wr, int wc, int fr, int fq) const {
        const int rowx = u.pm * 256 + wr * 64 + (fr & 7), col0 = u.pn * 256 + wc * 64 + 8 * (4 * (fr >> 3) + fq);
#pragma unroll
        for (int ai = 0; ai < 2; ++ai)
#pragma unroll
            for (int m = 0; m < 4; ++m) { const int row = rowx + ai * 128 + m * 16; const size_t o = (size_t)row * D + col0;
                const f32x4 xa0 = *(const f32x4*)(B.x + o), xa1 = *(const f32x4*)(B.x + o + 4), xb0 = *(const f32x4*)(B.x + o + 8 * D), xb1 = *(const f32x4*)(B.x + o + 8 * D + 4);
                f32x4 a0 = acc[ai][0][m][0], a1 = acc[ai][0][m][1], b0 = acc[ai][1][m][0], b1 = acc[ai][1][m][1]; xrow8f(a0, a1, b0, b1);
                a0 += xa0; a1 += xa1; b0 += xb0; b1 += xb1;
                *(u32x4*)(B.X1B + o) = pack8(a0, a1); *(u32x4*)(B.X1B + o + 8 * D) = pack8(b0, b1);
                float sa = ((a0.x * a0.x + a0.y * a0.y) + (a0.z * a0.z + a0.w * a0.w)) + ((a1.x * a1.x + a1.y * a1.y) + (a1.z * a1.z + a1.w * a1.w));
                float sb = ((b0.x * b0.x + b0.y * b0.y) + (b0.z * b0.z + b0.w * b0.w)) + ((b1.x * b1.x + b1.y * b1.y) + (b1.z * b1.z + b1.w * b1.w));
                sa += __shfl_xor(sa, 8); sb += __shfl_xor(sb, 8); sa += __shfl_xor(sa, 16); sb += __shfl_xor(sb, 16); sa += __shfl_xor(sa, 32); sb += __shfl_xor(sb, 32);
                if (fq == 0) atomicAdd(B.ss1 + row + (fr & 8), (fr & 8) ? sb : sa); }
    }
};
struct EpiMlp1 {
    static constexpr bool PERM = true, AFTER_DRAIN = false; Bufs B;
    __device__ __forceinline__ void operator()(const pg8::f32x4 (&acc)[2][2][4][2], const pg8::Unit& u, int wr, int wc, int fr, int fq) const {
        const int row0 = u.pm * 256 + wr * 64 + (fr & 7), col0 = u.pn * 256 + wc * 64 + 8 * (4 * (fr >> 3) + fq);
        const f32x4 z4 = {0.f, 0.f, 0.f, 0.f};
#pragma unroll
        for (int ai = 0; ai < 2; ++ai)
#pragma unroll
            for (int m = 0; m < 4; ++m) { bf16_t* rp = B.HID + (size_t)(row0 + ai * 128 + m * 16) * DFF + col0;
                const f32x4 a0 = __builtin_elementwise_max(acc[ai][0][m][0], z4), a1 = __builtin_elementwise_max(acc[ai][0][m][1], z4), b0 = __builtin_elementwise_max(acc[ai][1][m][0], z4), b1 = __builtin_elementwise_max(acc[ai][1][m][1], z4);
                u32x4 p0 = pack8(a0 * a0, a1 * a1), p1 = pack8(b0 * b0, b1 * b1); xrow8(p0, p1);
                *(u32x4*)rp = p0; *(u32x4*)(rp + 8 * DFF) = p1; }
    }
};
struct EpiMlp2 {
    static constexpr bool PERM = true, AFTER_DRAIN = false; Bufs B; const float* gfin; unsigned* tmo;
    __device__ __forceinline__ void operator()(pg8::f32x4 (&acc)[2][2][4][2], const pg8::Unit& u, int wr, int wc, int fr, int fq) const {
        const int rowx = u.pm * 256 + wr * 64 + (fr & 7), col0 = u.pn * 256 + wc * 64 + 8 * (4 * (fr >> 3) + fq);
#pragma unroll
        for (int ai = 0; ai < 2; ++ai)
#pragma unroll
            for (int m = 0; m < 4; ++m) { const int row = rowx + ai * 128 + m * 16; const size_t o = (size_t)row * D + col0;
                const float ra = __builtin_amdgcn_rcpf(__hip_atomic_load(B.ss1 + row, __ATOMIC_RELAXED, __HIP_MEMORY_SCOPE_AGENT) * (1.0f / D) + NORM_EPS);
                const float rb = __builtin_amdgcn_rcpf(__hip_atomic_load(B.ss1 + row + 8, __ATOMIC_RELAXED, __HIP_MEMORY_SCOPE_AGENT) * (1.0f / D) + NORM_EPS);
                const u32x4 xa = *(const u32x4*)(B.X1B + o), xb = *(const u32x4*)(B.X1B + o + 8 * D);
                f32x4 &a0 = acc[ai][0][m][0], &a1 = acc[ai][0][m][1], &b0 = acc[ai][1][m][0], &b1 = acc[ai][1][m][1]; xrow8f(a0, a1, b0, b1);
                f32x4 x0, x1; unpack8(xa, x0, x1); a0 = x0 + a0 * ra; a1 = x1 + a1 * ra; unpack8(xb, x0, x1); b0 = x0 + b0 * rb; b1 = x1 + b1 * rb;
                float sa = ((a0.x * a0.x + a0.y * a0.y) + (a0.z * a0.z + a0.w * a0.w)) + ((a1.x * a1.x + a1.y * a1.y) + (a1.z * a1.z + a1.w * a1.w));
                float sb = ((b0.x * b0.x + b0.y * b0.y) + (b0.z * b0.z + b0.w * b0.w)) + ((b1.x * b1.x + b1.y * b1.y) + (b1.z * b1.z + b1.w * b1.w));
                sa += __shfl_xor(sa, 8); sb += __shfl_xor(sb, 8); sa += __shfl_xor(sa, 16); sb += __shfl_xor(sb, 16); sa += __shfl_xor(sa, 32); sb += __shfl_xor(sb, 32);
                if (fq == 0) atomicAdd(B.ss2 + row + (fr & 8), (fr & 8) ? sb : sa); }
        asm volatile("s_waitcnt vmcnt(0)" ::: "memory");
        __syncthreads();
        if (threadIdx.x == 0) { unsigned* c = B.pcnt + u.pm * 16;
            (void)__hip_atomic_fetch_add(c, 1u, __ATOMIC_RELAXED, __HIP_MEMORY_SCOPE_AGENT);
            unsigned sp = 0;
            while (__hip_atomic_load(c, __ATOMIC_RELAXED, __HIP_MEMORY_SCOPE_AGENT) < 4u) { __builtin_amdgcn_s_sleep(1);
                if ((++sp & 255u) == 0u) { if (__hip_atomic_load(tmo, __ATOMIC_RELAXED, __HIP_MEMORY_SCOPE_AGENT)) break; if (sp > (1u << 18)) { atomicAdd(tmo, 1u); break; } } } }
        __syncthreads();
        const f32x4 g0 = *(const f32x4*)(gfin + col0), g1 = *(const f32x4*)(gfin + col0 + 4);
#pragma unroll
        for (int ai = 0; ai < 2; ++ai)
#pragma unroll
            for (int m = 0; m < 4; ++m) { const int row = rowx + ai * 128 + m * 16; const size_t o = (size_t)row * D + col0;
                const float qa = __builtin_amdgcn_rsqf(__hip_atomic_load(B.ss2 + row, __ATOMIC_RELAXED, __HIP_MEMORY_SCOPE_AGENT) * (1.0f / D) + NORM_EPS);
                const float qb = __builtin_amdgcn_rsqf(__hip_atomic_load(B.ss2 + row + 8, __ATOMIC_RELAXED, __HIP_MEMORY_SCOPE_AGENT) * (1.0f / D) + NORM_EPS);
                *(f32x4*)(B.out + o) = acc[ai][0][m][0] * qa * g0; *(f32x4*)(B.out + o + 4) = acc[ai][0][m][1] * qa * g1;
                *(f32x4*)(B.out + o + 8 * D) = acc[ai][1][m][0] * qb * g0; *(f32x4*)(B.out + o + 8 * D + 4) = acc[ai][1][m][1] * qb * g1; }
    }
};
struct ReverseOrder {
    pg8::StaticOrder S; int nM;
    __device__ __forceinline__ bool next(int i, pg8::Unit& u) const { if (!S.next(i, u)) return false; u.pm ^= 15; return true; }
    __device__ __forceinline__ void a_ready(const pg8::Unit&) const {}
    __device__ __forceinline__ void done(const pg8::Unit&) const {}
};
template <class Epi> __device__ __forceinline__ void gemm_run_rev(LAS unsigned char* lds, const bf16_t* A, const bf16_t* Bt, int Mr, int N, int K, const Epi& E, int cu) {
    pg8::Gemm g{A, Bt, Mr, N, K}; ReverseOrder S; S.S.init(Mr, N, (int)gridDim.x, cu); S.nM = Mr / 256;
    pg8::gemm_phase<Epi, ReverseOrder, true, true>(lds, g, S, E);
}
template <class Epi> __device__ __forceinline__ void gemm_run(LAS unsigned char* lds, const bf16_t* A, const bf16_t* Bt, int Mr, int N, int K, const Epi& E, int cu) {
    pg8::Gemm g{A, Bt, Mr, N, K}; pg8::StaticOrder S; S.init(Mr, N, (int)gridDim.x, cu);
    pg8::gemm_phase<Epi, pg8::StaticOrder, true, true>(lds, g, S, E);
}

#define RLX_AGENT __ATOMIC_RELAXED, __HIP_MEMORY_SCOPE_AGENT
#define XB_TMO      128
#define XB_XCNT(j)  (256  + 64 * (j))
#define XB_XSUB(j)  (1280 + 64 * (j))
#define XB_XGEN(j)  (2304 + 64 * (j))
#define XB_TOP      3328
#define XB_TOPGEN   3392
#define XB_EVT      3456
#define XCD_BAR_WORDS 3456
#define XB_SPIN_CAP (1u << 18)

__device__ __forceinline__ unsigned xb_ld(unsigned* p)              { return __hip_atomic_load(p, __ATOMIC_RELAXED, __HIP_MEMORY_SCOPE_AGENT); }
__device__ __forceinline__ unsigned xb_add(unsigned* p, unsigned v) { return __hip_atomic_fetch_add(p, v, __ATOMIC_RELAXED, __HIP_MEMORY_SCOPE_AGENT); }
__device__ __forceinline__ unsigned xb_xcc_id() { return (unsigned)__builtin_amdgcn_s_getreg((3 << 11) | 20) & 0xFu; }
#define XB_SPIN(cond, bar) do { unsigned _sp = 0; while (cond) { __builtin_amdgcn_s_sleep(1); \
    if ((++_sp & 255u) == 0u) { if (xb_ld(&(bar)[XB_TMO])) break; if (_sp > XB_SPIN_CAP) { atomicAdd(&(bar)[XB_TMO], 1u); break; } } } } while (0)

struct XcdBarrier {
    unsigned* bar; unsigned x;
    volatile LAS unsigned* st;
};

__device__ __forceinline__ XcdBarrier xcd_barrier_post(unsigned* bar, volatile LAS unsigned* st) {
    XcdBarrier b; b.bar = bar; b.x = xb_xcc_id(); b.st = st;
    if (threadIdx.x == 0) (void)xb_add(&bar[XB_XCNT(b.x)], 1u);
    return b;
}
__device__ __forceinline__ void xcd_barrier_complete(unsigned* bar, unsigned x, unsigned& nloc, unsigned& nx) {
    const unsigned G = gridDim.x * gridDim.y * gridDim.z;
    unsigned sum, cnt, mine, sp = 0u;
    for (;;) {
        sum = 0u; cnt = 0u; mine = 0u;
#pragma unroll
        for (unsigned j = 0; j < 16; ++j) { const unsigned c = xb_ld(&bar[XB_XCNT(j)]); sum += c; cnt += (c > 0u) ? 1u : 0u; mine = (j == x) ? c : mine; }
        if (sum == G) break;
        __builtin_amdgcn_s_sleep(1);
        if ((++sp & 255u) == 0u) { if (xb_ld(&bar[XB_TMO])) break; if (sp > XB_SPIN_CAP) { atomicAdd(&bar[XB_TMO], 1u); break; } }
    }
    nloc = mine > 0u ? mine : 1u; nx = cnt > 0u ? cnt : 1u;
}

__device__ __forceinline__ void xcd_barrier(const XcdBarrier& b) {
    asm volatile("s_waitcnt vmcnt(0)" ::: "memory");
    __syncthreads();
    if (threadIdx.x == 0) {
        unsigned* bar = b.bar;
        __builtin_amdgcn_s_waitcnt(0);
        unsigned nloc = b.st[0], nx = b.st[1];
        if (nloc == 0u) { xcd_barrier_complete(bar, b.x, nloc, nx); b.st[0] = nloc; b.st[1] = nx; }
        const unsigned old = xb_add(&bar[XB_XSUB(b.x)], 1u);
        const unsigned gen = old / nloc;
        if (old + 1u == (gen + 1u) * nloc) {
            __builtin_amdgcn_fence(__ATOMIC_RELEASE, "agent");
            asm volatile("s_waitcnt vmcnt(0)" ::: "memory");
            const unsigned og = xb_add(&bar[XB_TOP], 1u);
            const unsigned tg = og / nx;
            if (og + 1u == (tg + 1u) * nx) xb_add(&bar[XB_TOPGEN], 1u);
            else XB_SPIN(xb_ld(&bar[XB_TOPGEN]) == tg, bar);
            __builtin_amdgcn_fence(__ATOMIC_ACQUIRE, "agent");
            xb_add(&bar[XB_XGEN(b.x)], 1u);
            asm volatile("s_waitcnt vmcnt(0)" ::: "memory");
        } else {
            XB_SPIN(xb_ld(&bar[XB_XGEN(b.x)]) == gen, bar);
            __builtin_amdgcn_fence(__ATOMIC_ACQUIRE, "agent");
            asm volatile("s_waitcnt vmcnt(0)" ::: "memory");
        }
    }
    __syncthreads();
}

__device__ __forceinline__ void xcd_barrier_local(const XcdBarrier& b, int mode) {
    asm volatile("s_waitcnt vmcnt(0)" ::: "memory");
    __syncthreads();
    if (threadIdx.x == 0) {
        unsigned* bar = b.bar;
        __builtin_amdgcn_s_waitcnt(0);
        unsigned nloc = b.st[0], nx = b.st[1];
        if (nloc == 0u) { xcd_barrier_complete(bar, b.x, nloc, nx); b.st[0] = nloc; b.st[1] = nx; }
        const unsigned old = xb_add(&bar[XB_XSUB(b.x)], 1u);
        const unsigned gen = old / nloc;
        if (old + 1u == (gen + 1u) * nloc) {
            if (mode == 2) XB_SPIN(xb_ld(&bar[XB_EVT]) < nx, bar);
            xb_add(&bar[XB_XGEN(b.x)], 1u);
            if (mode == 1) { __builtin_amdgcn_fence(__ATOMIC_RELEASE, "agent"); asm volatile("s_waitcnt vmcnt(0)" ::: "memory"); xb_add(&bar[XB_EVT], 1u); }
        } else {
            if (mode == 1 && old == gen * nloc) { __builtin_amdgcn_fence(__ATOMIC_RELEASE, "agent"); asm volatile("s_waitcnt vmcnt(0)" ::: "memory"); }
            XB_SPIN(xb_ld(&bar[XB_XGEN(b.x)]) == gen, bar);
        }
        __builtin_amdgcn_fence(__ATOMIC_ACQUIRE, "agent");
        asm volatile("s_waitcnt vmcnt(0)" ::: "memory");
    }
    __syncthreads();
}

constexpr int LDS_BYTES = 155648;
constexpr int LDS_BARW = LDS_BYTES - 64;
constexpr int CW_BAR = 4096, CW_CEN = 8192;
constexpr int N_PHASES = 8;
__global__ void __launch_bounds__(NTHREADS, 2) fwd_kernel(Args a) {
    extern __shared__ __attribute__((aligned(16))) unsigned char lds_raw[];
    LAS unsigned char* lds = (LAS unsigned char*)lds_raw;
    const Bufs B = make_bufs(a);
    const int lo = a.ph_lo, hi = a.ph_hi;
    volatile LAS unsigned* barw = (volatile LAS unsigned*)(lds + LDS_BARW);
    if (threadIdx.x < 4) barw[threadIdx.x] = 0u;
    __syncthreads();
    XcdBarrier bar = xcd_barrier_post((unsigned*)(a.ws + WS_CTL) + CW_BAR, barw);
    unsigned* cen = (unsigned*)(a.ws + WS_CTL) + CW_CEN;
    int my_rank = 0; { unsigned r = 0; if (threadIdx.x == 0) r = atomicAdd(cen + 64 * bar.x, 1u); my_rank = (int)__builtin_amdgcn_readfirstlane(r); }
    if (threadIdx.x == 0) barw[2] = (unsigned)my_rank;
    __syncthreads();
    my_rank = (int)barw[2];
#define IN(k) (lo <= (k) && (k) < hi)
#define SEAM(k) do { if (IN(k) && IN((k) + 1)) xcd_barrier(bar); } while (0)
#define SEAM_X(k, mode) do { if (IN(k) && IN((k) + 1)) { if (xmode) xcd_barrier_local(bar, mode); else xcd_barrier(bar); } } while (0)
    if (IN(0)) { phase_prep(a, B, lds); } SEAM(0);
    int xmap = (int)(blockIdx.x & 7) | ((int)(blockIdx.x >> 3) << 3); bool xmode = false;
    if (hi - lo > 1) {
        int npop = 0, below = 0; bool ok = true;
        for (int q = 0; q < 16; ++q) { const unsigned c = __hip_atomic_load(cen + 64 * q, __ATOMIC_RELAXED, __HIP_MEMORY_SCOPE_AGENT); if (c) { ++npop; ok = ok && (c == 32u); if (q < (int)bar.x) ++below; } }
        if (ok && npop == 8 && gridDim.x == 256 && lo == 0 && hi == N_PHASES) { xmap = below | (my_rank << 3); xmode = true; }
    }
    const int cu = (gridDim.x == 256) ? xmap : (int)blockIdx.x;
    if (IN(1)) { EpiInProj E{B}; gemm_run(lds, B.H, B.Win, M, NIN, D, E, cu); }
    rnn::Consts rc; if (IN(2)) rnn::rnn_setup(a, rnn_blk(xmap), rc);
    SEAM_X(1, 0);
    if (IN(2)) { rnn::rnn_item(a, B, lds, rnn_batch(xmap), rnn_blk(xmap), B.GG, rc); __syncthreads();
        phase_attn_flash(a, B, lds, B.Q, xmap);
    } SEAM_X(2, 0);
    if (IN(3)) { EpiBrA E{B}; gemm_run(lds, B.GG, B.Wbr, M, D, D, E, cu); }
    if (IN(4)) { EpiBrB E{B}; gemm_run(lds, B.Q, B.Wba, M, D, D, E, cu); } SEAM_X(4, 1);
    if (IN(5)) { EpiOut E{B}; gemm_run(lds, B.MG, B.Wout, M, D, D, E, cu); } SEAM_X(5, 2);
    if (IN(6)) { EpiMlp1 E{B}; gemm_run(lds, B.X1B, B.W1, M, DFF, D, E, cu); } SEAM_X(6, 0);
    if (IN(7)) { EpiMlp2 E{B, a.in[21], (unsigned*)(a.ws + WS_CTL) + CW_BAR + XB_TMO}; gemm_run_rev(lds, B.HID, B.W2, M, D, DFF, E, cu); }
#undef SEAM_X
#undef IN
#undef SEAM
}

extern "C" void kernel_launch(void* const* d_in, const int* in_sizes, int n_in, void* d_out, int out_size, void* d_ws, size_t ws_size, hipStream_t stream) {
    static int grid = 0;
    if (grid == 0) {
        if (n_in != 22 || in_sizes[0] != M * D || out_size != M * D || ws_size < WS_END) { fprintf(stderr, "kernel_launch: unexpected shapes (n_in %d, in0 %d, out %d, ws %zu); nothing launched\n", n_in, n_in > 0 ? in_sizes[0] : -1, out_size, ws_size); grid = -1; return; }
        int dev = 0, cus = 0, per_cu = 0;
        if (hipGetDevice(&dev) != hipSuccess || hipDeviceGetAttribute(&cus, hipDeviceAttributeMultiprocessorCount, dev) != hipSuccess) { grid = -1; return; }
        if (hipFuncSetAttribute((const void*)fwd_kernel, hipFuncAttributeMaxDynamicSharedMemorySize, LDS_BYTES) != hipSuccess) { fprintf(stderr, "kernel_launch: hipFuncSetAttribute failed\n"); grid = -1; return; }
        if (hipOccupancyMaxActiveBlocksPerMultiprocessor(&per_cu, (const void*)fwd_kernel, NTHREADS, LDS_BYTES) != hipSuccess || per_cu < 1) { fprintf(stderr, "kernel_launch: occupancy query says %d blocks per CU\n", per_cu); (void)hipGetLastError(); per_cu = 1; }
        if (cus != 256) { fprintf(stderr, "kernel_launch: %d CUs; the static work orders (and the four-workgroup rendezvous of the last phase) are laid out for 256\n", cus); grid = -1; return; }
        grid = cus;
    }
    if (grid < 0) return;
    (void)hipMemsetAsync((char*)d_ws + WS_CTL, 0, CTL_ZERO_BYTES, stream);
    Args a{};
    for (int i = 0; i < 22; ++i) a.in[i] = (const float*)d_in[i];
    a.out = (float*)d_out; a.ws = (unsigned char*)d_ws;
#if MK_N_LAUNCHES == 1
    a.ph_lo = 0; a.ph_hi = N_PHASES;
    hipLaunchKernelGGL(fwd_kernel, dim3(grid), dim3(NTHREADS), LDS_BYTES, stream, a);
#else
    for (int p = 0; p < N_PHASES; ++p) { a.ph_lo = p; a.ph_hi = p + 1; hipLaunchKernelGGL(fwd_kernel, dim3(grid), dim3(NTHREADS), LDS_BYTES, stream, a); }
#endif
}
```

```cpp
#include <hip/hip_runtime.h>
#include <cstdio>
#include <cstdint>

#ifndef MK_N_LAUNCHES
#define MK_N_LAUNCHES 1
#endif

namespace pg8 {
#define PG8_LAS __attribute__((address_space(3)))
typedef unsigned short bf16_t;
typedef short bf16x8 __attribute__((ext_vector_type(8)));
typedef float f32x4 __attribute__((ext_vector_type(4)));
typedef unsigned u32x4 __attribute__((ext_vector_type(4)));
constexpr int BM = 256, BK = 64, HALF = 128, HTB = HALF * BK * 2  , STAGE_BYTES = 8 * HTB, NXCD = 8, WGM = 8;

__host__ __device__ __forceinline__ int lds_byte(int r, int c) { const int st = (r >> 4) * 2 + (c >> 5), rr = r & 15, cc = c & 31, ob = rr * 64 + cc * 2; return st * 1024 + (ob ^ (((ob >> 9) & 1) << 5)); }
__host__ __device__ __forceinline__ void stage_rc(int b, int& R, int& C) { const int st = b / 1024, sb = b % 1024, swz = sb ^ (((sb >> 9) & 1) << 5); R = (st >> 1) * 16 + swz / 64; C = (st & 1) * 32 + (swz % 64) / 2; }
__host__ __device__ __forceinline__ int perm32(int rho) { const int n = rho >> 4, i = rho & 15; return 8 * (i >> 2) + 4 * n + (i & 3); }

struct Unit { int pm, pn; };
struct Gemm { const bf16_t* A; const bf16_t* Bt; int M, N, K; };

struct StaticOrder {
    int nM, nN, nwg, G, c;
    __host__ __device__ __forceinline__ void init(int M, int N, int G_, int c_) { nM = M / BM; nN = N / BM; nwg = nM * nN; G = G_; c = c_; }
    __host__ __device__ __forceinline__ bool next(int i, Unit& u) const {
        const long L = (long)i * G + c; if (L >= nwg) return false;
        int wgid = (int)L; { const int q = nwg / NXCD, r = nwg % NXCD, xcd = wgid % NXCD, off = wgid / NXCD; wgid = (xcd < r ? xcd * (q + 1) : r * (q + 1) + (xcd - r) * q) + off; }
        const int nig = WGM * nN, gid = wgid / nig, fm = gid * WGM, gsz = (nM - fm) < WGM ? (nM - fm) : WGM;
        u.pm = fm + ((wgid % nig) % gsz); u.pn = (wgid % nig) / gsz; return true;
    }
    __device__ __forceinline__ void a_ready(const Unit&) const {}
    __device__ __forceinline__ void done(const Unit&) const {}
};
template <class Epi, class Sched, bool ALIGN_EPI = false, bool SP2 = false>
__device__ __forceinline__ void gemm_phase(PG8_LAS unsigned char* lds, const Gemm g, const Sched& S, const Epi& E) {
    const int tid = threadIdx.x, wid = __builtin_amdgcn_readfirstlane(tid >> 6), lane = tid & 63, wr = wid >> 2, wc = wid & 3, fr = lane & 15, fq = lane >> 4;
    const int K = g.K, nt = K / BK;
    unsigned voffA[2], voffB[2];
#pragma unroll
    for (int i = 0; i < 2; ++i) { int R, C; stage_rc(tid * 16 + i * 8192, R, C); const int Rb = Epi::PERM ? ((R & ~31) + perm32(R & 31)) : R;
        voffA[i] = (unsigned)(R * K + C) * 2u; voffB[i] = (unsigned)(Rb * K + C) * 2u; }
    const size_t kstep = (size_t)(BK * 2);
    const size_t hstep = (size_t)HALF * K * 2;
    const size_t tstep = 2 * hstep;
    const unsigned ldsw = (unsigned)wid * 1024u;
    const int aoff = lds_byte(wr * 64 + fr, fq * 8), boff = lds_byte(wc * 32 + fr, fq * 8);
#define PG8_SA(b, h) (((b) * 2 + (h)) * HTB)
#define PG8_SB(b, h) ((4 + (b) * 2 + (h)) * HTB)
#define PG8_STAGE(bufoff, gbase, voff) do { _Pragma("unroll") for (int _i = 0; _i < 2; ++_i) \
        __builtin_amdgcn_global_load_lds((const unsigned*)((const char*)(gbase) + (voff)[_i]), (PG8_LAS unsigned*)(lds + (bufoff) + ldsw + _i * 8192), 16, 0, 0); } while (0)
#define PG8_LDA(dst, b, h) do { _Pragma("unroll") for (int m = 0; m < 4; ++m) _Pragma("unroll") for (int k = 0; k < 2; ++k) dst[m][k] = *(const PG8_LAS bf16x8*)(lds + PG8_SA(b, h) + aoff + m * 2048 + k * 1024); } while (0)
#define PG8_LDB(dst, b, h) do { _Pragma("unroll") for (int n = 0; n < 2; ++n) _Pragma("unroll") for (int k = 0; k < 2; ++k) dst[n][k] = *(const PG8_LAS bf16x8*)(lds + PG8_SB(b, h) + boff + n * 2048 + k * 1024); } while (0)
#define PG8_MMA(ai, bj, At, Bt) do { __builtin_amdgcn_s_setprio(1); _Pragma("unroll") for (int m = 0; m < 4; ++m) _Pragma("unroll") for (int n = 0; n < 2; ++n) _Pragma("unroll") for (int k = 0; k < 2; ++k) \
        acc[ai][bj][m][n] = __builtin_amdgcn_mfma_f32_16x16x32_bf16(Bt[n][k], At[m][k], acc[ai][bj][m][n], 0, 0, 0); __builtin_amdgcn_s_setprio(0); } while (0)
#define PG8_WAIT_V(n) asm volatile("s_waitcnt vmcnt(" #n ")" ::: "memory")
#define PG8_WAIT_L(n) asm volatile("s_waitcnt lgkmcnt(" #n ")" ::: "memory")
#define PG8_BAR __builtin_amdgcn_s_barrier()
#define PG8_SCHED __builtin_amdgcn_sched_barrier(0)
    Unit cur, nxt; int ui = 0;
    if (!S.next(0, cur)) return;
    f32x4 acc[2][2][4][2];
#pragma unroll
    for (int a = 0; a < 2; ++a)
#pragma unroll
        for (int b = 0; b < 2; ++b)
#pragma unroll
            for (int m = 0; m < 4; ++m)
#pragma unroll
                for (int n = 0; n < 2; ++n) acc[a][b][m][n] = (f32x4){0.f, 0.f, 0.f, 0.f};
    bf16x8 At[4][2], B0[2][2], B1[2][2];
    const char* cA = (const char*)g.A + (size_t)cur.pm * tstep; const char* cB = (const char*)g.Bt + (size_t)cur.pn * tstep;
    S.a_ready(cur);
    if constexpr (SP2) {
        PG8_STAGE(PG8_SB(0, 0), cB, voffB); PG8_STAGE(PG8_SB(0, 1), cB + hstep, voffB); PG8_STAGE(PG8_SA(0, 0), cA, voffA); PG8_STAGE(PG8_SA(0, 1), cA + hstep, voffA);
        if (wr == 1) PG8_BAR;
        PG8_WAIT_V(2); PG8_BAR;
        PG8_STAGE(PG8_SB(1, 0), cB + kstep, voffB); PG8_STAGE(PG8_SA(1, 0), cA + kstep, voffA); PG8_STAGE(PG8_SB(1, 1), cB + hstep + kstep, voffB);
        PG8_WAIT_V(6); PG8_BAR;
    } else {
        PG8_STAGE(PG8_SB(0, 0), cB, voffB); PG8_STAGE(PG8_SA(0, 0), cA, voffA); PG8_STAGE(PG8_SB(0, 1), cB + hstep, voffB); PG8_STAGE(PG8_SA(0, 1), cA + hstep, voffA);
        if (wr == 1) PG8_BAR;
        PG8_WAIT_V(4); PG8_BAR;
        PG8_STAGE(PG8_SB(1, 0), cB + kstep, voffB); PG8_STAGE(PG8_SA(1, 0), cA + kstep, voffA); PG8_STAGE(PG8_SB(1, 1), cB + hstep + kstep, voffB);
        PG8_WAIT_V(6); PG8_BAR;
    }
    for (;;) {
        const bool has_next = S.next(ui + 1, nxt);
        const char* nA = has_next ? (const char*)g.A + (size_t)nxt.pm * tstep : cA; const char* nB = has_next ? (const char*)g.Bt + (size_t)nxt.pn * tstep : cB;
        for (int t = 0; t < nt; t += 2) {
            const bool last = (t == nt - 2);
            const char* a1 = cA + (size_t)(t + 1) * kstep;
            const char* a2 = last ? nA : cA + (size_t)(t + 2) * kstep; const char* b2 = last ? nB : cB + (size_t)(t + 2) * kstep;
            const char* a3 = a2 + kstep; const char* b3 = b2 + kstep;
            if (last && has_next) S.a_ready(nxt);
            if constexpr (SP2) {
            PG8_LDB(B0, 0, 0); PG8_LDB(B1, 0, 1); PG8_SCHED; PG8_LDA(At, 0, 0); PG8_STAGE(PG8_SA(1, 1), a1 + hstep, voffA);
            PG8_WAIT_V(8); PG8_WAIT_L(0); PG8_BAR; PG8_MMA(0, 0, At, B0); PG8_MMA(0, 1, At, B1); PG8_BAR; PG8_SCHED;
            PG8_LDA(At, 0, 1); PG8_STAGE(PG8_SB(0, 0), b2, voffB); PG8_STAGE(PG8_SB(0, 1), b2 + hstep, voffB); PG8_STAGE(PG8_SA(0, 0), a2, voffA);
            PG8_WAIT_V(8); PG8_WAIT_L(0); PG8_BAR; PG8_MMA(1, 0, At, B0); PG8_MMA(1, 1, At, B1); PG8_BAR; PG8_SCHED;
            PG8_LDB(B0, 1, 0); PG8_LDB(B1, 1, 1); PG8_SCHED; PG8_LDA(At, 1, 0); PG8_STAGE(PG8_SA(0, 1), a2 + hstep, voffA);
            PG8_WAIT_V(8); PG8_WAIT_L(0); PG8_BAR; PG8_MMA(0, 0, At, B0); PG8_MMA(0, 1, At, B1); PG8_BAR; PG8_SCHED;
            PG8_LDA(At, 1, 1); PG8_STAGE(PG8_SB(1, 0), b3, voffB); PG8_STAGE(PG8_SB(1, 1), b3 + hstep, voffB); PG8_STAGE(PG8_SA(1, 0), a3, voffA);
            PG8_WAIT_V(8); PG8_WAIT_L(0); PG8_BAR; PG8_MMA(1, 0, At, B0); PG8_MMA(1, 1, At, B1); PG8_BAR; PG8_SCHED;
            } else {
            PG8_LDB(B0, 0, 0); PG8_SCHED; PG8_LDA(At, 0, 0); PG8_STAGE(PG8_SA(1, 1), a1 + hstep, voffA);
            PG8_WAIT_L(8); PG8_BAR; PG8_WAIT_L(0); PG8_MMA(0, 0, At, B0); PG8_BAR; PG8_SCHED;
            PG8_LDB(B1, 0, 1); PG8_STAGE(PG8_SB(0, 0), b2, voffB);
            PG8_BAR; PG8_WAIT_L(0); PG8_MMA(0, 1, At, B1); PG8_BAR;
            PG8_LDA(At, 0, 1); PG8_STAGE(PG8_SA(0, 0), a2, voffA);
            PG8_BAR; PG8_WAIT_L(0); PG8_MMA(1, 0, At, B0); PG8_BAR; PG8_SCHED;
            PG8_STAGE(PG8_SB(0, 1), b2 + hstep, voffB);
            PG8_WAIT_V(6); PG8_BAR; PG8_MMA(1, 1, At, B1); PG8_BAR;
            PG8_LDB(B0, 1, 0); PG8_SCHED; PG8_LDA(At, 1, 0); PG8_STAGE(PG8_SA(0, 1), a2 + hstep, voffA);
            PG8_WAIT_L(8); PG8_BAR; PG8_WAIT_L(0); PG8_MMA(0, 0, At, B0); PG8_BAR; PG8_SCHED;
            PG8_LDB(B1, 1, 1); PG8_STAGE(PG8_SB(1, 0), b3, voffB);
            PG8_BAR; PG8_WAIT_L(0); PG8_MMA(0, 1, At, B1); PG8_BAR;
            PG8_LDA(At, 1, 1); PG8_STAGE(PG8_SA(1, 0), a3, voffA);
            PG8_BAR; PG8_WAIT_L(0); PG8_MMA(1, 0, At, B0); PG8_BAR; PG8_SCHED;
            PG8_STAGE(PG8_SB(1, 1), b3 + hstep, voffB);
            PG8_WAIT_V(6); PG8_BAR; PG8_MMA(1, 1, At, B1); PG8_BAR;
            }
        }
        if constexpr (ALIGN_EPI) { if (wr == 0) PG8_BAR; }
        if constexpr (!Epi::AFTER_DRAIN) { E(acc, cur, wr, wc, fr, fq); S.done(cur); }
        if (!has_next) break;
#pragma unroll
        for (int a = 0; a < 2; ++a)
#pragma unroll
            for (int b = 0; b < 2; ++b)
#pragma unroll
                for (int m = 0; m < 4; ++m)
#pragma unroll
                    for (int n = 0; n < 2; ++n) acc[a][b][m][n] = (f32x4){0.f, 0.f, 0.f, 0.f};
        cur = nxt; cA = nA; cB = nB; ++ui;
        if constexpr (ALIGN_EPI) { if (wr == 1) PG8_BAR; }
    }
    PG8_WAIT_V(0);
    if constexpr (!ALIGN_EPI) { if (wr == 0) PG8_BAR; }
    PG8_BAR;
    if constexpr (Epi::AFTER_DRAIN) { E.fused(acc, cur, wr, wc, fr, fq, lds, wid, lane); S.done(cur); }
#undef PG8_SA
#undef PG8_SB
#undef PG8_STAGE
#undef PG8_LDA
#undef PG8_LDB
#undef PG8_MMA
#undef PG8_WAIT_V
#undef PG8_WAIT_L
#undef PG8_BAR
#undef PG8_SCHED
}
}

constexpr int BATCH = 16, SEQ = 2048, D = 1024, M = BATCH * SEQ, NIN = 7168, DFF = 4096;
constexpr int NWAVES = 8, NTHREADS = 512;
constexpr float NORM_EPS = 1e-6f, SUBLN_EPS = 1e-5f;
constexpr float LOG2E = 1.4426950408889634f;
constexpr float QSCALE = 0.18033688011112042f;
constexpr float LAM_INIT = 0.2f;
constexpr float OUT_SCALE = 1.0f - LAM_INIT;

#define LAS __attribute__((address_space(3)))
typedef unsigned short bf16_t;
typedef short bf16x8 __attribute__((ext_vector_type(8)));
typedef float f32x4 __attribute__((ext_vector_type(4)));
typedef float f32x16 __attribute__((ext_vector_type(16)));
typedef unsigned u32x4 __attribute__((ext_vector_type(4)));
typedef unsigned u32x2 __attribute__((ext_vector_type(2)));

constexpr size_t MiB = 1u << 20;
constexpr size_t WS_CTL = 0, CTL_ZERO_BYTES = 64 * 1024;
constexpr size_t WS_SS1 = 512 * 1024;
constexpr size_t WS_SS2 = 640 * 1024;
constexpr int CW_PANEL = 10240;
constexpr size_t WS_ROPE = 1 * MiB;
constexpr size_t WS_WIN = 2 * MiB, WS_WBR = 16 * MiB, WS_WBA = 18 * MiB, WS_WOUT = 20 * MiB, WS_W1 = 22 * MiB, WS_W2 = 30 * MiB;
constexpr size_t WS_B0 = 48 * MiB, WS_B1 = 112 * MiB, WS_B2 = 176 * MiB, WS_B3 = 240 * MiB, WS_B4 = 304 * MiB, WS_B5 = 368 * MiB, WS_END = 432 * MiB;

struct Args { const float* in[22]; float* out; unsigned char* ws; int ph_lo, ph_hi; };

struct Bufs {
    const float* x; float* out;
    bf16_t *Win, *Wbr, *Wba, *Wout, *W1, *W2;
    bf16_t *H, *UX, *GG, *Q, *K, *V, *MG, *X1B, *HID; unsigned char *SR, *SA;
    float *ss1, *ss2, *ropec, *ropes; bf16_t* T; unsigned* pcnt;
};
__device__ __forceinline__ Bufs make_bufs(const Args& a) {
    Bufs b; unsigned char* ws = a.ws;
    b.x = a.in[0]; b.out = a.out;
    b.Win = (bf16_t*)(ws + WS_WIN); b.Wbr = (bf16_t*)(ws + WS_WBR); b.Wba = (bf16_t*)(ws + WS_WBA); b.Wout = (bf16_t*)(ws + WS_WOUT); b.W1 = (bf16_t*)(ws + WS_W1); b.W2 = (bf16_t*)(ws + WS_W2);
    b.H = (bf16_t*)(ws + WS_B0); b.UX = (bf16_t*)(ws + WS_B1); b.GG = (bf16_t*)(ws + WS_B2); b.Q = (bf16_t*)(ws + WS_B3); b.K = (bf16_t*)(ws + WS_B4); b.V = (bf16_t*)(ws + WS_B5);
    b.SR = (unsigned char*)a.out; b.SA = (unsigned char*)a.out + (size_t)M * D;
    b.MG = (bf16_t*)(ws + WS_B0); b.X1B = (bf16_t*)(ws + WS_B1); b.HID = (bf16_t*)(ws + WS_B2);
    b.T = (bf16_t*)(ws + WS_B4); b.ss1 = (float*)(ws + WS_SS1); b.ss2 = (float*)(ws + WS_SS2); b.pcnt = (unsigned*)(ws + WS_CTL) + CW_PANEL; b.ropec = (float*)(ws + WS_ROPE); b.ropes = b.ropec + 2048 * 32;
    return b;
}

__device__ __forceinline__ unsigned f2bf(float f) { unsigned u = __builtin_bit_cast(unsigned, f); return (u + 0x7fffu + ((u >> 16) & 1u)) >> 16; }
typedef float pk_f32x2_t __attribute__((ext_vector_type(2))); typedef __bf16 pk_bf16x2_t __attribute__((ext_vector_type(2)));
__device__ __forceinline__ unsigned pk2(float lo, float hi) { const pk_f32x2_t v = {lo, hi}; return __builtin_bit_cast(unsigned, __builtin_convertvector(v, pk_bf16x2_t)); }
__device__ __forceinline__ float bf2f(unsigned b) { return __builtin_bit_cast(float, b << 16); }
__device__ __forceinline__ float fexp2(float x) { return __builtin_amdgcn_exp2f(x); }
__device__ __forceinline__ float sigmoid_f(float v) { return 1.0f / (1.0f + fexp2(-v * LOG2E)); }
__device__ __forceinline__ float gelu_tanh_f(float v) { const float y = 0.7978845608028654f * (v + 0.044715f * v * v * v); return v / (1.0f + fexp2(-2.0f * LOG2E * y)); }
__device__ __forceinline__ float wave_sum(float v) {
#pragma unroll
    for (int o = 1; o < 64; o <<= 1) v += __shfl_xor(v, o);
    return v;
}
__device__ __forceinline__ float wave_max(float v) {
#pragma unroll
    for (int o = 1; o < 64; o <<= 1) v = fmaxf(v, __shfl_xor(v, o));
    return v;
}
#define LDS_WAIT() asm volatile("s_waitcnt lgkmcnt(0)" ::: "memory")

__device__ __forceinline__ void transpose_item(const float* W, int K, int N, bf16_t* WT, int item, LAS float* scr, int lane, int permqk, const float* kscale) {
    const int nblk = N / 32, kb = item / nblk, nb = item % nblk, k0 = 64 * kb, n0 = 32 * nb;
    int s0 = n0;
    int cs = 0;
    if (permqk) { const int l = n0 & 255, bj = l >> 7, wc = (l >> 5) & 3; s0 = (n0 & ~255) + 64 * wc + 32 * bj; if (permqk > 1 && n0 >= 5120) { s0 = (n0 & ~255) + 64 * wc + 8 * bj; cs = 1; } }
#pragma unroll
    for (int i = 0; i < 8; ++i) { const int kk = 8 * i + (lane >> 3), c4 = (lane & 7) * 4; f32x4 v = *(const f32x4*)(W + (size_t)(k0 + kk) * N + s0 + (cs ? 16 * (c4 >> 3) + (c4 & 7) : c4));
        if (kscale) v = v * kscale[k0 + kk];
        if (cs) v = v * -LOG2E;
        LAS float* d = scr + kk * 33 + c4; d[0] = v.x; d[1] = v.y; d[2] = v.z; d[3] = v.w; }
    LDS_WAIT();
    const int c = lane & 7;
#pragma unroll
    for (int j = 0; j < 4; ++j) { const int n = (lane >> 3) + 8 * j; const LAS float* s = scr + (8 * c) * 33 + n;
        u32x4 o; o.x = pk2(s[0 * 33], s[1 * 33]); o.y = pk2(s[2 * 33], s[3 * 33]); o.z = pk2(s[4 * 33], s[5 * 33]); o.w = pk2(s[6 * 33], s[7 * 33]);
        *(u32x4*)(WT + (size_t)(n0 + n) * K + k0 + 8 * c) = o; }
    LDS_WAIT();
}
__constant__ double ROPE_INVF[32] = {1.0, 0.7498942093324559, 0.5623413251903491, 0.4216965034285822, 0.31622776601683794, 0.23713737056616552, 0.1778279410038923, 0.1333521432163324, 0.1, 0.07498942093324558,
    0.05623413251903491, 0.042169650342858224, 0.03162277660168379, 0.023713737056616554, 0.01778279410038923, 0.01333521432163324, 0.01, 0.007498942093324558, 0.005623413251903491, 0.004216965034285823,
    0.0031622776601683794, 0.0023713737056616554, 0.0017782794100389228, 0.001333521432163324, 0.001, 0.0007498942093324559, 0.0005623413251903491, 0.00042169650342858224, 0.00031622776601683794,
    0.00023713737056616554, 0.00017782794100389227, 0.0001333521432163324};
__device__ __forceinline__ void sincos_f64(double a, double& s, double& c) {
    const double k = __builtin_rint(a * 6.36619772367581382433e-01);
    double r = a - k * 1.57079632673412561417e+00; r = r - k * 6.07710050650619224932e-11;
    const double z = r * r;
    const double ps = r + r * z * (-1.66666666666666324348e-01 + z * (8.33333333332248946124e-03 + z * (-1.98412698298579493134e-04 + z * (2.75573137070700676789e-06 + z * (-2.50507602534068634195e-08 + z * 1.58969099521155010221e-10)))));
    const double pc = 1.0 - 0.5 * z + z * z * (4.16666666666666019037e-02 + z * (-1.38888888888741095749e-03 + z * (2.48015872894767294178e-05 + z * (-2.75573143513906633035e-07 + z * (2.08757232129817482790e-09 + z * -1.13596475577881948265e-11)))));
    const int q = (int)k & 3;
    s = (q == 0) ? ps : (q == 1) ? pc : (q == 2) ? -ps : -pc;
    c = (q == 0) ? pc : (q == 1) ? -ps : (q == 2) ? -pc : ps;
}
__device__ __forceinline__ void phase_prep(const Args& a, const Bufs& B, LAS unsigned char* lds) {
    const int tid = threadIdx.x, lane = tid & 63, wave = __builtin_amdgcn_readfirstlane(tid >> 6);
    LAS float* scr = (LAS float*)(lds + wave * 16384);
    const int gw = blockIdx.x * NWAVES + wave, NGW = gridDim.x * NWAVES;
    constexpr int I_IN = (D / 64) * (NIN / 32), I_SQ = (D / 64) * (D / 32), I_1 = (D / 64) * (DFF / 32), I_2 = (DFF / 64) * (D / 32);
    constexpr int NITEMS = I_IN + 3 * I_SQ + I_1 + I_2;
    for (int it = gw; it < NITEMS; it += NGW) {
        int r = it;
        if (r < I_IN) { transpose_item(a.in[2], D, NIN, B.Win, r, scr, lane, 2, nullptr); continue; } r -= I_IN;
        if (r < I_SQ) { transpose_item(a.in[15], D, D, B.Wbr, r, scr, lane, 1, nullptr); continue; } r -= I_SQ;
        if (r < I_SQ) { transpose_item(a.in[16], D, D, B.Wba, r, scr, lane, 1, nullptr); continue; } r -= I_SQ;
        if (r < I_SQ) { transpose_item(a.in[17], D, D, B.Wout, r, scr, lane, 1, nullptr); continue; } r -= I_SQ;
        if (r < I_1) { transpose_item(a.in[19], D, DFF, B.W1, r, scr, lane, 1, a.in[18]); continue; } r -= I_1;
        transpose_item(a.in[20], DFF, D, B.W2, r, scr, lane, 1, nullptr);
    }
    const f32x4* g4 = (const f32x4*)a.in[1];
    for (int m = 2 * gw; m < M; m += 2 * NGW) {
        const f32x4* xr = (const f32x4*)(B.x + (size_t)m * D) + lane;
        f32x4 v[2][4]; float s0 = 0.f, s1 = 0.f;
#pragma unroll
        for (int j = 0; j < 4; ++j) { v[0][j] = xr[64 * j]; v[1][j] = xr[256 + 64 * j]; }
#pragma unroll
        for (int j = 0; j < 4; ++j) { s0 += (v[0][j].x * v[0][j].x + v[0][j].y * v[0][j].y) + (v[0][j].z * v[0][j].z + v[0][j].w * v[0][j].w);
                                      s1 += (v[1][j].x * v[1][j].x + v[1][j].y * v[1][j].y) + (v[1][j].z * v[1][j].z + v[1][j].w * v[1][j].w); }
        const float rs0 = 1.0f / sqrtf(wave_sum(s0) * (1.0f / D) + NORM_EPS), rs1 = 1.0f / sqrtf(wave_sum(s1) * (1.0f / D) + NORM_EPS);
        u32x2* o = (u32x2*)(B.H + (size_t)m * D) + lane;
#pragma unroll
        for (int j = 0; j < 4; ++j) { const f32x4 g = g4[lane + 64 * j]; u32x2 w;
            w.x = pk2(v[0][j].x * rs0 * g.x, v[0][j].y * rs0 * g.y); w.y = pk2(v[0][j].z * rs0 * g.z, v[0][j].w * rs0 * g.w); o[64 * j] = w;
            w.x = pk2(v[1][j].x * rs1 * g.x, v[1][j].y * rs1 * g.y); w.y = pk2(v[1][j].z * rs1 * g.z, v[1][j].w * rs1 * g.w); o[256 + 64 * j] = w; }
    }
    for (int i = blockIdx.x * NTHREADS + tid; i < M; i += gridDim.x * NTHREADS) { B.ss1[i] = 0.f; B.ss2[i] = 0.f; }
    for (int idx = blockIdx.x * NTHREADS + tid; idx < 2048 * 32; idx += gridDim.x * NTHREADS) {
        const int pos = idx >> 5, j = idx & 31; double s, c; sincos_f64((double)pos * ROPE_INVF[j], s, c);
        B.ropec[idx] = (float)c; B.ropes[idx] = (float)s;
    }
}

namespace att {
constexpr int KV_STAGE = 32768, LDS_XCH = 2 * KV_STAGE, XCH_PAIR = 17408, LDS_WSF = LDS_XCH + 4 * XCH_PAIR;
constexpr float THR = 8.0f;
typedef short v4i16_t __attribute__((ext_vector_type(4)));
typedef float f32x2_t __attribute__((ext_vector_type(2))); typedef __bf16 bf16x2_t __attribute__((ext_vector_type(2)));
__device__ __forceinline__ float max3f(float a, float b, float c) { float r; asm("v_max3_f32 %0, %1, %2, %3" : "=v"(r) : "v"(a), "v"(b), "v"(c)); return r; }
__device__ __forceinline__ int crow(int r, int hi) { return (r & 3) + 8 * (r >> 2) + 4 * hi; }
__device__ __forceinline__ unsigned cvtpk(float lo, float hi) { f32x2_t v = {lo, hi}; bf16x2_t b = __builtin_convertvector(v, bf16x2_t); return __builtin_bit_cast(unsigned, b); }
__device__ __forceinline__ v4i16_t vtr(const LAS unsigned char* p) { return __builtin_amdgcn_ds_read_tr16_b64_v4i16((LAS v4i16_t*)p); }
__device__ __forceinline__ void swap32(unsigned& a, unsigned& b) { asm volatile("s_nop 1\n\tv_permlane32_swap_b32 %0, %1\n\ts_nop 1" : "+v"(a), "+v"(b)); }
__device__ __forceinline__ float swap_max(float m) { unsigned a = __builtin_bit_cast(unsigned, m), b = a; swap32(a, b); return fmaxf(__builtin_bit_cast(float, a), __builtin_bit_cast(float, b)); }
__device__ __forceinline__ float swap_sum(float m) { unsigned a = __builtin_bit_cast(unsigned, m), b = a; swap32(a, b); return __builtin_bit_cast(float, a) + __builtin_bit_cast(float, b); }

__device__ __forceinline__ void glds16(const void* gsrc, unsigned lds_dst) { unsigned keep;
    asm volatile("s_mov_b32 %0, m0\n\ts_mov_b32 m0, %2\n\ts_nop 0\n\tglobal_load_lds_dwordx4 %1, off\n\ts_mov_b32 m0, %0" : "=&s"(keep) : "v"(gsrc), "s"(lds_dst) : "memory"); }
#define ATT_SB() __builtin_amdgcn_sched_barrier(0)
__device__ __forceinline__ unsigned scale_pk(unsigned w, float f) { return cvtpk(bf2f(w & 0xffffu) * f, bf2f(w >> 16) * f); }
__device__ __forceinline__ void pv_plain(f32x16 (&o)[4], const LAS unsigned char* vb, const u32x4 (&pw)[4]) {
#pragma unroll
    for (int d0 = 0; d0 < 4; ++d0)
#pragma unroll
        for (int ks = 0; ks < 4; ++ks) { const v4i16_t lo = vtr(vb + d0 * 4096 + ks * 1024), hh = vtr(vb + d0 * 4096 + ks * 1024 + 512);
            const bf16x8 vf = {lo[0], lo[1], lo[2], lo[3], hh[0], hh[1], hh[2], hh[3]};
            o[d0] = __builtin_amdgcn_mfma_f32_32x32x16_bf16(__builtin_bit_cast(bf16x8, pw[ks]), vf, o[d0], 0, 0, 0); }
}
constexpr int LDS_K = 0, LDS_V = 49152, LDS_X2 = 114688, LDS_WSF2 = LDS_X2 + 32768;
template <int RB, bool OWN0> __device__ __forceinline__ void attn_tail_half(f32x16 (&o)[4], LAS unsigned* XR, float lam, const float* subg, bf16_t* Orow, int lane, int r32, int hi) {
    float ssq[8];
#pragma unroll
    for (int r = 0; r < 8; ++r) ssq[r] = 0.f;
#pragma unroll
    for (int d0 = 0; d0 < 4; ++d0)
#pragma unroll
        for (int rr = 0; rr < 4; ++rr) { const unsigned w = XR[(d0 * 4 + rr) * 64 + lane]; const float b0 = bf2f(w & 0xffffu), b1 = bf2f(w >> 16);
            const float v0 = OWN0 ? o[d0][RB + 2 * rr] - lam * b0 : b0 - lam * o[d0][RB + 2 * rr], v1 = OWN0 ? o[d0][RB + 2 * rr + 1] - lam * b1 : b1 - lam * o[d0][RB + 2 * rr + 1];
            o[d0][RB + 2 * rr] = v0; o[d0][RB + 2 * rr + 1] = v1; ssq[2 * rr] += v0 * v0; ssq[2 * rr + 1] += v1 * v1; }
#define ATT_DPPF(v, ctrl) __builtin_bit_cast(float, __builtin_amdgcn_update_dpp(0, __builtin_bit_cast(int, v), ctrl, 0xF, 0xF, false))
#pragma unroll
    for (int r = 0; r < 8; ++r) { float v = ssq[r]; v += ATT_DPPF(v, 0xB1); v += ATT_DPPF(v, 0x4E); v += ATT_DPPF(v, 0x124); v += ATT_DPPF(v, 0x128); ssq[r] = v + __shfl_xor(v, 16); }
#undef ATT_DPPF
    float g[4];
#pragma unroll
    for (int d0 = 0; d0 < 4; ++d0) g[d0] = subg[32 * d0 + r32] * OUT_SCALE;
    LAS bf16_t* Xo = (LAS bf16_t*)XR + r32;
#pragma unroll
    for (int r = 0; r < 8; r += 2) {
        const float rn0 = __builtin_amdgcn_rsqf(ssq[r] * (1.0f / 128.0f) + SUBLN_EPS), rn1 = __builtin_amdgcn_rsqf(ssq[r + 1] * (1.0f / 128.0f) + SUBLN_EPS);
        LAS bf16_t* xp = Xo + ((r & 3) + 8 * (r >> 2) + 4 * hi) * 128;
#pragma unroll
        for (int d0 = 0; d0 < 4; ++d0) { const unsigned w = pk2(o[d0][RB + r] * rn0 * g[d0], o[d0][RB + r + 1] * rn1 * g[d0]); xp[32 * d0] = (bf16_t)w; xp[128 + 32 * d0] = (bf16_t)(w >> 16); } }
    LDS_WAIT();
    bf16_t* ob = Orow + (size_t)(lane >> 4) * D + (lane & 15) * 8; const LAS unsigned char* xr = (const LAS unsigned char*)XR + lane * 16;
#pragma unroll
    for (int i = 0; i < 4; ++i) *(u32x4*)(ob + (size_t)(4 * i) * D) = *(const LAS u32x4*)(xr + i * 1024);
}
constexpr int LDS_QS = LDS_V + 32768;
__device__ __forceinline__ void attn_open(int b, int h, int qb, const bf16_t* Q, const bf16_t* K, const bf16_t* V, LAS unsigned char* lds) {
    const int tid = threadIdx.x, lane = tid & 63;
    const int wid = __builtin_amdgcn_readfirstlane(tid >> 6), ch = wid >> 2, s = (wid >> 1) & 1, qh = wid & 1;
    const int q0 = qb * 128 + ch * 64 + qh * 32;
    const size_t hb = ((size_t)(b * 8 + h) * SEQ) * 128;
    const bf16_t* ksrc = K + hb + (8 * ((2 * wid) & 7) + (lane >> 3)) * 128 + (wid >> 2) * 64 + ((lane & 7) ^ (lane >> 3)) * 8;
    const bf16_t* vsrc = V + hb + (32 * (wid & 1) + (lane >> 2)) * 128 + 32 * (wid >> 1) + (lane & 3) * 8;
    const bf16_t* qsrc = Q + ((size_t)b * SEQ + q0 + (lane >> 3)) * D + h * 128 + s * 64 + ((lane & 7) ^ (lane >> 3)) * 8;
    const unsigned ldsb = (unsigned)(uintptr_t)lds;
    const unsigned kdst = (unsigned)__builtin_amdgcn_readfirstlane(ldsb + LDS_K + (wid >> 2) * 8192 + ((2 * wid) & 7) * 1024), vdst = (unsigned)__builtin_amdgcn_readfirstlane(ldsb + LDS_V + (wid >> 1) * 4096 + (2 * (wid & 1)) * 1024);
    const unsigned qdst = (unsigned)__builtin_amdgcn_readfirstlane(ldsb + LDS_QS + wid * 4096);
#pragma unroll
    for (int p = 0; p < 4; ++p) glds16(qsrc + (size_t)(8 * p) * D, qdst + p * 1024);
#pragma unroll
    for (int t = 0; t < 2; ++t) { const size_t o = (size_t)t * 64 * 128;
        glds16(ksrc + o, kdst + t * 16384); glds16(ksrc + o + 8 * 128, kdst + t * 16384 + 1024); glds16(vsrc + o, vdst + t * 16384); glds16(vsrc + o + 16 * 128, vdst + t * 16384 + 1024); }
}
__device__ __forceinline__ void attn_unit(int b, int h, int qb, const bf16_t* Q, const bf16_t* K, const bf16_t* V, bf16_t* O, LAS unsigned char* lds, float lam, const float* subg, bool has_next, int nb, int nh, int nqb) {
    const int tid = threadIdx.x, lane = tid & 63, r32 = lane & 31, hi = lane >> 5;
    const int wid = __builtin_amdgcn_readfirstlane(tid >> 6), ch = wid >> 2, s = (wid >> 1) & 1, qh = wid & 1, pair = ch * 2 + qh;
    const int NT = 2 * qb + 2, ntw = 2 * qb + 1 + ch;
    const size_t rowb = (size_t)b * SEQ;
    const int q0 = qb * 128 + ch * 64 + qh * 32;
    const size_t hb = ((size_t)(b * 8 + h) * SEQ) * 128;
    const bf16_t* ksrc = K + hb + (8 * ((2 * wid) & 7) + (lane >> 3)) * 128 + (wid >> 2) * 64 + ((lane & 7) ^ (lane >> 3)) * 8;
    const bf16_t* vsrc = V + hb + (32 * (wid & 1) + (lane >> 2)) * 128 + 32 * (wid >> 1) + (lane & 3) * 8;
    const unsigned ldsb = (unsigned)(uintptr_t)lds;
    const unsigned kdst = ldsb + LDS_K + (wid >> 2) * 8192 + ((2 * wid) & 7) * 1024, vdst = ldsb + LDS_V + (wid >> 1) * 4096 + (2 * (wid & 1)) * 1024;
#define ATT_DMA(t, ks_, vs_) do { const size_t _o = (size_t)(t) * 64 * 128; \
        glds16(ksrc + _o, (unsigned)__builtin_amdgcn_readfirstlane(kdst + (ks_))); glds16(ksrc + _o + 8 * 128, (unsigned)__builtin_amdgcn_readfirstlane(kdst + (ks_) + 1024)); \
        glds16(vsrc + _o, (unsigned)__builtin_amdgcn_readfirstlane(vdst + (vs_))); glds16(vsrc + _o + 16 * 128, (unsigned)__builtin_amdgcn_readfirstlane(vdst + (vs_) + 1024)); } while (0)
    asm volatile("s_waitcnt vmcnt(8)" ::: "memory");
    bf16x8 qr[4];
    { const LAS unsigned char* qb_ = lds + LDS_QS + wid * 4096 + r32 * 128;
#pragma unroll
      for (int k = 0; k < 4; ++k) qr[k] = *(const LAS bf16x8*)(qb_ + (((2 * k + hi) ^ (r32 & 7)) << 4)); }
    LDS_WAIT();
    f32x16 o[4];
#pragma unroll
    for (int r = 0; r < 16; ++r) { o[0][r] = 0.f; o[1][r] = 0.f; o[2][r] = 0.f; o[3][r] = 0.f; }
    f32x16 osum;
#pragma unroll
    for (int r = 0; r < 16; ++r) osum[r] = 0.f;
    bf16x8 ones; { const short one = (short)0x3F80;
#pragma unroll
        for (int e = 0; e < 8; ++e) ones[e] = one; }
    bool refset = false;
    float mhat = 0.f;
    u32x4 pw[4];
#pragma unroll
    for (int k = 0; k < 4; ++k) pw[k] = (u32x4){0u, 0u, 0u, 0u};
    LAS float* wsf = (LAS float*)(lds + LDS_WSF2) + wid * 64;
    const LAS unsigned char* kbase = lds + LDS_K + s * 8192 + r32 * 128;
    const int kx7 = r32 & 7;
    const LAS unsigned char* vbase = lds + LDS_V + ((lane >> 4) & 1) * 32 + (lane & 3) * 8 + (4 * hi + ((lane & 15) >> 2)) * 64;
    int ks_cur = 0, ks_n2 = 32768;
    int vs_prev = 49152, vs_n2 = 32768;
    for (int t = 0; t < NT; ++t) {
        if (t + 1 < NT) asm volatile("s_waitcnt vmcnt(4)" ::: "memory"); else asm volatile("s_waitcnt vmcnt(0)" ::: "memory");
        __syncthreads();
        if (t + 2 < NT) ATT_DMA(t + 2, ks_n2, vs_n2);
        if (t < ntw) {
            const LAS unsigned char* kb = kbase + ks_cur; const LAS unsigned char* vb = vbase + vs_prev;
            bf16x8 kf[8];
#pragma unroll
            for (int d0 = 0; d0 < 4; ++d0) { const int kx = ((2 * d0 + hi) ^ kx7) << 4; kf[2 * d0] = *(const LAS bf16x8*)(kb + kx); kf[2 * d0 + 1] = *(const LAS bf16x8*)(kb + kx + 4096); }
            ATT_SB();
            v4i16_t va_l[4], va_h[4], vb_l[4], vb_h[4];
#define ATT_VRD(L_, H_, off_, k0_) do { if (t > 0) { L_[k0_] = vtr(vb + (off_) + (k0_) * 1024); H_[k0_] = vtr(vb + (off_) + (k0_) * 1024 + 512); \
                L_[(k0_) + 1] = vtr(vb + (off_) + ((k0_) + 1) * 1024); H_[(k0_) + 1] = vtr(vb + (off_) + ((k0_) + 1) * 1024 + 512); } } while (0)
            f32x16 p0, p1;
            if (!refset) {
                const f32x16 z = {0.f, 0.f, 0.f, 0.f, 0.f, 0.f, 0.f, 0.f, 0.f, 0.f, 0.f, 0.f, 0.f, 0.f, 0.f, 0.f};
                p0 = __builtin_amdgcn_mfma_f32_32x32x16_bf16(kf[0], qr[0], z, 0, 0, 0); p1 = __builtin_amdgcn_mfma_f32_32x32x16_bf16(kf[1], qr[0], z, 0, 0, 0);
            } else { const float nm = -mhat;
#pragma unroll
                for (int r = 0; r < 16; ++r) { p0[r] = nm; p1[r] = nm; }
                p0 = __builtin_amdgcn_mfma_f32_32x32x16_bf16(kf[0], qr[0], p0, 0, 0, 0); p1 = __builtin_amdgcn_mfma_f32_32x32x16_bf16(kf[1], qr[0], p1, 0, 0, 0); }
            ATT_VRD(va_l, va_h, 0, 0); ATT_SB();
            p0 = __builtin_amdgcn_mfma_f32_32x32x16_bf16(kf[2], qr[1], p0, 0, 0, 0); p1 = __builtin_amdgcn_mfma_f32_32x32x16_bf16(kf[3], qr[1], p1, 0, 0, 0); ATT_VRD(va_l, va_h, 0, 2); ATT_SB();
            p0 = __builtin_amdgcn_mfma_f32_32x32x16_bf16(kf[4], qr[2], p0, 0, 0, 0); p1 = __builtin_amdgcn_mfma_f32_32x32x16_bf16(kf[5], qr[2], p1, 0, 0, 0); ATT_VRD(vb_l, vb_h, 4096, 0); ATT_SB();
            p0 = __builtin_amdgcn_mfma_f32_32x32x16_bf16(kf[6], qr[3], p0, 0, 0, 0); p1 = __builtin_amdgcn_mfma_f32_32x32x16_bf16(kf[7], qr[3], p1, 0, 0, 0); ATT_VRD(vb_l, vb_h, 4096, 2); ATT_SB();
#undef ATT_VRD
#define ATT_MF(d0_, ks_, L_, H_) do { const bf16x8 vf_ = {L_[ks_][0], L_[ks_][1], L_[ks_][2], L_[ks_][3], H_[ks_][0], H_[ks_][1], H_[ks_][2], H_[ks_][3]}; \
                o[d0_] = __builtin_amdgcn_mfma_f32_32x32x16_bf16(__builtin_bit_cast(bf16x8, pw[ks_]), vf_, o[d0_], 0, 0, 0); } while (0)
            float rm, rm2;
            if (t > 0) {
#define ATT_V2(ks_) do { va_l[ks_] = vtr(vb + 8192 + (ks_) * 1024); va_h[ks_] = vtr(vb + 8192 + (ks_) * 1024 + 512); } while (0)
#define ATT_OS(ks_) osum = __builtin_amdgcn_mfma_f32_32x32x16_bf16(__builtin_bit_cast(bf16x8, pw[ks_]), ones, osum, 0, 0, 0)
                ATT_MF(0, 0, va_l, va_h); ATT_SB(); ATT_MF(0, 1, va_l, va_h); ATT_V2(0); ATT_SB(); ATT_MF(0, 2, va_l, va_h); ATT_V2(1); ATT_SB(); ATT_MF(0, 3, va_l, va_h); ATT_V2(2); ATT_SB();
#define ATT_MX(r_) do { rm = max3f(rm, p0[r_], p1[r_]); rm2 = max3f(rm2, p0[(r_) + 1], p1[(r_) + 1]); } while (0)
                ATT_OS(0); ATT_V2(3); rm = max3f(p0[0], p1[0], p0[1]); rm2 = max3f(p1[1], p0[2], p1[2]); ATT_MX(3); ATT_SB();
                ATT_OS(1); ATT_MX(5); ATT_MX(7); ATT_SB(); ATT_OS(2); ATT_MX(9); ATT_MX(11); ATT_SB(); ATT_OS(3); ATT_MX(13); rm = max3f(rm, rm2, p0[15]); rm = max3f(rm, p1[15], p1[15]); ATT_SB();
#undef ATT_OS
#undef ATT_V2
            } else {
                rm = max3f(p0[0], p1[0], p0[1]); rm2 = max3f(p1[1], p0[2], p1[2]);
                ATT_MX(3); ATT_MX(5); ATT_MX(7); ATT_MX(9); ATT_MX(11); ATT_MX(13);
                rm = max3f(rm, rm2, p0[15]); rm = max3f(rm, p1[15], p1[15]);
            }
#undef ATT_MX
            rm = swap_max(rm);
            if (__builtin_expect(__any(rm > THR), 0)) {
                const float dl = fmaxf(rm, 0.f); mhat += dl; refset = true;
#pragma unroll
                for (int r = 0; r < 16; ++r) { p0[r] -= dl; p1[r] -= dl; }
                const float f = fexp2(-dl);
#pragma unroll
                for (int k = 0; k < 4; ++k) { pw[k].x = scale_pk(pw[k].x, f); pw[k].y = scale_pk(pw[k].y, f); pw[k].z = scale_pk(pw[k].z, f); pw[k].w = scale_pk(pw[k].w, f); }
                if (hi == 0) wsf[r32] = f;
                LDS_WAIT();
#pragma unroll
                for (int r = 0; r < 16; ++r) { const float fr = wsf[crow(r, hi)]; o[0][r] *= fr; o[1][r] *= fr; o[2][r] *= fr; o[3][r] *= fr; osum[r] *= fr; }
                LDS_WAIT();
            }
            ATT_SB();
            u32x4 pn[4];
#define ATT_GAP(i) do { const float e0_ = fexp2((i) < 8 ? p0[2 * ((i) & 7)] : p1[2 * ((i) & 7)]), e1_ = fexp2((i) < 8 ? p0[2 * ((i) & 7) + 1] : p1[2 * ((i) & 7) + 1]); \
                unsigned w_ = cvtpk(e0_, e1_); asm volatile("" : "+v"(w_)); pn[(i) >> 2][(i) & 3] = w_; } while (0)
            if (t > 0) {
#define ATT_V3(ks_) do { vb_l[ks_] = vtr(vb + 12288 + (ks_) * 1024); vb_h[ks_] = vtr(vb + 12288 + (ks_) * 1024 + 512); } while (0)
                ATT_MF(1, 0, vb_l, vb_h); ATT_GAP(0); ATT_SB(); ATT_MF(1, 1, vb_l, vb_h); ATT_GAP(1); ATT_V3(0); ATT_SB(); ATT_MF(1, 2, vb_l, vb_h); ATT_GAP(2); ATT_V3(1); ATT_SB(); ATT_MF(1, 3, vb_l, vb_h); ATT_GAP(3); ATT_V3(2); ATT_SB();
                ATT_MF(2, 0, va_l, va_h); ATT_GAP(4); ATT_GAP(5); ATT_V3(3); ATT_SB();
#undef ATT_V3
                ATT_MF(2, 1, va_l, va_h); ATT_GAP(6); ATT_SB(); ATT_MF(2, 2, va_l, va_h); ATT_GAP(7); ATT_GAP(8); ATT_SB(); ATT_MF(2, 3, va_l, va_h); ATT_GAP(9); ATT_SB();
                ATT_MF(3, 0, vb_l, vb_h); ATT_GAP(10); ATT_GAP(11); ATT_SB(); ATT_MF(3, 1, vb_l, vb_h); ATT_GAP(12); ATT_SB(); ATT_MF(3, 2, vb_l, vb_h); ATT_GAP(13); ATT_GAP(14); ATT_SB(); ATT_MF(3, 3, vb_l, vb_h); ATT_GAP(15); ATT_SB();
            } else {
                ATT_GAP(0); ATT_GAP(1); ATT_GAP(2); ATT_GAP(3); ATT_GAP(4); ATT_GAP(5); ATT_GAP(6); ATT_GAP(7);
                ATT_GAP(8); ATT_GAP(9); ATT_GAP(10); ATT_GAP(11); ATT_GAP(12); ATT_GAP(13); ATT_GAP(14); ATT_GAP(15);
            }
#undef ATT_GAP
#undef ATT_MF
#pragma unroll
            for (int k = 0; k < 4; ++k) pw[k] = pn[k];
        } else {
            pv_plain(o, vbase + vs_prev, pw); { _Pragma("unroll") for (int ks = 0; ks < 4; ++ks) osum = __builtin_amdgcn_mfma_f32_32x32x16_bf16(__builtin_bit_cast(bf16x8, pw[ks]), ones, osum, 0, 0, 0); }
        }
        ks_cur = (ks_cur == 32768) ? 0 : ks_cur + 16384; ks_n2 = (ks_n2 == 32768) ? 0 : ks_n2 + 16384;
        vs_prev = (vs_prev == 49152) ? 0 : vs_prev + 16384; vs_n2 = (vs_n2 == 49152) ? 0 : vs_n2 + 16384;
    }
    if (ntw == NT) { pv_plain(o, vbase + vs_prev, pw); _Pragma("unroll") for (int ks = 0; ks < 4; ++ks) osum = __builtin_amdgcn_mfma_f32_32x32x16_bf16(__builtin_bit_cast(bf16x8, pw[ks]), ones, osum, 0, 0, 0); }
#undef ATT_DMA
#pragma unroll
    for (int r = 0; r < 16; ++r) { const float fr = __builtin_amdgcn_rcpf(osum[r]); o[0][r] *= fr; o[1][r] *= fr; o[2][r] *= fr; o[3][r] *= fr; }
    LAS unsigned* X = (LAS unsigned*)(lds + LDS_X2 + pair * 8192);
    if (s == 0) {
#pragma unroll
        for (int d0 = 0; d0 < 4; ++d0)
#pragma unroll
            for (int rr = 0; rr < 4; ++rr) X[(d0 * 4 + rr) * 64 + lane] = cvtpk(o[d0][8 + 2 * rr], o[d0][8 + 2 * rr + 1]);
    } else {
#pragma unroll
        for (int d0 = 0; d0 < 4; ++d0)
#pragma unroll
            for (int rr = 0; rr < 4; ++rr) X[1024 + (d0 * 4 + rr) * 64 + lane] = cvtpk(o[d0][2 * rr], o[d0][2 * rr + 1]);
    }
    __syncthreads();
    if (has_next) attn_open(nb, nh, nqb, Q, K, V, lds);
    bf16_t* Ob = O + (rowb + q0) * D + h * 128;
    if (s == 0) attn_tail_half<0, true>(o, X + 1024, lam, subg, Ob, lane, r32, hi);
    else attn_tail_half<8, false>(o, X, lam, subg, Ob + (size_t)16 * D, lane, r32, hi);
}
}
__device__ __forceinline__ void phase_attn_flash(const Args& a, const Bufs& B, LAS unsigned char* lds, bf16_t* YOUT, int xmap) {
    const int lane = threadIdx.x & 63;
    const float lam = expf(wave_sum(a.in[10][lane] * a.in[11][lane])) - expf(wave_sum(a.in[12][lane] * a.in[13][lane])) + LAM_INIT;
    const int G = gridDim.x, bx = blockIdx.x;
    if (G == 256) {
        const int x = xmap & 7, j32 = xmap >> 3, half = j32 >> 4, j = j32 & 15;
        { const int bh0 = x * 16 + half; att::attn_open(bh0 >> 3, bh0 & 7, j, B.Q, B.K, B.V, lds); }
        for (int i = 0; i < 8; ++i) { const int bh = x * 16 + 2 * i + half, qb = (i & 1) ? (15 - j) : j, bhn = bh + 2, qbn = (i & 1) ? j : (15 - j);
            att::attn_unit(bh >> 3, bh & 7, qb, B.Q, B.K, B.V, YOUT, lds, lam, a.in[14], i < 7, bhn >> 3, bhn & 7, qbn); }
    } else {
        for (int u = bx; u < BATCH * 8 * 16; u += G) { att::attn_open(u >> 7, (u >> 4) & 7, u & 15, B.Q, B.K, B.V, lds); att::attn_unit(u >> 7, (u >> 4) & 7, u & 15, B.Q, B.K, B.V, YOUT, lds, lam, a.in[14], false, 0, 0, 0); }
    }
}


namespace rnn {
constexpr int XR_STRIDE = 68, TILE_BYTES = 32 * XR_STRIDE * 4 + 32 * 64 * 4  , LDS_TOT = 8 * TILE_BYTES  , LDS_CIN = LDS_TOT + 8192;
struct Consts { bf16x8 bfr[2][2][4]; float ba[2], bx[2], c8sp[2]; };
__device__ __forceinline__ void rnn_setup(const Args& a, int blk, Consts& C) {
    const int lane = threadIdx.x & 63, r32 = lane & 31, hi = lane >> 5, c0 = blk * 64;
#pragma unroll
    for (int g = 0; g < 2; ++g) { const float* W = a.in[g == 0 ? 5 : 7] + (size_t)blk * 4096;
#pragma unroll
        for (int nt = 0; nt < 2; ++nt)
#pragma unroll
            for (int ks = 0; ks < 4; ++ks) { const float* wp = W + (16 * ks + 8 * hi) * 64 + 32 * nt + r32; u32x4 pk;
                pk.x = pk2(-LOG2E * wp[0], -LOG2E * wp[64]); pk.y = pk2(-LOG2E * wp[128], -LOG2E * wp[192]); pk.z = pk2(-LOG2E * wp[256], -LOG2E * wp[320]); pk.w = pk2(-LOG2E * wp[384], -LOG2E * wp[448]);
                C.bfr[g][nt][ks] = __builtin_bit_cast(bf16x8, pk); } }
#pragma unroll
    for (int nt = 0; nt < 2; ++nt) { const int j = c0 + 32 * nt + r32; C.ba[nt] = -LOG2E * a.in[6][j]; C.bx[nt] = -LOG2E * a.in[8][j]; C.c8sp[nt] = 8.0f * log1pf(expf(-a.in[9][j])) * LOG2E; }
}
__device__ __forceinline__ void rnn_item(const Args& a, const Bufs& B, LAS unsigned char* lds, int b, int blk, bf16_t* YOUT, const Consts& C) {
    const int tid = threadIdx.x, lane = tid & 63, r32 = lane & 31, hi = lane >> 5, cg = lane & 7, tr = lane >> 3;
    const int w = __builtin_amdgcn_readfirstlane(tid >> 6), c0 = blk * 64;
    LAS float* XR = (LAS float*)(lds + w * TILE_BYTES);
    LAS float* AT = XR + 32 * XR_STRIDE;
    LAS float* TOT = (LAS float*)(lds + LDS_TOT);
    LAS float* CIN = (LAS float*)(lds + LDS_CIN) + w * 64;
    float carry = 0.f;
    const size_t rowb = (size_t)b * SEQ;
    u32x4 v[7];
#pragma unroll
    for (int k = 0; k < 7; ++k) { const int t = 32 * w + 4 * tr - 3 + k; v[k] = (u32x4){0u, 0u, 0u, 0u}; if (t >= 0) v[k] = *(const u32x4*)(B.UX + (rowb + t) * D + c0 + 8 * cg); }
    for (int it = 0; it < 8; ++it) {
        const int T0 = it * 256 + 32 * w;
        {
            const float* cwp = a.in[3]; const float* cbp = a.in[4];
            asm volatile("" : "+s"(cwp), "+s"(cbp));
            f32x4 w4[4][2], b4[2];
#pragma unroll
            for (int j = 0; j < 4; ++j) { w4[j][0] = *(const f32x4*)(cwp + j * D + c0 + 8 * cg); w4[j][1] = *(const f32x4*)(cwp + j * D + c0 + 8 * cg + 4); }
            b4[0] = *(const f32x4*)(cbp + c0 + 8 * cg); b4[1] = *(const f32x4*)(cbp + c0 + 8 * cg + 4);
#pragma unroll
            for (int i = 0; i < 4; ++i) { f32x4 xo[2] = {b4[0], b4[1]};
#pragma unroll
                for (int j = 0; j < 4; ++j) { const u32x4 q = v[i + j];
                    xo[0].x += w4[j][0].x * bf2f(q.x & 0xffffu); xo[0].y += w4[j][0].y * bf2f(q.x >> 16); xo[0].z += w4[j][0].z * bf2f(q.y & 0xffffu); xo[0].w += w4[j][0].w * bf2f(q.y >> 16);
                    xo[1].x += w4[j][1].x * bf2f(q.z & 0xffffu); xo[1].y += w4[j][1].y * bf2f(q.z >> 16); xo[1].z += w4[j][1].z * bf2f(q.w & 0xffffu); xo[1].w += w4[j][1].w * bf2f(q.w >> 16); }
                LAS f32x4* xp = (LAS f32x4*)(XR + (4 * tr + i) * XR_STRIDE + 8 * cg); xp[0] = xo[0]; xp[1] = xo[1]; }
        }
        if (it < 7) {
#pragma unroll
            for (int k = 0; k < 7; ++k) v[k] = *(const u32x4*)(B.UX + (rowb + T0 + 256 + 4 * tr - 3 + k) * D + c0 + 8 * cg);
        }
        LDS_WAIT();
        f32x16 acc[2][2];
#pragma unroll
        for (int g = 0; g < 2; ++g)
#pragma unroll
            for (int nt = 0; nt < 2; ++nt)
#pragma unroll
                for (int r = 0; r < 16; ++r) acc[g][nt][r] = 0.f;
#pragma unroll
        for (int ks = 0; ks < 4; ++ks) { const LAS f32x4* ap = (const LAS f32x4*)(XR + r32 * XR_STRIDE + 16 * ks + 8 * hi); const f32x4 x0 = ap[0], x1 = ap[1];
            u32x4 pk; pk.x = att::cvtpk(x0.x, x0.y); pk.y = att::cvtpk(x0.z, x0.w); pk.z = att::cvtpk(x1.x, x1.y); pk.w = att::cvtpk(x1.z, x1.w);
            const bf16x8 af = __builtin_bit_cast(bf16x8, pk);
#pragma unroll
            for (int g = 0; g < 2; ++g)
#pragma unroll
                for (int nt = 0; nt < 2; ++nt) acc[g][nt] = __builtin_amdgcn_mfma_f32_32x32x16_bf16(af, C.bfr[g][nt][ks], acc[g][nt], 0, 0, 0); }
#pragma unroll
        for (int nt = 0; nt < 2; ++nt)
#pragma unroll
            for (int r = 0; r < 16; ++r) { const int t = att::crow(r, hi), j = 32 * nt + r32;
                const float rg = __builtin_amdgcn_rcpf(1.0f + fexp2(acc[0][nt][r] + C.ba[nt])), ig = __builtin_amdgcn_rcpf(1.0f + fexp2(acc[1][nt][r] + C.bx[nt]));
                const float av = fexp2(-C.c8sp[nt] * rg);
                const float om = __builtin_fmaf(-av, av, 1.0f);
                const float xr = XR[t * XR_STRIDE + j];
                XR[t * XR_STRIDE + j] = __builtin_amdgcn_sqrtf(om) * ig * xr; AT[t * 64 + j] = av; }
        LDS_WAIT();
        u32x4 gv[4];
#pragma unroll
        for (int i = 0; i < 4; ++i) gv[i] = *(const u32x4*)(B.GG + (rowb + T0 + 4 * tr + i) * D + c0 + 8 * cg);
        { float h = 0.f, pc = 1.f;
#pragma unroll
            for (int tb = 0; tb < 32; tb += 8) { float av[8], uv[8];
#pragma unroll
                for (int t = 0; t < 8; ++t) { av[t] = AT[(tb + t) * 64 + lane]; uv[t] = XR[(tb + t) * XR_STRIDE + lane]; }
#pragma unroll
                for (int t = 0; t < 8; ++t) { h = av[t] * h + uv[t]; pc *= av[t]; uv[t] = h; av[t] = pc; }
#pragma unroll
                for (int t = 0; t < 8; ++t) { XR[(tb + t) * XR_STRIDE + lane] = uv[t]; AT[(tb + t) * 64 + lane] = av[t]; } }
            LAS float* tp = TOT + ((it & 1) * 8 + w) * 128; tp[lane] = pc; tp[64 + lane] = h; }
        __syncthreads();
        { float c = carry, cin = 0.f;
#pragma unroll
            for (int ww = 0; ww < 8; ++ww) { const LAS float* tp = TOT + ((it & 1) * 8 + ww) * 128; if (ww == w) cin = c; c = tp[lane] * c + tp[64 + lane]; }
            carry = c; CIN[lane] = cin; }
        LDS_WAIT();
        { const LAS f32x4* cp = (const LAS f32x4*)(CIN + 8 * cg); const f32x4 c0v = cp[0], c1v = cp[1];
#pragma unroll
            for (int i = 0; i < 4; ++i) { const int row = 4 * tr + i;
                const LAS f32x4* hp = (const LAS f32x4*)(XR + row * XR_STRIDE + 8 * cg); const LAS f32x4* pp = (const LAS f32x4*)(AT + row * 64 + 8 * cg);
                const f32x4 h0 = hp[0], h1 = hp[1], p0 = pp[0], p1 = pp[1];
                const size_t go = (rowb + T0 + row) * D + c0 + 8 * cg; const u32x4 g4 = gv[i];
                u32x4 o;
                o.x = pk2((h0.x + p0.x * c0v.x) * bf2f(g4.x & 0xffffu), (h0.y + p0.y * c0v.y) * bf2f(g4.x >> 16));
                o.y = pk2((h0.z + p0.z * c0v.z) * bf2f(g4.y & 0xffffu), (h0.w + p0.w * c0v.w) * bf2f(g4.y >> 16));
                o.z = pk2((h1.x + p1.x * c1v.x) * bf2f(g4.z & 0xffffu), (h1.y + p1.y * c1v.y) * bf2f(g4.z >> 16));
                o.w = pk2((h1.z + p1.z * c1v.z) * bf2f(g4.w & 0xffffu), (h1.w + p1.w * c1v.w) * bf2f(g4.w >> 16));
                *(u32x4*)(YOUT + go) = o; }
        }
        LDS_WAIT();
    }
}
}
__device__ __forceinline__ int rnn_batch(int xmap) { return 2 * (xmap & 7) + (xmap >> 7); }
__device__ __forceinline__ int rnn_blk(int xmap) { return (xmap >> 3) & 15; }

__device__ __forceinline__ void unpack8(const u32x4& w, f32x4& a, f32x4& b) {
    a = (f32x4){bf2f(w.x & 0xffffu), bf2f(w.x >> 16), bf2f(w.y & 0xffffu), bf2f(w.y >> 16)}; b = (f32x4){bf2f(w.z & 0xffffu), bf2f(w.z >> 16), bf2f(w.w & 0xffffu), bf2f(w.w >> 16)}; }
__device__ __forceinline__ u32x4 pack8(const f32x4& a, const f32x4& b) { u32x4 w; w.x = att::cvtpk(a.x, a.y); w.y = att::cvtpk(a.z, a.w); w.z = att::cvtpk(b.x, b.y); w.w = att::cvtpk(b.z, b.w); return w; }
__device__ __forceinline__ f32x4 unpack_u8(unsigned w) { return (f32x4){(float)(w & 0xffu), (float)((w >> 8) & 0xffu), (float)((w >> 16) & 0xffu), (float)(w >> 24)} * (1.0f / 255.0f); }
__device__ __forceinline__ float gelu_fast(float v) { constexpr float C0 = -2.0f * LOG2E * 0.7978845608028654f, C1 = C0 * 0.044715f; return v * __builtin_amdgcn_rcpf(1.0f + fexp2(v * __builtin_fmaf(v * v, C1, C0))); }
__device__ __forceinline__ float sig255_pre(float acc) { return __builtin_amdgcn_rcpf(__builtin_fmaf(fexp2(acc), 1.0f / 255.0f, 1.0f / 255.0f)); }
__device__ __forceinline__ unsigned pack_sig_u8(const f32x4& g) {
    unsigned w = __builtin_amdgcn_cvt_pk_u8_f32(sig255_pre(g.x), 0u, 0u); w = __builtin_amdgcn_cvt_pk_u8_f32(sig255_pre(g.y), 1u, w); w = __builtin_amdgcn_cvt_pk_u8_f32(sig255_pre(g.z), 2u, w); return __builtin_amdgcn_cvt_pk_u8_f32(sig255_pre(g.w), 3u, w); }
__device__ __forceinline__ f32x4 map_gelu(const f32x4& v) { return (f32x4){gelu_fast(v.x), gelu_fast(v.y), gelu_fast(v.z), gelu_fast(v.w)}; }

__device__ __forceinline__ unsigned dpp_hi(unsigned keep, unsigned src) { return (unsigned)__builtin_amdgcn_update_dpp((int)keep, (int)src, 0x128, 0xF, 0xC, false); }
__device__ __forceinline__ unsigned dpp_lo(unsigned keep, unsigned src) { return (unsigned)__builtin_amdgcn_update_dpp((int)keep, (int)src, 0x128, 0xF, 0x3, false); }
__device__ __forceinline__ void xrow8(u32x4& p0, u32x4& p1) {
    u32x4 a, b;
    a.x = dpp_hi(p0.x, p1.x); a.y = dpp_hi(p0.y, p1.y); a.z = dpp_hi(p0.z, p1.z); a.w = dpp_hi(p0.w, p1.w);
    b.x = dpp_lo(p1.x, p0.x); b.y = dpp_lo(p1.y, p0.y); b.z = dpp_lo(p1.z, p0.z); b.w = dpp_lo(p1.w, p0.w);
    p0 = a; p1 = b;
}
__device__ __forceinline__ void xrow8f(f32x4& a0, f32x4& a1, f32x4& b0, f32x4& b1) {
    u32x4 p = __builtin_bit_cast(u32x4, a0), q = __builtin_bit_cast(u32x4, b0); xrow8(p, q); a0 = __builtin_bit_cast(f32x4, p); b0 = __builtin_bit_cast(f32x4, q);
    p = __builtin_bit_cast(u32x4, a1); q = __builtin_bit_cast(u32x4, b1); xrow8(p, q); a1 = __builtin_bit_cast(f32x4, p); b1 = __builtin_bit_cast(f32x4, q);
}
struct EpiInProj {
    static constexpr bool PERM = true, AFTER_DRAIN = false; Bufs B;
    __device__ __forceinline__ void operator()(const pg8::f32x4 (&acc)[2][2][4][2], const pg8::Unit& u, int wr, int wc, int fr, int fq) const {
        const int seg = u.pn >> 2, tp = u.pn & 3, row0 = u.pm * 256 + wr * 64 + fr;
        const int rowx = u.pm * 256 + wr * 64 + (fr & 7), pc8 = 8 * (4 * (fr >> 3) + fq);
        if (seg == 2 || seg == 3) {
            const float sc = (seg == 2) ? QSCALE : 1.0f;
            const bool hm = (seg == 3);
#pragma unroll
            for (int ai = 0; ai < 2; ++ai)
#pragma unroll
                for (int m = 0; m < 4; ++m) { const int row = row0 + ai * 128 + m * 16, pos = row & (SEQ - 1), rx = rowx + ai * 128 + m * 16;
                    const f32x4* cp = (const f32x4*)(B.ropec + pos * 32 + 8 * fq); const f32x4* sp = (const f32x4*)(B.ropes + pos * 32 + 8 * fq);
                    const f32x4 c0 = cp[0], c1 = cp[1], s0 = sp[0], s1 = sp[1];
                    const f32x4 a0 = acc[ai][0][m][0], a1 = acc[ai][0][m][1], b0 = acc[ai][1][m][0], b1 = acc[ai][1][m][1];
                    const f32x4 o0 = (a0 * c0 - b0 * s0) * sc, o1 = (a1 * c1 - b1 * s1) * sc, p0 = (b0 * c0 + a0 * s0) * sc, p1 = (b1 * c1 + a1 * s1) * sc;
                    u32x4 w0 = pack8(o0, o1), w1 = pack8(p0, p1); xrow8(w0, w1);
                    bf16_t* rp = hm ? B.K + ((size_t)((rx >> 11) * 8 + 2 * tp + (wc >> 1)) * SEQ + (rx & (SEQ - 1))) * 128 + (wc & 1) * 64 + pc8 : B.Q + (size_t)rx * D + (4 * tp + wc) * 64 + pc8;
                    *(u32x4*)rp = w0; *(u32x4*)(rp + (hm ? 8 * 128 : 8 * D)) = w1; }
        } else if (seg >= 5) {
            unsigned char* gb = ((seg == 5) ? B.SR : B.SA) + tp * 256 + wc * 64 + 16 * fq;
#pragma unroll
            for (int ai = 0; ai < 2; ++ai)
#pragma unroll
                for (int m = 0; m < 4; ++m) { unsigned char* rp = gb + (size_t)(row0 + ai * 128 + m * 16) * D;
                    *(u32x4*)rp = (u32x4){pack_sig_u8(acc[ai][0][m][0]), pack_sig_u8(acc[ai][0][m][1]), pack_sig_u8(acc[ai][1][m][0]), pack_sig_u8(acc[ai][1][m][1])}; }
        } else if (seg == 4) {
#pragma unroll
            for (int ai = 0; ai < 2; ++ai)
#pragma unroll
                for (int m = 0; m < 4; ++m) { const int rx = rowx + ai * 128 + m * 16;
                    u32x4 w0 = pack8(acc[ai][0][m][0], acc[ai][0][m][1]), w1 = pack8(acc[ai][1][m][0], acc[ai][1][m][1]); xrow8(w0, w1);
                    bf16_t* rp = B.V + ((size_t)((rx >> 11) * 8 + 2 * tp + (wc >> 1)) * SEQ + (rx & (SEQ - 1))) * 128 + (wc & 1) * 64 + pc8;
                    *(u32x4*)rp = w0; *(u32x4*)(rp + 8 * 128) = w1; }
        } else {
            bf16_t* base = ((seg == 0) ? B.UX : B.GG) + tp * 256 + wc * 64 + pc8;
#pragma unroll
            for (int ai = 0; ai < 2; ++ai)
#pragma unroll
                for (int m = 0; m < 4; ++m) { bf16_t* rp = base + (size_t)(rowx + ai * 128 + m * 16) * D;
                    f32x4 a0 = acc[ai][0][m][0], a1 = acc[ai][0][m][1], b0 = acc[ai][1][m][0], b1 = acc[ai][1][m][1];
                    if (seg == 1) { a0 = map_gelu(a0); a1 = map_gelu(a1); b0 = map_gelu(b0); b1 = map_gelu(b1); }
                    u32x4 w0 = pack8(a0, a1), w1 = pack8(b0, b1); xrow8(w0, w1);
                    *(u32x4*)rp = w0; *(u32x4*)(rp + 8 * D) = w1; }
        }
    }
};
struct EpiBrA {
    static constexpr bool PERM = true, AFTER_DRAIN = false; Bufs B;
    __device__ __forceinline__ void operator()(const pg8::f32x4 (&acc)[2][2][4][2], const pg8::Unit& u, int wr, int wc, int fr, int fq) const {
        const int rowx = u.pm * 256 + wr * 64 + (fr & 7), col0 = u.pn * 256 + wc * 64 + 8 * (4 * (fr >> 3) + fq);
#pragma unroll
        for (int ai = 0; ai < 2; ++ai)
#pragma unroll
            for (int m = 0; m < 4; ++m) { const size_t o = (size_t)(rowx + ai * 128 + m * 16) * D + col0;
                const u32x2 ga = *(const u32x2*)(B.SR + o), gb = *(const u32x2*)(B.SR + o + 8 * D);
                f32x4 a0 = acc[ai][0][m][0], a1 = acc[ai][0][m][1], b0 = acc[ai][1][m][0], b1 = acc[ai][1][m][1]; xrow8f(a0, a1, b0, b1);
                *(u32x4*)(B.T + o) = pack8(unpack_u8(ga.x) * a0, unpack_u8(ga.y) * a1); *(u32x4*)(B.T + o + 8 * D) = pack8(unpack_u8(gb.x) * b0, unpack_u8(gb.y) * b1); }
    }
};
struct EpiBrB {
    static constexpr bool PERM = true, AFTER_DRAIN = false; Bufs B;
    __device__ __forceinline__ void operator()(const pg8::f32x4 (&acc)[2][2][4][2], const pg8::Unit& u, int wr, int wc, int fr, int fq) const {
        const int rowx = u.pm * 256 + wr * 64 + (fr & 7), col0 = u.pn * 256 + wc * 64 + 8 * (4 * (fr >> 3) + fq);
#pragma unroll
        for (int ai = 0; ai < 2; ++ai)
#pragma unroll
            for (int m = 0; m < 4; ++m) { const size_t o = (size_t)(rowx + ai * 128 + m * 16) * D + col0;
                const u32x2 ga = *(const u32x2*)(B.SA + o), gb = *(const u32x2*)(B.SA + o + 8 * D); const u32x4 ta = *(const u32x4*)(B.T + o), tb = *(const u32x4*)(B.T + o + 8 * D);
                f32x4 a0 = acc[ai][0][m][0], a1 = acc[ai][0][m][1], b0 = acc[ai][1][m][0], b1 = acc[ai][1][m][1]; xrow8f(a0, a1, b0, b1);
                f32x4 t0, t1; unpack8(ta, t0, t1); *(u32x4*)(B.MG + o) = pack8(t0 + unpack_u8(ga.x) * a0, t1 + unpack_u8(ga.y) * a1);
                unpack8(tb, t0, t1); *(u32x4*)(B.MG + o + 8 * D) = pack8(t0 + unpack_u8(gb.x) * b0, t1 + unpack_u8(gb.y) * b1); }
    }
};
struct EpiOut {
    static constexpr bool PERM = true, AFTER_DRAIN = false; Bufs B;
    __device__ __forceinline__ void operator()(const pg8::f32x4 (&acc)[2][2][4][2], const pg8::Unit& u, int wr, int wc, int fr, int fq) const {
        const int rowx = u.pm * 256 + wr * 64 + (fr & 7), col0 = u.pn * 256 + wc * 64 + 8 * (4 * (fr >> 3) + fq);
#pragma unroll
        for (int ai = 0; ai < 2; ++ai)
#pragma unroll
            for (int m = 0; m < 4; ++m) { const int row = rowx + ai * 128 + m * 16; const size_t o = (size_t)row * D + col0;
                const f32x4 xa0 = *(const f32x4*)(B.x + o), xa1 = *(const f32x4*)(B.x + o + 4), xb0 = *(const f32x4*)(B.x + o + 8 * D), xb1 = *(const f32x4*)(B.x + o + 8 * D + 4);
                f32x4 a0 = acc[ai][0][m][0], a1 = acc[ai][0][m][1], b0 = acc[ai][1][m][0], b1 = acc[ai][1][m][1]; xrow8f(a0, a1, b0, b1);
                a0 += xa0; a1 += xa1; b0 += xb0; b1 += xb1;
                *(u32x4*)(B.X1B + o) = pack8(a0, a1); *(u32x4*)(B.X1B + o + 8 * D) = pack8(b0, b1);
                float sa = ((a0.x * a0.x + a0.y * a0.y) + (a0.z * a0.z + a0.w * a0.w)) + ((a1.x * a1.x + a1.y * a1.y) + (a1.z * a1.z + a1.w * a1.w));
                float sb = ((b0.x * b0.x + b0.y * b0.y) + (b0.z * b0.z + b0.w * b0.w)) + ((b1.x * b1.x + b1.y * b1.y) + (b1.z * b1.z + b1.w * b1.w));
                sa += __shfl_xor(sa, 8); sb += __shfl_xor(sb, 8); sa += __shfl_xor(sa, 16); sb += __shfl_xor(sb, 16); sa += __shfl_xor(sa, 32); sb += __shfl_xor(sb, 32);
                if (fq == 0) atomicAdd(B.ss1 + row + (fr & 8), (fr & 8) ? sb : sa); }
    }
};
struct EpiMlp1 {
    static constexpr bool PERM = true, AFTER_DRAIN = false; Bufs B;
    __device__ __forceinline__ void operator()(const pg8::f32x4 (&acc)[2][2][4][2], const pg8::Unit& u, int wr, int wc, int fr, int fq) const {
        const int row0 = u.pm * 256 + wr * 64 + (fr & 7), col0 = u.pn * 256 + wc * 64 + 8 * (4 * (fr >> 3) + fq);
        const f32x4 z4 = {0.f, 0.f, 0.f, 0.f};
#pragma unroll
        for (int ai = 0; ai < 2; ++ai)
#pragma unroll
            for (int m = 0; m < 4; ++m) { bf16_t* rp = B.HID + (size_t)(row0 + ai * 128 + m * 16) * DFF + col0;
                const f32x4 a0 = __builtin_elementwise_max(acc[ai][0][m][0], z4), a1 = __builtin_elementwise_max(acc[ai][0][m][1], z4), b0 = __builtin_elementwise_max(acc[ai][1][m][0], z4), b1 = __builtin_elementwise_max(acc[ai][1][m][1], z4);
                u32x4 p0 = pack8(a0 * a0, a1 * a1), p1 = pack8(b0 * b0, b1 * b1); xrow8(p0, p1);
                *(u32x4*)rp = p0; *(u32x4*)(rp + 8 * DFF) = p1; }
    }
};
struct EpiMlp2 {
    static constexpr bool PERM = true, AFTER_DRAIN = false; Bufs B; const float* gfin; unsigned* tmo;
    __device__ __forceinline__ void operator()(pg8::f32x4 (&acc)[2][2][4][2], const pg8::Unit& u, int wr, int wc, int fr, int fq) const {
        const int rowx = u.pm * 256 + wr * 64 + (fr & 7), col0 = u.pn * 256 + wc * 64 + 8 * (4 * (fr >> 3) + fq);
#pragma unroll
        for (int ai = 0; ai < 2; ++ai)
#pragma unroll
            for (int m = 0; m < 4; ++m) { const int row = rowx + ai * 128 + m * 16; const size_t o = (size_t)row * D + col0;
                const float ra = __builtin_amdgcn_rcpf(__hip_atomic_load(B.ss1 + row, __ATOMIC_RELAXED, __HIP_MEMORY_SCOPE_AGENT) * (1.0f / D) + NORM_EPS);
                const float rb = __builtin_amdgcn_rcpf(__hip_atomic_load(B.ss1 + row + 8, __ATOMIC_RELAXED, __HIP_MEMORY_SCOPE_AGENT) * (1.0f / D) + NORM_EPS);
                const u32x4 xa = *(const u32x4*)(B.X1B + o), xb = *(const u32x4*)(B.X1B + o + 8 * D);
                f32x4 &a0 = acc[ai][0][m][0], &a1 = acc[ai][0][m][1], &b0 = acc[ai][1][m][0], &b1 = acc[ai][1][m][1]; xrow8f(a0, a1, b0, b1);
                f32x4 x0, x1; unpack8(xa, x0, x1); a0 = x0 + a0 * ra; a1 = x1 + a1 * ra; unpack8(xb, x0, x1); b0 = x0 + b0 * rb; b1 = x1 + b1 * rb;
                float sa = ((a0.x * a0.x + a0.y * a0.y) + (a0.z * a0.z + a0.w * a0.w)) + ((a1.x * a1.x + a1.y * a1.y) + (a1.z * a1.z + a1.w * a1.w));
                float sb = ((b0.x * b0.x + b0.y * b0.y) + (b0.z * b0.z + b0.w * b0.w)) + ((b1.x * b1.x + b1.y * b1.y) + (b1.z * b1.z + b1.w * b1.w));
                sa += __shfl_xor(sa, 8); sb += __shfl_xor(sb, 8); sa += __shfl_xor(sa, 16); sb += __shfl_xor(sb, 16); sa += __shfl_xor(sa, 32); sb += __shfl_xor(sb, 32);
                if (fq == 0) atomicAdd(B.ss2 + row + (fr & 8), (fr & 8) ? sb : sa); }
        asm volatile("s_waitcnt vmcnt(0)" ::: "memory");
        __syncthreads();
        if (threadIdx.x == 0) { unsigned* c = B.pcnt + u.pm * 16;
            (void)__hip_atomic_fetch_add(c, 1u, __ATOMIC_RELAXED, __HIP_MEMORY_SCOPE_AGENT);
            unsigned sp = 0;
            while (__hip_atomic_load(c, __ATOMIC_RELAXED, __HIP_MEMORY_SCOPE_AGENT) < 4u) { __builtin_amdgcn_s_sleep(1);
                if ((++sp & 255u) == 0u) { if (__hip_atomic_load(tmo, __ATOMIC_RELAXED, __HIP_MEMORY_SCOPE_AGENT)) break; if (sp > (1u << 18)) { atomicAdd(tmo, 1u); break; } } } }
        __syncthreads();
        const f32x4 g0 = *(const f32x4*)(gfin + col0), g1 = *(const f32x4*)(gfin + col0 + 4);
        float s2a[2][4], s2b[2][4];
#pragma unroll
        for (int ai = 0; ai < 2; ++ai)
#pragma unroll
            for (int m = 0; m < 4; ++m) { const int row = rowx + ai * 128 + m * 16; s2a[ai][m] = __hip_atomic_load(B.ss2 + row, __ATOMIC_RELAXED, __HIP_MEMORY_SCOPE_AGENT); s2b[ai][m] = __hip_atomic_load(B.ss2 + row + 8, __ATOMIC_RELAXED, __HIP_MEMORY_SCOPE_AGENT); }
        __builtin_amdgcn_sched_barrier(0);
#pragma unroll
        for (int ai = 0; ai < 2; ++ai)
#pragma unroll
            for (int m = 0; m < 4; ++m) { const int row = rowx + ai * 128 + m * 16; const size_t o = (size_t)row * D + col0;
                const float qa = __builtin_amdgcn_rsqf(s2a[ai][m] * (1.0f / D) + NORM_EPS);
                const float qb = __builtin_amdgcn_rsqf(s2b[ai][m] * (1.0f / D) + NORM_EPS);
                *(f32x4*)(B.out + o) = acc[ai][0][m][0] * qa * g0; *(f32x4*)(B.out + o + 4) = acc[ai][0][m][1] * qa * g1;
                *(f32x4*)(B.out + o + 8 * D) = acc[ai][1][m][0] * qb * g0; *(f32x4*)(B.out + o + 8 * D + 4) = acc[ai][1][m][1] * qb * g1; }
    }
};
struct ReverseOrder {
    pg8::StaticOrder S; int nM;
    __device__ __forceinline__ bool next(int i, pg8::Unit& u) const { if (!S.next(i, u)) return false; u.pm ^= 15; return true; }
    __device__ __forceinline__ void a_ready(const pg8::Unit&) const {}
    __device__ __forceinline__ void done(const pg8::Unit&) const {}
};
template <class Epi> __device__ __forceinline__ void gemm_run_rev(LAS unsigned char* lds, const bf16_t* A, const bf16_t* Bt, int Mr, int N, int K, const Epi& E, int cu) {
    pg8::Gemm g{A, Bt, Mr, N, K}; ReverseOrder S; S.S.init(Mr, N, (int)gridDim.x, cu); S.nM = Mr / 256;
    pg8::gemm_phase<Epi, ReverseOrder, true, true>(lds, g, S, E);
}
template <class Epi> __device__ __forceinline__ void gemm_run(LAS unsigned char* lds, const bf16_t* A, const bf16_t* Bt, int Mr, int N, int K, const Epi& E, int cu) {
    pg8::Gemm g{A, Bt, Mr, N, K}; pg8::StaticOrder S; S.init(Mr, N, (int)gridDim.x, cu);
    pg8::gemm_phase<Epi, pg8::StaticOrder, true, true>(lds, g, S, E);
}

#define RLX_AGENT __ATOMIC_RELAXED, __HIP_MEMORY_SCOPE_AGENT
#define XB_TMO      128
#define XB_XCNT(j)  (256  + 64 * (j))
#define XB_XSUB(j)  (1280 + 64 * (j))
#define XB_XGEN(j)  (2304 + 64 * (j))
#define XB_TOP      3328
#define XB_TOPGEN   3392
#define XB_EVT      3456
#define XCD_BAR_WORDS 3456
#define XB_SPIN_CAP (1u << 18)

__device__ __forceinline__ unsigned xb_ld(unsigned* p)              { return __hip_atomic_load(p, __ATOMIC_RELAXED, __HIP_MEMORY_SCOPE_AGENT); }
__device__ __forceinline__ unsigned xb_add(unsigned* p, unsigned v) { return __hip_atomic_fetch_add(p, v, __ATOMIC_RELAXED, __HIP_MEMORY_SCOPE_AGENT); }
__device__ __forceinline__ unsigned xb_xcc_id() { return (unsigned)__builtin_amdgcn_s_getreg((3 << 11) | 20) & 0xFu; }
#define XB_SPIN(cond, bar) do { unsigned _sp = 0; while (cond) { __builtin_amdgcn_s_sleep(1); \
    if ((++_sp & 255u) == 0u) { if (xb_ld(&(bar)[XB_TMO])) break; if (_sp > XB_SPIN_CAP) { atomicAdd(&(bar)[XB_TMO], 1u); break; } } } } while (0)

struct XcdBarrier {
    unsigned* bar; unsigned x;
    volatile LAS unsigned* st;
};

__device__ __forceinline__ XcdBarrier xcd_barrier_post(unsigned* bar, volatile LAS unsigned* st) {
    XcdBarrier b; b.bar = bar; b.x = xb_xcc_id(); b.st = st;
    if (threadIdx.x == 0) (void)xb_add(&bar[XB_XCNT(b.x)], 1u);
    return b;
}
__device__ __forceinline__ void xcd_barrier_complete(unsigned* bar, unsigned x, unsigned& nloc, unsigned& nx) {
    const unsigned G = gridDim.x * gridDim.y * gridDim.z;
    unsigned sum, cnt, mine, sp = 0u;
    for (;;) {
        sum = 0u; cnt = 0u; mine = 0u;
#pragma unroll
        for (unsigned j = 0; j < 16; ++j) { const unsigned c = xb_ld(&bar[XB_XCNT(j)]); sum += c; cnt += (c > 0u) ? 1u : 0u; mine = (j == x) ? c : mine; }
        if (sum == G) break;
        __builtin_amdgcn_s_sleep(1);
        if ((++sp & 255u) == 0u) { if (xb_ld(&bar[XB_TMO])) break; if (sp > XB_SPIN_CAP) { atomicAdd(&bar[XB_TMO], 1u); break; } }
    }
    nloc = mine > 0u ? mine : 1u; nx = cnt > 0u ? cnt : 1u;
}

__device__ __forceinline__ void xcd_barrier(const XcdBarrier& b) {
    asm volatile("s_waitcnt vmcnt(0)" ::: "memory");
    __syncthreads();
    if (threadIdx.x == 0) {
        unsigned* bar = b.bar;
        __builtin_amdgcn_s_waitcnt(0);
        unsigned nloc = b.st[0], nx = b.st[1];
        if (nloc == 0u) { xcd_barrier_complete(bar, b.x, nloc, nx); b.st[0] = nloc; b.st[1] = nx; }
        const unsigned old = xb_add(&bar[XB_XSUB(b.x)], 1u);
        const unsigned gen = old / nloc;
        if (old + 1u == (gen + 1u) * nloc) {
            __builtin_amdgcn_fence(__ATOMIC_RELEASE, "agent");
            asm volatile("s_waitcnt vmcnt(0)" ::: "memory");
            const unsigned og = xb_add(&bar[XB_TOP], 1u);
            const unsigned tg = og / nx;
            if (og + 1u == (tg + 1u) * nx) xb_add(&bar[XB_TOPGEN], 1u);
            else XB_SPIN(xb_ld(&bar[XB_TOPGEN]) == tg, bar);
            __builtin_amdgcn_fence(__ATOMIC_ACQUIRE, "agent");
            xb_add(&bar[XB_XGEN(b.x)], 1u);
            asm volatile("s_waitcnt vmcnt(0)" ::: "memory");
        } else {
            XB_SPIN(xb_ld(&bar[XB_XGEN(b.x)]) == gen, bar);
            __builtin_amdgcn_fence(__ATOMIC_ACQUIRE, "agent");
            asm volatile("s_waitcnt vmcnt(0)" ::: "memory");
        }
    }
    __syncthreads();
}

__device__ __forceinline__ void xcd_barrier_local(const XcdBarrier& b, int mode) {
    asm volatile("s_waitcnt vmcnt(0)" ::: "memory");
    __syncthreads();
    if (threadIdx.x == 0) {
        unsigned* bar = b.bar;
        __builtin_amdgcn_s_waitcnt(0);
        unsigned nloc = b.st[0], nx = b.st[1];
        if (nloc == 0u) { xcd_barrier_complete(bar, b.x, nloc, nx); b.st[0] = nloc; b.st[1] = nx; }
        const unsigned old = xb_add(&bar[XB_XSUB(b.x)], 1u);
        const unsigned gen = old / nloc;
        if (old + 1u == (gen + 1u) * nloc) {
            if (mode == 2) XB_SPIN(xb_ld(&bar[XB_EVT]) < nx, bar);
            xb_add(&bar[XB_XGEN(b.x)], 1u);
            if (mode == 1) { __builtin_amdgcn_fence(__ATOMIC_RELEASE, "agent"); asm volatile("s_waitcnt vmcnt(0)" ::: "memory"); xb_add(&bar[XB_EVT], 1u); }
        } else XB_SPIN(xb_ld(&bar[XB_XGEN(b.x)]) == gen, bar);
        __builtin_amdgcn_fence(__ATOMIC_ACQUIRE, "agent");
        asm volatile("s_waitcnt vmcnt(0)" ::: "memory");
    }
    __syncthreads();
}

constexpr int LDS_BYTES = 155648;
constexpr int LDS_BARW = LDS_BYTES - 64;
constexpr int CW_BAR = 4096, CW_CEN = 8192;
constexpr int N_PHASES = 8;
__global__ void __launch_bounds__(NTHREADS, 2) fwd_kernel(Args a) {
    extern __shared__ __attribute__((aligned(16))) unsigned char lds_raw[];
    LAS unsigned char* lds = (LAS unsigned char*)lds_raw;
    const Bufs B = make_bufs(a);
    const int lo = a.ph_lo, hi = a.ph_hi;
    volatile LAS unsigned* barw = (volatile LAS unsigned*)(lds + LDS_BARW);
    if (threadIdx.x < 4) barw[threadIdx.x] = 0u;
    __syncthreads();
    XcdBarrier bar = xcd_barrier_post((unsigned*)(a.ws + WS_CTL) + CW_BAR, barw);
    unsigned* cen = (unsigned*)(a.ws + WS_CTL) + CW_CEN;
    int my_rank = 0; { unsigned r = 0; if (threadIdx.x == 0) r = atomicAdd(cen + 64 * bar.x, 1u); my_rank = (int)__builtin_amdgcn_readfirstlane(r); }
    if (threadIdx.x == 0) barw[2] = (unsigned)my_rank;
    __syncthreads();
    my_rank = (int)barw[2];
#define IN(k) (lo <= (k) && (k) < hi)
#define SEAM(k) do { if (IN(k) && IN((k) + 1)) xcd_barrier(bar); } while (0)
#define SEAM_X(k, mode) do { if (IN(k) && IN((k) + 1)) { if (xmode) xcd_barrier_local(bar, mode); else xcd_barrier(bar); } } while (0)
    if (IN(0)) { phase_prep(a, B, lds); } SEAM(0);
    int xmap = (int)(blockIdx.x & 7) | ((int)(blockIdx.x >> 3) << 3); bool xmode = false;
    if (hi - lo > 1) {
        int npop = 0, below = 0; bool ok = true;
        for (int q = 0; q < 16; ++q) { const unsigned c = __hip_atomic_load(cen + 64 * q, __ATOMIC_RELAXED, __HIP_MEMORY_SCOPE_AGENT); if (c) { ++npop; ok = ok && (c == 32u); if (q < (int)bar.x) ++below; } }
        if (ok && npop == 8 && gridDim.x == 256 && lo == 0 && hi == N_PHASES) { xmap = below | (my_rank << 3); xmode = true; }
    }
    const int cu = (gridDim.x == 256) ? xmap : (int)blockIdx.x;
    if (IN(1)) { EpiInProj E{B}; gemm_run(lds, B.H, B.Win, M, NIN, D, E, cu); }
    rnn::Consts rc; if (IN(2)) rnn::rnn_setup(a, rnn_blk(xmap), rc);
    SEAM_X(1, 0);
    if (IN(2)) { rnn::rnn_item(a, B, lds, rnn_batch(xmap), rnn_blk(xmap), B.GG, rc); __syncthreads();
        phase_attn_flash(a, B, lds, B.Q, xmap);
    } SEAM_X(2, 0);
    if (IN(3)) { EpiBrA E{B}; gemm_run(lds, B.GG, B.Wbr, M, D, D, E, cu); }
    if (IN(4)) { EpiBrB E{B}; gemm_run(lds, B.Q, B.Wba, M, D, D, E, cu); } SEAM_X(4, 1);
    if (IN(5)) { EpiOut E{B}; gemm_run(lds, B.MG, B.Wout, M, D, D, E, cu); } SEAM_X(5, 2);
    if (IN(6)) { EpiMlp1 E{B}; gemm_run(lds, B.X1B, B.W1, M, DFF, D, E, cu); } SEAM_X(6, 0);
    if (IN(7)) { EpiMlp2 E{B, a.in[21], (unsigned*)(a.ws + WS_CTL) + CW_BAR + XB_TMO}; gemm_run_rev(lds, B.HID, B.W2, M, D, DFF, E, cu); }
#undef SEAM_X
#undef IN
#undef SEAM
}

extern "C" void kernel_launch(void* const* d_in, const int* in_sizes, int n_in, void* d_out, int out_size, void* d_ws, size_t ws_size, hipStream_t stream) {
    static int grid = 0;
    if (grid == 0) {
        if (n_in != 22 || in_sizes[0] != M * D || out_size != M * D || ws_size < WS_END) { fprintf(stderr, "kernel_launch: unexpected shapes (n_in %d, in0 %d, out %d, ws %zu); nothing launched\n", n_in, n_in > 0 ? in_sizes[0] : -1, out_size, ws_size); grid = -1; return; }
        int dev = 0, cus = 0, per_cu = 0;
        if (hipGetDevice(&dev) != hipSuccess || hipDeviceGetAttribute(&cus, hipDeviceAttributeMultiprocessorCount, dev) != hipSuccess) { grid = -1; return; }
        if (hipFuncSetAttribute((const void*)fwd_kernel, hipFuncAttributeMaxDynamicSharedMemorySize, LDS_BYTES) != hipSuccess) { fprintf(stderr, "kernel_launch: hipFuncSetAttribute failed\n"); grid = -1; return; }
        if (hipOccupancyMaxActiveBlocksPerMultiprocessor(&per_cu, (const void*)fwd_kernel, NTHREADS, LDS_BYTES) != hipSuccess || per_cu < 1) { fprintf(stderr, "kernel_launch: occupancy query says %d blocks per CU\n", per_cu); (void)hipGetLastError(); per_cu = 1; }
        if (cus != 256) { fprintf(stderr, "kernel_launch: %d CUs; the static work orders (and the four-workgroup rendezvous of the last phase) are laid out for 256\n", cus); grid = -1; return; }
        grid = cus;
    }
    if (grid < 0) return;
    (void)hipMemsetAsync((char*)d_ws + WS_CTL, 0, CTL_ZERO_BYTES, stream);
    Args a{};
    for (int i = 0; i < 22; ++i) a.in[i] = (const float*)d_in[i];
    a.out = (float*)d_out; a.ws = (unsigned char*)d_ws;
#if MK_N_LAUNCHES == 1
    a.ph_lo = 0; a.ph_hi = N_PHASES;
    hipLaunchKernelGGL(fwd_kernel, dim3(grid), dim3(NTHREADS), LDS_BYTES, stream, a);
#else
    for (int p = 0; p < N_PHASES; ++p) { a.ph_lo = p; a.ph_hi = p + 1; hipLaunchKernelGGL(fwd_kernel, dim3(grid), dim3(NTHREADS), LDS_BYTES, stream, a); }
#endif
}
```

```cpp
#include <hip/hip_runtime.h>
#include <cstdio>
#include <cstdint>

#ifndef MK_N_LAUNCHES
#define MK_N_LAUNCHES 1
#endif

namespace pg8 {
#define PG8_LAS __attribute__((address_space(3)))
typedef unsigned short bf16_t;
typedef short bf16x8 __attribute__((ext_vector_type(8)));
typedef float f32x4 __attribute__((ext_vector_type(4)));
typedef unsigned u32x4 __attribute__((ext_vector_type(4)));
constexpr int BM = 256, BK = 64, HALF = 128, HTB = HALF * BK * 2  , STAGE_BYTES = 8 * HTB, NXCD = 8, WGM = 8;

__host__ __device__ __forceinline__ int lds_byte(int r, int c) { const int st = (r >> 4) * 2 + (c >> 5), rr = r & 15, cc = c & 31, ob = rr * 64 + cc * 2; return st * 1024 + (ob ^ (((ob >> 9) & 1) << 5)); }
__host__ __device__ __forceinline__ void stage_rc(int b, int& R, int& C) { const int st = b / 1024, sb = b % 1024, swz = sb ^ (((sb >> 9) & 1) << 5); R = (st >> 1) * 16 + swz / 64; C = (st & 1) * 32 + (swz % 64) / 2; }
__host__ __device__ __forceinline__ int perm32(int rho) { const int n = rho >> 4, i = rho & 15; return 8 * (i >> 2) + 4 * n + (i & 3); }

struct Unit { int pm, pn; };
struct Gemm { const bf16_t* A; const bf16_t* Bt; int M, N, K; };

struct StaticOrder {
    int nM, nN, nwg, G, c;
    __host__ __device__ __forceinline__ void init(int M, int N, int G_, int c_) { nM = M / BM; nN = N / BM; nwg = nM * nN; G = G_; c = c_; }
    __host__ __device__ __forceinline__ bool next(int i, Unit& u) const {
        const long L = (long)i * G + c; if (L >= nwg) return false;
        int wgid = (int)L; { const int q = nwg / NXCD, r = nwg % NXCD, xcd = wgid % NXCD, off = wgid / NXCD; wgid = (xcd < r ? xcd * (q + 1) : r * (q + 1) + (xcd - r) * q) + off; }
        const int nig = WGM * nN, gid = wgid / nig, fm = gid * WGM, gsz = (nM - fm) < WGM ? (nM - fm) : WGM;
        u.pm = fm + ((wgid % nig) % gsz); u.pn = (wgid % nig) / gsz; return true;
    }
    __device__ __forceinline__ void a_ready(const Unit&) const {}
    __device__ __forceinline__ void done(const Unit&) const {}
};
template <class Epi, class Sched, bool ALIGN_EPI = false, bool SP2 = false>
__device__ __forceinline__ void gemm_phase(PG8_LAS unsigned char* lds, const Gemm g, const Sched& S, const Epi& E) {
    const int tid = threadIdx.x, wid = __builtin_amdgcn_readfirstlane(tid >> 6), lane = tid & 63, wr = wid >> 2, wc = wid & 3, fr = lane & 15, fq = lane >> 4;
    const int K = g.K, nt = K / BK;
    unsigned voffA[2], voffB[2];
#pragma unroll
    for (int i = 0; i < 2; ++i) { int R, C; stage_rc(tid * 16 + i * 8192, R, C); const int Rb = Epi::PERM ? ((R & ~31) + perm32(R & 31)) : R;
        voffA[i] = (unsigned)(R * K + C) * 2u; voffB[i] = (unsigned)(Rb * K + C) * 2u; }
    const size_t kstep = (size_t)(BK * 2);
    const size_t hstep = (size_t)HALF * K * 2;
    const size_t tstep = 2 * hstep;
    const unsigned ldsw = (unsigned)wid * 1024u;
    const int aoff = lds_byte(wr * 64 + fr, fq * 8), boff = lds_byte(wc * 32 + fr, fq * 8);
#define PG8_SA(b, h) (((b) * 2 + (h)) * HTB)
#define PG8_SB(b, h) ((4 + (b) * 2 + (h)) * HTB)
#define PG8_STAGE(bufoff, gbase, voff) do { _Pragma("unroll") for (int _i = 0; _i < 2; ++_i) \
        __builtin_amdgcn_global_load_lds((const unsigned*)((const char*)(gbase) + (voff)[_i]), (PG8_LAS unsigned*)(lds + (bufoff) + ldsw + _i * 8192), 16, 0, 0); } while (0)
#define PG8_LDA(dst, b, h) do { _Pragma("unroll") for (int m = 0; m < 4; ++m) _Pragma("unroll") for (int k = 0; k < 2; ++k) dst[m][k] = *(const PG8_LAS bf16x8*)(lds + PG8_SA(b, h) + aoff + m * 2048 + k * 1024); } while (0)
#define PG8_LDB(dst, b, h) do { _Pragma("unroll") for (int n = 0; n < 2; ++n) _Pragma("unroll") for (int k = 0; k < 2; ++k) dst[n][k] = *(const PG8_LAS bf16x8*)(lds + PG8_SB(b, h) + boff + n * 2048 + k * 1024); } while (0)
#define PG8_MMA(ai, bj, At, Bt) do { __builtin_amdgcn_s_setprio(1); _Pragma("unroll") for (int m = 0; m < 4; ++m) _Pragma("unroll") for (int n = 0; n < 2; ++n) _Pragma("unroll") for (int k = 0; k < 2; ++k) \
        acc[ai][bj][m][n] = __builtin_amdgcn_mfma_f32_16x16x32_bf16(Bt[n][k], At[m][k], acc[ai][bj][m][n], 0, 0, 0); __builtin_amdgcn_s_setprio(0); } while (0)
#define PG8_WAIT_V(n) asm volatile("s_waitcnt vmcnt(" #n ")" ::: "memory")
#define PG8_WAIT_L(n) asm volatile("s_waitcnt lgkmcnt(" #n ")" ::: "memory")
#define PG8_BAR __builtin_amdgcn_s_barrier()
#define PG8_SCHED __builtin_amdgcn_sched_barrier(0)
    Unit cur, nxt; int ui = 0;
    if (!S.next(0, cur)) return;
    f32x4 acc[2][2][4][2];
#pragma unroll
    for (int a = 0; a < 2; ++a)
#pragma unroll
        for (int b = 0; b < 2; ++b)
#pragma unroll
            for (int m = 0; m < 4; ++m)
#pragma unroll
                for (int n = 0; n < 2; ++n) acc[a][b][m][n] = (f32x4){0.f, 0.f, 0.f, 0.f};
    bf16x8 At[4][2], B0[2][2], B1[2][2];
    const char* cA = (const char*)g.A + (size_t)cur.pm * tstep; const char* cB = (const char*)g.Bt + (size_t)cur.pn * tstep;
    S.a_ready(cur);
    if constexpr (SP2) {
        PG8_STAGE(PG8_SB(0, 0), cB, voffB); PG8_STAGE(PG8_SB(0, 1), cB + hstep, voffB); PG8_STAGE(PG8_SA(0, 0), cA, voffA); PG8_STAGE(PG8_SA(0, 1), cA + hstep, voffA);
        if (wr == 1) PG8_BAR;
        PG8_WAIT_V(2); PG8_BAR;
        PG8_STAGE(PG8_SB(1, 0), cB + kstep, voffB); PG8_STAGE(PG8_SA(1, 0), cA + kstep, voffA); PG8_STAGE(PG8_SB(1, 1), cB + hstep + kstep, voffB);
        PG8_WAIT_V(6); PG8_BAR;
    } else {
        PG8_STAGE(PG8_SB(0, 0), cB, voffB); PG8_STAGE(PG8_SA(0, 0), cA, voffA); PG8_STAGE(PG8_SB(0, 1), cB + hstep, voffB); PG8_STAGE(PG8_SA(0, 1), cA + hstep, voffA);
        if (wr == 1) PG8_BAR;
        PG8_WAIT_V(4); PG8_BAR;
        PG8_STAGE(PG8_SB(1, 0), cB + kstep, voffB); PG8_STAGE(PG8_SA(1, 0), cA + kstep, voffA); PG8_STAGE(PG8_SB(1, 1), cB + hstep + kstep, voffB);
        PG8_WAIT_V(6); PG8_BAR;
    }
    for (;;) {
        const bool has_next = S.next(ui + 1, nxt);
        const char* nA = has_next ? (const char*)g.A + (size_t)nxt.pm * tstep : cA; const char* nB = has_next ? (const char*)g.Bt + (size_t)nxt.pn * tstep : cB;
        for (int t = 0; t < nt; t += 2) {
            const bool last = (t == nt - 2);
            const char* a1 = cA + (size_t)(t + 1) * kstep;
            const char* a2 = last ? nA : cA + (size_t)(t + 2) * kstep; const char* b2 = last ? nB : cB + (size_t)(t + 2) * kstep;
            const char* a3 = a2 + kstep; const char* b3 = b2 + kstep;
            if (last && has_next) S.a_ready(nxt);
            if constexpr (SP2) {
            PG8_LDB(B0, 0, 0); PG8_LDB(B1, 0, 1); PG8_SCHED; PG8_LDA(At, 0, 0); PG8_STAGE(PG8_SA(1, 1), a1 + hstep, voffA);
            PG8_WAIT_V(8); PG8_WAIT_L(0); PG8_BAR; PG8_MMA(0, 0, At, B0); PG8_MMA(0, 1, At, B1); PG8_BAR; PG8_SCHED;
            PG8_LDA(At, 0, 1); PG8_STAGE(PG8_SB(0, 0), b2, voffB); PG8_STAGE(PG8_SB(0, 1), b2 + hstep, voffB); PG8_STAGE(PG8_SA(0, 0), a2, voffA);
            PG8_WAIT_V(8); PG8_WAIT_L(0); PG8_BAR; PG8_MMA(1, 0, At, B0); PG8_MMA(1, 1, At, B1); PG8_BAR; PG8_SCHED;
            PG8_LDB(B0, 1, 0); PG8_LDB(B1, 1, 1); PG8_SCHED; PG8_LDA(At, 1, 0); PG8_STAGE(PG8_SA(0, 1), a2 + hstep, voffA);
            PG8_WAIT_V(8); PG8_WAIT_L(0); PG8_BAR; PG8_MMA(0, 0, At, B0); PG8_MMA(0, 1, At, B1); PG8_BAR; PG8_SCHED;
            PG8_LDA(At, 1, 1); PG8_STAGE(PG8_SB(1, 0), b3, voffB); PG8_STAGE(PG8_SB(1, 1), b3 + hstep, voffB); PG8_STAGE(PG8_SA(1, 0), a3, voffA);
            PG8_WAIT_V(8); PG8_WAIT_L(0); PG8_BAR; PG8_MMA(1, 0, At, B0); PG8_MMA(1, 1, At, B1); PG8_BAR; PG8_SCHED;
            } else {
            PG8_LDB(B0, 0, 0); PG8_SCHED; PG8_LDA(At, 0, 0); PG8_STAGE(PG8_SA(1, 1), a1 + hstep, voffA);
            PG8_WAIT_L(8); PG8_BAR; PG8_WAIT_L(0); PG8_MMA(0, 0, At, B0); PG8_BAR; PG8_SCHED;
            PG8_LDB(B1, 0, 1); PG8_STAGE(PG8_SB(0, 0), b2, voffB);
            PG8_BAR; PG8_WAIT_L(0); PG8_MMA(0, 1, At, B1); PG8_BAR;
            PG8_LDA(At, 0, 1); PG8_STAGE(PG8_SA(0, 0), a2, voffA);
            PG8_BAR; PG8_WAIT_L(0); PG8_MMA(1, 0, At, B0); PG8_BAR; PG8_SCHED;
            PG8_STAGE(PG8_SB(0, 1), b2 + hstep, voffB);
            PG8_WAIT_V(6); PG8_BAR; PG8_MMA(1, 1, At, B1); PG8_BAR;
            PG8_LDB(B0, 1, 0); PG8_SCHED; PG8_LDA(At, 1, 0); PG8_STAGE(PG8_SA(0, 1), a2 + hstep, voffA);
            PG8_WAIT_L(8); PG8_BAR; PG8_WAIT_L(0); PG8_MMA(0, 0, At, B0); PG8_BAR; PG8_SCHED;
            PG8_LDB(B1, 1, 1); PG8_STAGE(PG8_SB(1, 0), b3, voffB);
            PG8_BAR; PG8_WAIT_L(0); PG8_MMA(0, 1, At, B1); PG8_BAR;
            PG8_LDA(At, 1, 1); PG8_STAGE(PG8_SA(1, 0), a3, voffA);
            PG8_BAR; PG8_WAIT_L(0); PG8_MMA(1, 0, At, B0); PG8_BAR; PG8_SCHED;
            PG8_STAGE(PG8_SB(1, 1), b3 + hstep, voffB);
            PG8_WAIT_V(6); PG8_BAR; PG8_MMA(1, 1, At, B1); PG8_BAR;
            }
        }
        if constexpr (ALIGN_EPI) { if (wr == 0) PG8_BAR; }
        if constexpr (!Epi::AFTER_DRAIN) { E(acc, cur, wr, wc, fr, fq); S.done(cur); }
        if (!has_next) break;
#pragma unroll
        for (int a = 0; a < 2; ++a)
#pragma unroll
            for (int b = 0; b < 2; ++b)
#pragma unroll
                for (int m = 0; m < 4; ++m)
#pragma unroll
                    for (int n = 0; n < 2; ++n) acc[a][b][m][n] = (f32x4){0.f, 0.f, 0.f, 0.f};
        cur = nxt; cA = nA; cB = nB; ++ui;
        if constexpr (ALIGN_EPI) { if (wr == 1) PG8_BAR; }
    }
    PG8_WAIT_V(0);
    if constexpr (!ALIGN_EPI) { if (wr == 0) PG8_BAR; }
    PG8_BAR;
    if constexpr (Epi::AFTER_DRAIN) { E.fused(acc, cur, wr, wc, fr, fq, lds, wid, lane); S.done(cur); }
#undef PG8_SA
#undef PG8_SB
#undef PG8_STAGE
#undef PG8_LDA
#undef PG8_LDB
#undef PG8_MMA
#undef PG8_WAIT_V
#undef PG8_WAIT_L
#undef PG8_BAR
#undef PG8_SCHED
}
}

constexpr int BATCH = 16, SEQ = 2048, D = 1024, M = BATCH * SEQ, NIN = 7168, DFF = 4096;
constexpr int NWAVES = 8, NTHREADS = 512;
constexpr float NORM_EPS = 1e-6f, SUBLN_EPS = 1e-5f;
constexpr float LOG2E = 1.4426950408889634f;
constexpr float QSCALE = 0.18033688011112042f;
constexpr float LAM_INIT = 0.2f;
constexpr float OUT_SCALE = 1.0f - LAM_INIT;

#define LAS __attribute__((address_space(3)))
typedef unsigned short bf16_t;
typedef short bf16x8 __attribute__((ext_vector_type(8)));
typedef float f32x4 __attribute__((ext_vector_type(4)));
typedef float f32x16 __attribute__((ext_vector_type(16)));
typedef unsigned u32x4 __attribute__((ext_vector_type(4)));
typedef unsigned u32x2 __attribute__((ext_vector_type(2)));

constexpr size_t MiB = 1u << 20;
constexpr size_t WS_CTL = 0, CTL_ZERO_BYTES = 64 * 1024;
constexpr size_t WS_SS1 = 512 * 1024;
constexpr size_t WS_SS2 = 640 * 1024;
constexpr int CW_PANEL = 10240;
constexpr size_t WS_ROPE = 1 * MiB;
constexpr size_t WS_WIN = 2 * MiB, WS_WBR = 16 * MiB, WS_WBA = 18 * MiB, WS_WOUT = 20 * MiB, WS_W1 = 22 * MiB, WS_W2 = 30 * MiB;
constexpr size_t WS_B0 = 48 * MiB, WS_B1 = 112 * MiB, WS_B2 = 176 * MiB, WS_B3 = 240 * MiB, WS_B4 = 304 * MiB, WS_B5 = 368 * MiB, WS_END = 432 * MiB;

struct Args { const float* in[22]; float* out; unsigned char* ws; int ph_lo, ph_hi; };

struct Bufs {
    const float* x; float* out;
    bf16_t *Win, *Wbr, *Wba, *Wout, *W1, *W2;
    bf16_t *H, *UX, *GG, *Q, *K, *V, *MG, *X1B, *HID; unsigned char *SR, *SA;
    float *ss1, *ss2, *ropec, *ropes; bf16_t* T; unsigned* pcnt;
};
__device__ __forceinline__ Bufs make_bufs(const Args& a) {
    Bufs b; unsigned char* ws = a.ws;
    b.x = a.in[0]; b.out = a.out;
    b.Win = (bf16_t*)(ws + WS_WIN); b.Wbr = (bf16_t*)(ws + WS_WBR); b.Wba = (bf16_t*)(ws + WS_WBA); b.Wout = (bf16_t*)(ws + WS_WOUT); b.W1 = (bf16_t*)(ws + WS_W1); b.W2 = (bf16_t*)(ws + WS_W2);
    b.H = (bf16_t*)(ws + WS_B0); b.UX = (bf16_t*)(ws + WS_B1); b.GG = (bf16_t*)(ws + WS_B2); b.Q = (bf16_t*)(ws + WS_B3); b.K = (bf16_t*)(ws + WS_B4); b.V = (bf16_t*)(ws + WS_B5);
    b.SR = (unsigned char*)a.out; b.SA = (unsigned char*)a.out + (size_t)M * D;
    b.MG = (bf16_t*)(ws + WS_B0); b.X1B = (bf16_t*)(ws + WS_B1); b.HID = (bf16_t*)(ws + WS_B2);
    b.T = (bf16_t*)(ws + WS_B4); b.ss1 = (float*)(ws + WS_SS1); b.ss2 = (float*)(ws + WS_SS2); b.pcnt = (unsigned*)(ws + WS_CTL) + CW_PANEL; b.ropec = (float*)(ws + WS_ROPE); b.ropes = b.ropec + 2048 * 32;
    return b;
}

__device__ __forceinline__ unsigned f2bf(float f) { unsigned u = __builtin_bit_cast(unsigned, f); return (u + 0x7fffu + ((u >> 16) & 1u)) >> 16; }
typedef float pk_f32x2_t __attribute__((ext_vector_type(2))); typedef __bf16 pk_bf16x2_t __attribute__((ext_vector_type(2)));
__device__ __forceinline__ unsigned pk2(float lo, float hi) { const pk_f32x2_t v = {lo, hi}; return __builtin_bit_cast(unsigned, __builtin_convertvector(v, pk_bf16x2_t)); }
__device__ __forceinline__ float bf2f(unsigned b) { return __builtin_bit_cast(float, b << 16); }
__device__ __forceinline__ float fexp2(float x) { return __builtin_amdgcn_exp2f(x); }
__device__ __forceinline__ float sigmoid_f(float v) { return 1.0f / (1.0f + fexp2(-v * LOG2E)); }
__device__ __forceinline__ float gelu_tanh_f(float v) { const float y = 0.7978845608028654f * (v + 0.044715f * v * v * v); return v / (1.0f + fexp2(-2.0f * LOG2E * y)); }
__device__ __forceinline__ float wave_sum(float v) {
#pragma unroll
    for (int o = 1; o < 64; o <<= 1) v += __shfl_xor(v, o);
    return v;
}
__device__ __forceinline__ float wave_max(float v) {
#pragma unroll
    for (int o = 1; o < 64; o <<= 1) v = fmaxf(v, __shfl_xor(v, o));
    return v;
}
#define LDS_WAIT() asm volatile("s_waitcnt lgkmcnt(0)" ::: "memory")

__device__ __forceinline__ void transpose_item(const float* W, int K, int N, bf16_t* WT, int item, LAS float* scr, int lane, int permqk, const float* kscale) {
    const int nblk = N / 32, kb = item / nblk, nb = item % nblk, k0 = 64 * kb, n0 = 32 * nb;
    int s0 = n0;
    int cs = 0;
    if (permqk) { const int l = n0 & 255, bj = l >> 7, wc = (l >> 5) & 3; s0 = (n0 & ~255) + 64 * wc + 32 * bj; if (permqk > 1 && n0 >= 5120) { s0 = (n0 & ~255) + 64 * wc + 8 * bj; cs = 1; } }
#pragma unroll
    for (int i = 0; i < 8; ++i) { const int kk = 8 * i + (lane >> 3), c4 = (lane & 7) * 4; f32x4 v = *(const f32x4*)(W + (size_t)(k0 + kk) * N + s0 + (cs ? 16 * (c4 >> 3) + (c4 & 7) : c4));
        if (kscale) v = v * kscale[k0 + kk];
        if (cs) v = v * -LOG2E;
        LAS float* d = scr + kk * 33 + c4; d[0] = v.x; d[1] = v.y; d[2] = v.z; d[3] = v.w; }
    LDS_WAIT();
    const int c = lane & 7;
#pragma unroll
    for (int j = 0; j < 4; ++j) { const int n = (lane >> 3) + 8 * j; const LAS float* s = scr + (8 * c) * 33 + n;
        u32x4 o; o.x = pk2(s[0 * 33], s[1 * 33]); o.y = pk2(s[2 * 33], s[3 * 33]); o.z = pk2(s[4 * 33], s[5 * 33]); o.w = pk2(s[6 * 33], s[7 * 33]);
        *(u32x4*)(WT + (size_t)(n0 + n) * K + k0 + 8 * c) = o; }
    LDS_WAIT();
}
__constant__ double ROPE_INVF[32] = {1.0, 0.7498942093324559, 0.5623413251903491, 0.4216965034285822, 0.31622776601683794, 0.23713737056616552, 0.1778279410038923, 0.1333521432163324, 0.1, 0.07498942093324558,
    0.05623413251903491, 0.042169650342858224, 0.03162277660168379, 0.023713737056616554, 0.01778279410038923, 0.01333521432163324, 0.01, 0.007498942093324558, 0.005623413251903491, 0.004216965034285823,
    0.0031622776601683794, 0.0023713737056616554, 0.0017782794100389228, 0.001333521432163324, 0.001, 0.0007498942093324559, 0.0005623413251903491, 0.00042169650342858224, 0.00031622776601683794,
    0.00023713737056616554, 0.00017782794100389227, 0.0001333521432163324};
__device__ __forceinline__ void sincos_f64(double a, double& s, double& c) {
    const double k = __builtin_rint(a * 6.36619772367581382433e-01);
    double r = a - k * 1.57079632673412561417e+00; r = r - k * 6.07710050650619224932e-11;
    const double z = r * r;
    const double ps = r + r * z * (-1.66666666666666324348e-01 + z * (8.33333333332248946124e-03 + z * (-1.98412698298579493134e-04 + z * (2.75573137070700676789e-06 + z * (-2.50507602534068634195e-08 + z * 1.58969099521155010221e-10)))));
    const double pc = 1.0 - 0.5 * z + z * z * (4.16666666666666019037e-02 + z * (-1.38888888888741095749e-03 + z * (2.48015872894767294178e-05 + z * (-2.75573143513906633035e-07 + z * (2.08757232129817482790e-09 + z * -1.13596475577881948265e-11)))));
    const int q = (int)k & 3;
    s = (q == 0) ? ps : (q == 1) ? pc : (q == 2) ? -ps : -pc;
    c = (q == 0) ? pc : (q == 1) ? -ps : (q == 2) ? -pc : ps;
}
__device__ __forceinline__ void phase_prep(const Args& a, const Bufs& B, LAS unsigned char* lds) {
    const int tid = threadIdx.x, lane = tid & 63, wave = __builtin_amdgcn_readfirstlane(tid >> 6);
    LAS float* scr = (LAS float*)(lds + wave * 16384);
    const int gw = blockIdx.x * NWAVES + wave, NGW = gridDim.x * NWAVES;
    constexpr int I_IN = (D / 64) * (NIN / 32), I_SQ = (D / 64) * (D / 32), I_1 = (D / 64) * (DFF / 32), I_2 = (DFF / 64) * (D / 32);
    constexpr int NITEMS = I_IN + 3 * I_SQ + I_1 + I_2;
    for (int it = gw; it < NITEMS; it += NGW) {
        int r = it;
        if (r < I_IN) { transpose_item(a.in[2], D, NIN, B.Win, r, scr, lane, 2, nullptr); continue; } r -= I_IN;
        if (r < I_SQ) { transpose_item(a.in[15], D, D, B.Wbr, r, scr, lane, 1, nullptr); continue; } r -= I_SQ;
        if (r < I_SQ) { transpose_item(a.in[16], D, D, B.Wba, r, scr, lane, 1, nullptr); continue; } r -= I_SQ;
        if (r < I_SQ) { transpose_item(a.in[17], D, D, B.Wout, r, scr, lane, 1, nullptr); continue; } r -= I_SQ;
        if (r < I_1) { transpose_item(a.in[19], D, DFF, B.W1, r, scr, lane, 1, a.in[18]); continue; } r -= I_1;
        transpose_item(a.in[20], DFF, D, B.W2, r, scr, lane, 1, nullptr);
    }
    const f32x4* g4 = (const f32x4*)a.in[1];
    for (int m = 2 * gw; m < M; m += 2 * NGW) {
        const f32x4* xr = (const f32x4*)(B.x + (size_t)m * D) + lane;
        f32x4 v[2][4]; float s0 = 0.f, s1 = 0.f;
#pragma unroll
        for (int j = 0; j < 4; ++j) { v[0][j] = xr[64 * j]; v[1][j] = xr[256 + 64 * j]; }
#pragma unroll
        for (int j = 0; j < 4; ++j) { s0 += (v[0][j].x * v[0][j].x + v[0][j].y * v[0][j].y) + (v[0][j].z * v[0][j].z + v[0][j].w * v[0][j].w);
                                      s1 += (v[1][j].x * v[1][j].x + v[1][j].y * v[1][j].y) + (v[1][j].z * v[1][j].z + v[1][j].w * v[1][j].w); }
        const float rs0 = 1.0f / sqrtf(wave_sum(s0) * (1.0f / D) + NORM_EPS), rs1 = 1.0f / sqrtf(wave_sum(s1) * (1.0f / D) + NORM_EPS);
        u32x2* o = (u32x2*)(B.H + (size_t)m * D) + lane;
#pragma unroll
        for (int j = 0; j < 4; ++j) { const f32x4 g = g4[lane + 64 * j]; u32x2 w;
            w.x = pk2(v[0][j].x * rs0 * g.x, v[0][j].y * rs0 * g.y); w.y = pk2(v[0][j].z * rs0 * g.z, v[0][j].w * rs0 * g.w); o[64 * j] = w;
            w.x = pk2(v[1][j].x * rs1 * g.x, v[1][j].y * rs1 * g.y); w.y = pk2(v[1][j].z * rs1 * g.z, v[1][j].w * rs1 * g.w); o[256 + 64 * j] = w; }
    }
    for (int i = blockIdx.x * NTHREADS + tid; i < M; i += gridDim.x * NTHREADS) { B.ss1[i] = 0.f; B.ss2[i] = 0.f; }
    for (int idx = blockIdx.x * NTHREADS + tid; idx < 2048 * 32; idx += gridDim.x * NTHREADS) {
        const int pos = idx >> 5, j = idx & 31; double s, c; sincos_f64((double)pos * ROPE_INVF[j], s, c);
        B.ropec[idx] = (float)c; B.ropes[idx] = (float)s;
    }
}

namespace att {
constexpr int KV_STAGE = 32768, LDS_XCH = 2 * KV_STAGE, XCH_PAIR = 17408, LDS_WSF = LDS_XCH + 4 * XCH_PAIR;
constexpr float THR = 8.0f;
typedef short v4i16_t __attribute__((ext_vector_type(4)));
typedef float f32x2_t __attribute__((ext_vector_type(2))); typedef __bf16 bf16x2_t __attribute__((ext_vector_type(2)));
__device__ __forceinline__ float max3f(float a, float b, float c) { float r; asm("v_max3_f32 %0, %1, %2, %3" : "=v"(r) : "v"(a), "v"(b), "v"(c)); return r; }
__device__ __forceinline__ int crow(int r, int hi) { return (r & 3) + 8 * (r >> 2) + 4 * hi; }
__device__ __forceinline__ unsigned cvtpk(float lo, float hi) { f32x2_t v = {lo, hi}; bf16x2_t b = __builtin_convertvector(v, bf16x2_t); return __builtin_bit_cast(unsigned, b); }
__device__ __forceinline__ v4i16_t vtr(const LAS unsigned char* p) { return __builtin_amdgcn_ds_read_tr16_b64_v4i16((LAS v4i16_t*)p); }
__device__ __forceinline__ void swap32(unsigned& a, unsigned& b) { asm volatile("s_nop 1\n\tv_permlane32_swap_b32 %0, %1\n\ts_nop 1" : "+v"(a), "+v"(b)); }
__device__ __forceinline__ float swap_max(float m) { unsigned a = __builtin_bit_cast(unsigned, m), b = a; swap32(a, b); return fmaxf(__builtin_bit_cast(float, a), __builtin_bit_cast(float, b)); }
__device__ __forceinline__ float swap_sum(float m) { unsigned a = __builtin_bit_cast(unsigned, m), b = a; swap32(a, b); return __builtin_bit_cast(float, a) + __builtin_bit_cast(float, b); }

__device__ __forceinline__ void glds16(const void* gsrc, unsigned lds_dst) { unsigned keep;
    asm volatile("s_mov_b32 %0, m0\n\ts_mov_b32 m0, %2\n\ts_nop 0\n\tglobal_load_lds_dwordx4 %1, off\n\ts_mov_b32 m0, %0" : "=&s"(keep) : "v"(gsrc), "s"(lds_dst) : "memory"); }
#define ATT_SB() __builtin_amdgcn_sched_barrier(0)
__device__ __forceinline__ unsigned scale_pk(unsigned w, float f) { return cvtpk(bf2f(w & 0xffffu) * f, bf2f(w >> 16) * f); }
__device__ __forceinline__ void pv_plain(f32x16 (&o)[4], const LAS unsigned char* vb, const u32x4 (&pw)[4]) {
#pragma unroll
    for (int d0 = 0; d0 < 4; ++d0)
#pragma unroll
        for (int ks = 0; ks < 4; ++ks) { const v4i16_t lo = vtr(vb + d0 * 4096 + ks * 1024), hh = vtr(vb + d0 * 4096 + ks * 1024 + 512);
            const bf16x8 vf = {lo[0], lo[1], lo[2], lo[3], hh[0], hh[1], hh[2], hh[3]};
            o[d0] = __builtin_amdgcn_mfma_f32_32x32x16_bf16(__builtin_bit_cast(bf16x8, pw[ks]), vf, o[d0], 0, 0, 0); }
}
constexpr int LDS_K = 0, LDS_V = 49152, LDS_X2 = 114688, LDS_WSF2 = LDS_X2 + 32768;
template <int RB, bool OWN0> __device__ __forceinline__ void attn_tail_half(f32x16 (&o)[4], LAS unsigned* XR, float lam, const float* subg, bf16_t* Orow, int lane, int r32, int hi) {
    float ssq[8];
#pragma unroll
    for (int r = 0; r < 8; ++r) ssq[r] = 0.f;
#pragma unroll
    for (int d0 = 0; d0 < 4; ++d0)
#pragma unroll
        for (int rr = 0; rr < 4; ++rr) { const unsigned w = XR[(d0 * 4 + rr) * 64 + lane]; const float b0 = bf2f(w & 0xffffu), b1 = bf2f(w >> 16);
            const float v0 = OWN0 ? o[d0][RB + 2 * rr] - lam * b0 : b0 - lam * o[d0][RB + 2 * rr], v1 = OWN0 ? o[d0][RB + 2 * rr + 1] - lam * b1 : b1 - lam * o[d0][RB + 2 * rr + 1];
            o[d0][RB + 2 * rr] = v0; o[d0][RB + 2 * rr + 1] = v1; ssq[2 * rr] += v0 * v0; ssq[2 * rr + 1] += v1 * v1; }
#define ATT_DPPF(v, ctrl) __builtin_bit_cast(float, __builtin_amdgcn_update_dpp(0, __builtin_bit_cast(int, v), ctrl, 0xF, 0xF, false))
#pragma unroll
    for (int r = 0; r < 8; ++r) { float v = ssq[r]; v += ATT_DPPF(v, 0xB1); v += ATT_DPPF(v, 0x4E); v += ATT_DPPF(v, 0x124); v += ATT_DPPF(v, 0x128); ssq[r] = v + __shfl_xor(v, 16); }
#undef ATT_DPPF
    float g[4];
#pragma unroll
    for (int d0 = 0; d0 < 4; ++d0) g[d0] = subg[32 * d0 + r32] * OUT_SCALE;
    LAS bf16_t* Xo = (LAS bf16_t*)XR + r32;
#pragma unroll
    for (int r = 0; r < 8; r += 2) {
        const float rn0 = __builtin_amdgcn_rsqf(ssq[r] * (1.0f / 128.0f) + SUBLN_EPS), rn1 = __builtin_amdgcn_rsqf(ssq[r + 1] * (1.0f / 128.0f) + SUBLN_EPS);
        LAS bf16_t* xp = Xo + ((r & 3) + 8 * (r >> 2) + 4 * hi) * 128;
#pragma unroll
        for (int d0 = 0; d0 < 4; ++d0) { const unsigned w = pk2(o[d0][RB + r] * rn0 * g[d0], o[d0][RB + r + 1] * rn1 * g[d0]); xp[32 * d0] = (bf16_t)w; xp[128 + 32 * d0] = (bf16_t)(w >> 16); } }
    LDS_WAIT();
    bf16_t* ob = Orow + (size_t)(lane >> 4) * D + (lane & 15) * 8; const LAS unsigned char* xr = (const LAS unsigned char*)XR + lane * 16;
#pragma unroll
    for (int i = 0; i < 4; ++i) *(u32x4*)(ob + (size_t)(4 * i) * D) = *(const LAS u32x4*)(xr + i * 1024);
}
constexpr int LDS_QS = LDS_V + 32768;
__device__ __forceinline__ void attn_open(int b, int h, int qb, const bf16_t* Q, const bf16_t* K, const bf16_t* V, LAS unsigned char* lds) {
    const int tid = threadIdx.x, lane = tid & 63;
    const int wid = __builtin_amdgcn_readfirstlane(tid >> 6), ch = wid >> 2, s = (wid >> 1) & 1, qh = wid & 1;
    const int q0 = qb * 128 + ch * 64 + qh * 32;
    const size_t hb = ((size_t)(b * 8 + h) * SEQ) * 128;
    const bf16_t* ksrc = K + hb + (8 * ((2 * wid) & 7) + (lane >> 3)) * 128 + (wid >> 2) * 64 + ((lane & 7) ^ (lane >> 3)) * 8;
    const bf16_t* vsrc = V + hb + (32 * (wid & 1) + (lane >> 2)) * 128 + 32 * (wid >> 1) + (lane & 3) * 8;
    const bf16_t* qsrc = Q + ((size_t)b * SEQ + q0 + (lane >> 3)) * D + h * 128 + s * 64 + ((lane & 7) ^ (lane >> 3)) * 8;
    const unsigned ldsb = (unsigned)(uintptr_t)lds;
    const unsigned kdst = (unsigned)__builtin_amdgcn_readfirstlane(ldsb + LDS_K + (wid >> 2) * 8192 + ((2 * wid) & 7) * 1024), vdst = (unsigned)__builtin_amdgcn_readfirstlane(ldsb + LDS_V + (wid >> 1) * 4096 + (2 * (wid & 1)) * 1024);
    const unsigned qdst = (unsigned)__builtin_amdgcn_readfirstlane(ldsb + LDS_QS + wid * 4096);
#pragma unroll
    for (int p = 0; p < 4; ++p) glds16(qsrc + (size_t)(8 * p) * D, qdst + p * 1024);
#pragma unroll
    for (int t = 0; t < 2; ++t) { const size_t o = (size_t)t * 64 * 128;
        glds16(ksrc + o, kdst + t * 16384); glds16(ksrc + o + 8 * 128, kdst + t * 16384 + 1024); glds16(vsrc + o, vdst + t * 16384); glds16(vsrc + o + 16 * 128, vdst + t * 16384 + 1024); }
}
__device__ __forceinline__ void attn_unit(int b, int h, int qb, const bf16_t* Q, const bf16_t* K, const bf16_t* V, bf16_t* O, LAS unsigned char* lds, float lam, const float* subg, bool has_next, int nb, int nh, int nqb) {
    const int tid = threadIdx.x, lane = tid & 63, r32 = lane & 31, hi = lane >> 5;
    const int wid = __builtin_amdgcn_readfirstlane(tid >> 6), ch = wid >> 2, s = (wid >> 1) & 1, qh = wid & 1, pair = ch * 2 + qh;
    const int NT = 2 * qb + 2, ntw = 2 * qb + 1 + ch;
    const size_t rowb = (size_t)b * SEQ;
    const int q0 = qb * 128 + ch * 64 + qh * 32;
    const size_t hb = ((size_t)(b * 8 + h) * SEQ) * 128;
    const bf16_t* ksrc = K + hb + (8 * ((2 * wid) & 7) + (lane >> 3)) * 128 + (wid >> 2) * 64 + ((lane & 7) ^ (lane >> 3)) * 8;
    const bf16_t* vsrc = V + hb + (32 * (wid & 1) + (lane >> 2)) * 128 + 32 * (wid >> 1) + (lane & 3) * 8;
    const unsigned ldsb = (unsigned)(uintptr_t)lds;
    const unsigned kdst = ldsb + LDS_K + (wid >> 2) * 8192 + ((2 * wid) & 7) * 1024, vdst = ldsb + LDS_V + (wid >> 1) * 4096 + (2 * (wid & 1)) * 1024;
#define ATT_DMA(t, ks_, vs_) do { const size_t _o = (size_t)(t) * 64 * 128; \
        glds16(ksrc + _o, (unsigned)__builtin_amdgcn_readfirstlane(kdst + (ks_))); glds16(ksrc + _o + 8 * 128, (unsigned)__builtin_amdgcn_readfirstlane(kdst + (ks_) + 1024)); \
        glds16(vsrc + _o, (unsigned)__builtin_amdgcn_readfirstlane(vdst + (vs_))); glds16(vsrc + _o + 16 * 128, (unsigned)__builtin_amdgcn_readfirstlane(vdst + (vs_) + 1024)); } while (0)
    asm volatile("s_waitcnt vmcnt(8)" ::: "memory");
    bf16x8 qr[4];
    { const LAS unsigned char* qb_ = lds + LDS_QS + wid * 4096 + r32 * 128;
#pragma unroll
      for (int k = 0; k < 4; ++k) qr[k] = *(const LAS bf16x8*)(qb_ + (((2 * k + hi) ^ (r32 & 7)) << 4)); }
    LDS_WAIT();
    f32x16 o[4];
#pragma unroll
    for (int r = 0; r < 16; ++r) { o[0][r] = 0.f; o[1][r] = 0.f; o[2][r] = 0.f; o[3][r] = 0.f; }
    f32x16 osum;
#pragma unroll
    for (int r = 0; r < 16; ++r) osum[r] = 0.f;
    bf16x8 ones; { const short one = (short)0x3F80;
#pragma unroll
        for (int e = 0; e < 8; ++e) ones[e] = one; }
    bool refset = false;
    float mhat = 0.f;
    u32x4 pw[4];
#pragma unroll
    for (int k = 0; k < 4; ++k) pw[k] = (u32x4){0u, 0u, 0u, 0u};
    LAS float* wsf = (LAS float*)(lds + LDS_WSF2) + wid * 64;
    const LAS unsigned char* kbase = lds + LDS_K + s * 8192 + r32 * 128;
    const int kx7 = r32 & 7;
    const LAS unsigned char* vbase = lds + LDS_V + ((lane >> 4) & 1) * 32 + (lane & 3) * 8 + (4 * hi + ((lane & 15) >> 2)) * 64;
    int ks_cur = 0, ks_n2 = 32768;
    int vs_prev = 49152, vs_n2 = 32768;
    for (int t = 0; t < NT; ++t) {
        if (t + 1 < NT) asm volatile("s_waitcnt vmcnt(4)" ::: "memory"); else asm volatile("s_waitcnt vmcnt(0)" ::: "memory");
        __syncthreads();
        if (t + 2 < NT) ATT_DMA(t + 2, ks_n2, vs_n2);
        if (t < ntw) {
            const LAS unsigned char* kb = kbase + ks_cur; const LAS unsigned char* vb = vbase + vs_prev;
            bf16x8 kf[8];
#pragma unroll
            for (int d0 = 0; d0 < 4; ++d0) { const int kx = ((2 * d0 + hi) ^ kx7) << 4; kf[2 * d0] = *(const LAS bf16x8*)(kb + kx); kf[2 * d0 + 1] = *(const LAS bf16x8*)(kb + kx + 4096); }
            ATT_SB();
            v4i16_t va_l[4], va_h[4], vb_l[4], vb_h[4];
#define ATT_VRD(L_, H_, off_, k0_) do { if (t > 0) { L_[k0_] = vtr(vb + (off_) + (k0_) * 1024); H_[k0_] = vtr(vb + (off_) + (k0_) * 1024 + 512); \
                L_[(k0_) + 1] = vtr(vb + (off_) + ((k0_) + 1) * 1024); H_[(k0_) + 1] = vtr(vb + (off_) + ((k0_) + 1) * 1024 + 512); } } while (0)
            f32x16 p0, p1;
            if (!refset) {
                const f32x16 z = {0.f, 0.f, 0.f, 0.f, 0.f, 0.f, 0.f, 0.f, 0.f, 0.f, 0.f, 0.f, 0.f, 0.f, 0.f, 0.f};
                p0 = __builtin_amdgcn_mfma_f32_32x32x16_bf16(kf[0], qr[0], z, 0, 0, 0); p1 = __builtin_amdgcn_mfma_f32_32x32x16_bf16(kf[1], qr[0], z, 0, 0, 0);
            } else { const float nm = -mhat;
#pragma unroll
                for (int r = 0; r < 16; ++r) { p0[r] = nm; p1[r] = nm; }
                p0 = __builtin_amdgcn_mfma_f32_32x32x16_bf16(kf[0], qr[0], p0, 0, 0, 0); p1 = __builtin_amdgcn_mfma_f32_32x32x16_bf16(kf[1], qr[0], p1, 0, 0, 0); }
            ATT_VRD(va_l, va_h, 0, 0); ATT_SB();
            p0 = __builtin_amdgcn_mfma_f32_32x32x16_bf16(kf[2], qr[1], p0, 0, 0, 0); p1 = __builtin_amdgcn_mfma_f32_32x32x16_bf16(kf[3], qr[1], p1, 0, 0, 0); ATT_VRD(va_l, va_h, 0, 2); ATT_SB();
            p0 = __builtin_amdgcn_mfma_f32_32x32x16_bf16(kf[4], qr[2], p0, 0, 0, 0); p1 = __builtin_amdgcn_mfma_f32_32x32x16_bf16(kf[5], qr[2], p1, 0, 0, 0); ATT_VRD(vb_l, vb_h, 4096, 0); ATT_SB();
            p0 = __builtin_amdgcn_mfma_f32_32x32x16_bf16(kf[6], qr[3], p0, 0, 0, 0); p1 = __builtin_amdgcn_mfma_f32_32x32x16_bf16(kf[7], qr[3], p1, 0, 0, 0); ATT_VRD(vb_l, vb_h, 4096, 2); ATT_SB();
#undef ATT_VRD
#define ATT_MF(d0_, ks_, L_, H_) do { const bf16x8 vf_ = {L_[ks_][0], L_[ks_][1], L_[ks_][2], L_[ks_][3], H_[ks_][0], H_[ks_][1], H_[ks_][2], H_[ks_][3]}; \
                o[d0_] = __builtin_amdgcn_mfma_f32_32x32x16_bf16(__builtin_bit_cast(bf16x8, pw[ks_]), vf_, o[d0_], 0, 0, 0); } while (0)
            float rm, rm2;
            if (t > 0) {
#define ATT_V2(ks_) do { va_l[ks_] = vtr(vb + 8192 + (ks_) * 1024); va_h[ks_] = vtr(vb + 8192 + (ks_) * 1024 + 512); } while (0)
#define ATT_OS(ks_) osum = __builtin_amdgcn_mfma_f32_32x32x16_bf16(__builtin_bit_cast(bf16x8, pw[ks_]), ones, osum, 0, 0, 0)
                ATT_MF(0, 0, va_l, va_h); ATT_SB(); ATT_MF(0, 1, va_l, va_h); ATT_V2(0); ATT_SB(); ATT_MF(0, 2, va_l, va_h); ATT_V2(1); ATT_SB(); ATT_MF(0, 3, va_l, va_h); ATT_V2(2); ATT_SB();
#define ATT_MX(r_) do { rm = max3f(rm, p0[r_], p1[r_]); rm2 = max3f(rm2, p0[(r_) + 1], p1[(r_) + 1]); } while (0)
                ATT_OS(0); ATT_V2(3); rm = max3f(p0[0], p1[0], p0[1]); rm2 = max3f(p1[1], p0[2], p1[2]); ATT_MX(3); ATT_SB();
                ATT_OS(1); ATT_MX(5); ATT_MX(7); ATT_SB(); ATT_OS(2); ATT_MX(9); ATT_MX(11); ATT_SB(); ATT_OS(3); ATT_MX(13); rm = max3f(rm, rm2, p0[15]); rm = max3f(rm, p1[15], p1[15]); ATT_SB();
#undef ATT_OS
#undef ATT_V2
            } else {
                rm = max3f(p0[0], p1[0], p0[1]); rm2 = max3f(p1[1], p0[2], p1[2]);
                ATT_MX(3); ATT_MX(5); ATT_MX(7); ATT_MX(9); ATT_MX(11); ATT_MX(13);
                rm = max3f(rm, rm2, p0[15]); rm = max3f(rm, p1[15], p1[15]);
            }
#undef ATT_MX
            rm = swap_max(rm);
            if (__builtin_expect(__any(rm > THR), 0)) {
                const float dl = fmaxf(rm, 0.f); mhat += dl; refset = true;
#pragma unroll
                for (int r = 0; r < 16; ++r) { p0[r] -= dl; p1[r] -= dl; }
                const float f = fexp2(-dl);
#pragma unroll
                for (int k = 0; k < 4; ++k) { pw[k].x = scale_pk(pw[k].x, f); pw[k].y = scale_pk(pw[k].y, f); pw[k].z = scale_pk(pw[k].z, f); pw[k].w = scale_pk(pw[k].w, f); }
                if (hi == 0) wsf[r32] = f;
                LDS_WAIT();
#pragma unroll
                for (int r = 0; r < 16; ++r) { const float fr = wsf[crow(r, hi)]; o[0][r] *= fr; o[1][r] *= fr; o[2][r] *= fr; o[3][r] *= fr; osum[r] *= fr; }
                LDS_WAIT();
            }
            ATT_SB();
            u32x4 pn[4];
#define ATT_GAP(i) do { const float e0_ = fexp2((i) < 8 ? p0[2 * ((i) & 7)] : p1[2 * ((i) & 7)]), e1_ = fexp2((i) < 8 ? p0[2 * ((i) & 7) + 1] : p1[2 * ((i) & 7) + 1]); \
                unsigned w_ = cvtpk(e0_, e1_); asm volatile("" : "+v"(w_)); pn[(i) >> 2][(i) & 3] = w_; } while (0)
            if (t > 0) {
#define ATT_V3(ks_) do { vb_l[ks_] = vtr(vb + 12288 + (ks_) * 1024); vb_h[ks_] = vtr(vb + 12288 + (ks_) * 1024 + 512); } while (0)
                ATT_MF(1, 0, vb_l, vb_h); ATT_GAP(0); ATT_SB(); ATT_MF(1, 1, vb_l, vb_h); ATT_GAP(1); ATT_V3(0); ATT_SB(); ATT_MF(1, 2, vb_l, vb_h); ATT_GAP(2); ATT_V3(1); ATT_SB(); ATT_MF(1, 3, vb_l, vb_h); ATT_GAP(3); ATT_V3(2); ATT_SB();
                ATT_MF(2, 0, va_l, va_h); ATT_GAP(4); ATT_GAP(5); ATT_V3(3); ATT_SB();
#undef ATT_V3
                ATT_MF(2, 1, va_l, va_h); ATT_GAP(6); ATT_SB(); ATT_MF(2, 2, va_l, va_h); ATT_GAP(7); ATT_GAP(8); ATT_SB(); ATT_MF(2, 3, va_l, va_h); ATT_GAP(9); ATT_SB();
                ATT_MF(3, 0, vb_l, vb_h); ATT_GAP(10); ATT_GAP(11); ATT_SB(); ATT_MF(3, 1, vb_l, vb_h); ATT_GAP(12); ATT_SB(); ATT_MF(3, 2, vb_l, vb_h); ATT_GAP(13); ATT_GAP(14); ATT_SB(); ATT_MF(3, 3, vb_l, vb_h); ATT_GAP(15); ATT_SB();
            } else {
                ATT_GAP(0); ATT_GAP(1); ATT_GAP(2); ATT_GAP(3); ATT_GAP(4); ATT_GAP(5); ATT_GAP(6); ATT_GAP(7);
                ATT_GAP(8); ATT_GAP(9); ATT_GAP(10); ATT_GAP(11); ATT_GAP(12); ATT_GAP(13); ATT_GAP(14); ATT_GAP(15);
            }
#undef ATT_GAP
#undef ATT_MF
#pragma unroll
            for (int k = 0; k < 4; ++k) pw[k] = pn[k];
        } else {
            pv_plain(o, vbase + vs_prev, pw); { _Pragma("unroll") for (int ks = 0; ks < 4; ++ks) osum = __builtin_amdgcn_mfma_f32_32x32x16_bf16(__builtin_bit_cast(bf16x8, pw[ks]), ones, osum, 0, 0, 0); }
        }
        ks_cur = (ks_cur == 32768) ? 0 : ks_cur + 16384; ks_n2 = (ks_n2 == 32768) ? 0 : ks_n2 + 16384;
        vs_prev = (vs_prev == 49152) ? 0 : vs_prev + 16384; vs_n2 = (vs_n2 == 49152) ? 0 : vs_n2 + 16384;
    }
    if (ntw == NT) { pv_plain(o, vbase + vs_prev, pw); _Pragma("unroll") for (int ks = 0; ks < 4; ++ks) osum = __builtin_amdgcn_mfma_f32_32x32x16_bf16(__builtin_bit_cast(bf16x8, pw[ks]), ones, osum, 0, 0, 0); }
#undef ATT_DMA
#pragma unroll
    for (int r = 0; r < 16; ++r) { const float fr = __builtin_amdgcn_rcpf(osum[r]); o[0][r] *= fr; o[1][r] *= fr; o[2][r] *= fr; o[3][r] *= fr; }
    LAS unsigned* X = (LAS unsigned*)(lds + LDS_X2 + pair * 8192);
    if (s == 0) {
#pragma unroll
        for (int d0 = 0; d0 < 4; ++d0)
#pragma unroll
            for (int rr = 0; rr < 4; ++rr) X[(d0 * 4 + rr) * 64 + lane] = cvtpk(o[d0][8 + 2 * rr], o[d0][8 + 2 * rr + 1]);
    } else {
#pragma unroll
        for (int d0 = 0; d0 < 4; ++d0)
#pragma unroll
            for (int rr = 0; rr < 4; ++rr) X[1024 + (d0 * 4 + rr) * 64 + lane] = cvtpk(o[d0][2 * rr], o[d0][2 * rr + 1]);
    }
    __syncthreads();
    if (has_next) attn_open(nb, nh, nqb, Q, K, V, lds);
    bf16_t* Ob = O + (rowb + q0) * D + h * 128;
    if (s == 0) attn_tail_half<0, true>(o, X + 1024, lam, subg, Ob, lane, r32, hi);
    else attn_tail_half<8, false>(o, X, lam, subg, Ob + (size_t)16 * D, lane, r32, hi);
}
}
__device__ __forceinline__ void phase_attn_flash(const Args& a, const Bufs& B, LAS unsigned char* lds, bf16_t* YOUT, int xmap) {
    const int lane = threadIdx.x & 63;
    const float lam = expf(wave_sum(a.in[10][lane] * a.in[11][lane])) - expf(wave_sum(a.in[12][lane] * a.in[13][lane])) + LAM_INIT;
    const int G = gridDim.x, bx = blockIdx.x;
    if (G == 256) {
        const int x = xmap & 7, j32 = xmap >> 3, half = j32 >> 4, j = j32 & 15;
        { const int bh0 = x * 16 + half; att::attn_open(bh0 >> 3, bh0 & 7, j, B.Q, B.K, B.V, lds); }
        for (int i = 0; i < 8; ++i) { const int bh = x * 16 + 2 * i + half, qb = (i & 1) ? (15 - j) : j, bhn = bh + 2, qbn = (i & 1) ? j : (15 - j);
            att::attn_unit(bh >> 3, bh & 7, qb, B.Q, B.K, B.V, YOUT, lds, lam, a.in[14], i < 7, bhn >> 3, bhn & 7, qbn); }
    } else {
        for (int u = bx; u < BATCH * 8 * 16; u += G) { att::attn_open(u >> 7, (u >> 4) & 7, u & 15, B.Q, B.K, B.V, lds); att::attn_unit(u >> 7, (u >> 4) & 7, u & 15, B.Q, B.K, B.V, YOUT, lds, lam, a.in[14], false, 0, 0, 0); }
    }
}


namespace rnn {
constexpr int XR_STRIDE = 68, TILE_BYTES = 32 * XR_STRIDE * 4 + 32 * 64 * 4  , LDS_TOT = 8 * TILE_BYTES  , LDS_CIN = LDS_TOT + 8192;
struct Consts { bf16x8 bfr[2][2][4]; float ba[2], bx[2], c8sp[2]; };
__device__ __forceinline__ void rnn_setup(const Args& a, int blk, Consts& C) {
    const int lane = threadIdx.x & 63, r32 = lane & 31, hi = lane >> 5, c0 = blk * 64;
#pragma unroll
    for (int g = 0; g < 2; ++g) { const float* W = a.in[g == 0 ? 5 : 7] + (size_t)blk * 4096;
#pragma unroll
        for (int nt = 0; nt < 2; ++nt)
#pragma unroll
            for (int ks = 0; ks < 4; ++ks) { const float* wp = W + (16 * ks + 8 * hi) * 64 + 32 * nt + r32; u32x4 pk;
                pk.x = pk2(-LOG2E * wp[0], -LOG2E * wp[64]); pk.y = pk2(-LOG2E * wp[128], -LOG2E * wp[192]); pk.z = pk2(-LOG2E * wp[256], -LOG2E * wp[320]); pk.w = pk2(-LOG2E * wp[384], -LOG2E * wp[448]);
                C.bfr[g][nt][ks] = __builtin_bit_cast(bf16x8, pk); } }
#pragma unroll
    for (int nt = 0; nt < 2; ++nt) { const int j = c0 + 32 * nt + r32; C.ba[nt] = -LOG2E * a.in[6][j]; C.bx[nt] = -LOG2E * a.in[8][j]; C.c8sp[nt] = 8.0f * log1pf(expf(-a.in[9][j])) * LOG2E; }
}
__device__ __forceinline__ void rnn_item(const Args& a, const Bufs& B, LAS unsigned char* lds, int b, int blk, bf16_t* YOUT, const Consts& C) {
    const int tid = threadIdx.x, lane = tid & 63, r32 = lane & 31, hi = lane >> 5, cg = lane & 7, tr = lane >> 3;
    const int w = __builtin_amdgcn_readfirstlane(tid >> 6), c0 = blk * 64;
    LAS float* XR = (LAS float*)(lds + w * TILE_BYTES);
    LAS float* AT = XR + 32 * XR_STRIDE;
    LAS float* TOT = (LAS float*)(lds + LDS_TOT);
    LAS float* CIN = (LAS float*)(lds + LDS_CIN) + w * 64;
    float carry = 0.f;
    const size_t rowb = (size_t)b * SEQ;
    u32x4 v[7];
#pragma unroll
    for (int k = 0; k < 7; ++k) { const int t = 32 * w + 4 * tr - 3 + k; v[k] = (u32x4){0u, 0u, 0u, 0u}; if (t >= 0) v[k] = *(const u32x4*)(B.UX + (rowb + t) * D + c0 + 8 * cg); }
    for (int it = 0; it < 8; ++it) {
        const int T0 = it * 256 + 32 * w;
        {
            const float* cwp = a.in[3]; const float* cbp = a.in[4];
            asm volatile("" : "+s"(cwp), "+s"(cbp));
            f32x4 w4[4][2], b4[2];
#pragma unroll
            for (int j = 0; j < 4; ++j) { w4[j][0] = *(const f32x4*)(cwp + j * D + c0 + 8 * cg); w4[j][1] = *(const f32x4*)(cwp + j * D + c0 + 8 * cg + 4); }
            b4[0] = *(const f32x4*)(cbp + c0 + 8 * cg); b4[1] = *(const f32x4*)(cbp + c0 + 8 * cg + 4);
#pragma unroll
            for (int i = 0; i < 4; ++i) { f32x4 xo[2] = {b4[0], b4[1]};
#pragma unroll
                for (int j = 0; j < 4; ++j) { const u32x4 q = v[i + j];
                    xo[0].x += w4[j][0].x * bf2f(q.x & 0xffffu); xo[0].y += w4[j][0].y * bf2f(q.x >> 16); xo[0].z += w4[j][0].z * bf2f(q.y & 0xffffu); xo[0].w += w4[j][0].w * bf2f(q.y >> 16);
                    xo[1].x += w4[j][1].x * bf2f(q.z & 0xffffu); xo[1].y += w4[j][1].y * bf2f(q.z >> 16); xo[1].z += w4[j][1].z * bf2f(q.w & 0xffffu); xo[1].w += w4[j][1].w * bf2f(q.w >> 16); }
                LAS f32x4* xp = (LAS f32x4*)(XR + (4 * tr + i) * XR_STRIDE + 8 * cg); xp[0] = xo[0]; xp[1] = xo[1]; }
        }
        if (it < 7) {
#pragma unroll
            for (int k = 0; k < 7; ++k) v[k] = *(const u32x4*)(B.UX + (rowb + T0 + 256 + 4 * tr - 3 + k) * D + c0 + 8 * cg);
        }
        LDS_WAIT();
        f32x16 acc[2][2];
#pragma unroll
        for (int g = 0; g < 2; ++g)
#pragma unroll
            for (int nt = 0; nt < 2; ++nt)
#pragma unroll
                for (int r = 0; r < 16; ++r) acc[g][nt][r] = 0.f;
#pragma unroll
        for (int ks = 0; ks < 4; ++ks) { const LAS f32x4* ap = (const LAS f32x4*)(XR + r32 * XR_STRIDE + 16 * ks + 8 * hi); const f32x4 x0 = ap[0], x1 = ap[1];
            u32x4 pk; pk.x = att::cvtpk(x0.x, x0.y); pk.y = att::cvtpk(x0.z, x0.w); pk.z = att::cvtpk(x1.x, x1.y); pk.w = att::cvtpk(x1.z, x1.w);
            const bf16x8 af = __builtin_bit_cast(bf16x8, pk);
#pragma unroll
            for (int g = 0; g < 2; ++g)
#pragma unroll
                for (int nt = 0; nt < 2; ++nt) acc[g][nt] = __builtin_amdgcn_mfma_f32_32x32x16_bf16(af, C.bfr[g][nt][ks], acc[g][nt], 0, 0, 0); }
#pragma unroll
        for (int nt = 0; nt < 2; ++nt)
#pragma unroll
            for (int r = 0; r < 16; ++r) { const int t = att::crow(r, hi), j = 32 * nt + r32;
                const float rg = __builtin_amdgcn_rcpf(1.0f + fexp2(acc[0][nt][r] + C.ba[nt])), ig = __builtin_amdgcn_rcpf(1.0f + fexp2(acc[1][nt][r] + C.bx[nt]));
                const float av = fexp2(-C.c8sp[nt] * rg);
                const float om = __builtin_fmaf(-av, av, 1.0f);
                const float xr = XR[t * XR_STRIDE + j];
                XR[t * XR_STRIDE + j] = __builtin_amdgcn_sqrtf(om) * ig * xr; AT[t * 64 + j] = av; }
        LDS_WAIT();
        u32x4 gv[4];
#pragma unroll
        for (int i = 0; i < 4; ++i) gv[i] = *(const u32x4*)(B.GG + (rowb + T0 + 4 * tr + i) * D + c0 + 8 * cg);
        { float h = 0.f, pc = 1.f;
#pragma unroll
            for (int tb = 0; tb < 32; tb += 8) { float av[8], uv[8];
#pragma unroll
                for (int t = 0; t < 8; ++t) { av[t] = AT[(tb + t) * 64 + lane]; uv[t] = XR[(tb + t) * XR_STRIDE + lane]; }
#pragma unroll
                for (int t = 0; t < 8; ++t) { h = av[t] * h + uv[t]; pc *= av[t]; uv[t] = h; av[t] = pc; }
#pragma unroll
                for (int t = 0; t < 8; ++t) { XR[(tb + t) * XR_STRIDE + lane] = uv[t]; AT[(tb + t) * 64 + lane] = av[t]; } }
            LAS float* tp = TOT + ((it & 1) * 8 + w) * 128; tp[lane] = pc; tp[64 + lane] = h; }
        __syncthreads();
        { float c = carry, cin = 0.f;
#pragma unroll
            for (int ww = 0; ww < 8; ++ww) { const LAS float* tp = TOT + ((it & 1) * 8 + ww) * 128; if (ww == w) cin = c; c = tp[lane] * c + tp[64 + lane]; }
            carry = c; CIN[lane] = cin; }
        LDS_WAIT();
        { const LAS f32x4* cp = (const LAS f32x4*)(CIN + 8 * cg); const f32x4 c0v = cp[0], c1v = cp[1];
#pragma unroll
            for (int i = 0; i < 4; ++i) { const int row = 4 * tr + i;
                const LAS f32x4* hp = (const LAS f32x4*)(XR + row * XR_STRIDE + 8 * cg); const LAS f32x4* pp = (const LAS f32x4*)(AT + row * 64 + 8 * cg);
                const f32x4 h0 = hp[0], h1 = hp[1], p0 = pp[0], p1 = pp[1];
                const size_t go = (rowb + T0 + row) * D + c0 + 8 * cg; const u32x4 g4 = gv[i];
                u32x4 o;
                o.x = pk2((h0.x + p0.x * c0v.x) * bf2f(g4.x & 0xffffu), (h0.y + p0.y * c0v.y) * bf2f(g4.x >> 16));
                o.y = pk2((h0.z + p0.z * c0v.z) * bf2f(g4.y & 0xffffu), (h0.w + p0.w * c0v.w) * bf2f(g4.y >> 16));
                o.z = pk2((h1.x + p1.x * c1v.x) * bf2f(g4.z & 0xffffu), (h1.y + p1.y * c1v.y) * bf2f(g4.z >> 16));
                o.w = pk2((h1.z + p1.z * c1v.z) * bf2f(g4.w & 0xffffu), (h1.w + p1.w * c1v.w) * bf2f(g4.w >> 16));
                *(u32x4*)(YOUT + go) = o; }
        }
        LDS_WAIT();
    }
}
}
__device__ __forceinline__ int rnn_batch(int xmap) { return 2 * (xmap & 7) + (xmap >> 7); }
__device__ __forceinline__ int rnn_blk(int xmap) { return (xmap >> 3) & 15; }

__device__ __forceinline__ void unpack8(const u32x4& w, f32x4& a, f32x4& b) {
    a = (f32x4){bf2f(w.x & 0xffffu), bf2f(w.x >> 16), bf2f(w.y & 0xffffu), bf2f(w.y >> 16)}; b = (f32x4){bf2f(w.z & 0xffffu), bf2f(w.z >> 16), bf2f(w.w & 0xffffu), bf2f(w.w >> 16)}; }
__device__ __forceinline__ u32x4 pack8(const f32x4& a, const f32x4& b) { u32x4 w; w.x = att::cvtpk(a.x, a.y); w.y = att::cvtpk(a.z, a.w); w.z = att::cvtpk(b.x, b.y); w.w = att::cvtpk(b.z, b.w); return w; }
__device__ __forceinline__ f32x4 unpack_u8(unsigned w) { return (f32x4){(float)(w & 0xffu), (float)((w >> 8) & 0xffu), (float)((w >> 16) & 0xffu), (float)(w >> 24)} * (1.0f / 255.0f); }
__device__ __forceinline__ float gelu_fast(float v) { constexpr float C0 = -2.0f * LOG2E * 0.7978845608028654f, C1 = C0 * 0.044715f; return v * __builtin_amdgcn_rcpf(1.0f + fexp2(v * __builtin_fmaf(v * v, C1, C0))); }
__device__ __forceinline__ float sig255_pre(float acc) { return __builtin_amdgcn_rcpf(__builtin_fmaf(fexp2(acc), 1.0f / 255.0f, 1.0f / 255.0f)); }
__device__ __forceinline__ unsigned pack_sig_u8(const f32x4& g) {
    unsigned w = __builtin_amdgcn_cvt_pk_u8_f32(sig255_pre(g.x), 0u, 0u); w = __builtin_amdgcn_cvt_pk_u8_f32(sig255_pre(g.y), 1u, w); w = __builtin_amdgcn_cvt_pk_u8_f32(sig255_pre(g.z), 2u, w); return __builtin_amdgcn_cvt_pk_u8_f32(sig255_pre(g.w), 3u, w); }
__device__ __forceinline__ f32x4 map_gelu(const f32x4& v) { return (f32x4){gelu_fast(v.x), gelu_fast(v.y), gelu_fast(v.z), gelu_fast(v.w)}; }

__device__ __forceinline__ unsigned dpp_hi(unsigned keep, unsigned src) { return (unsigned)__builtin_amdgcn_update_dpp((int)keep, (int)src, 0x128, 0xF, 0xC, false); }
__device__ __forceinline__ unsigned dpp_lo(unsigned keep, unsigned src) { return (unsigned)__builtin_amdgcn_update_dpp((int)keep, (int)src, 0x128, 0xF, 0x3, false); }
__device__ __forceinline__ void xrow8(u32x4& p0, u32x4& p1) {
    u32x4 a, b;
    a.x = dpp_hi(p0.x, p1.x); a.y = dpp_hi(p0.y, p1.y); a.z = dpp_hi(p0.z, p1.z); a.w = dpp_hi(p0.w, p1.w);
    b.x = dpp_lo(p1.x, p0.x); b.y = dpp_lo(p1.y, p0.y); b.z = dpp_lo(p1.z, p0.z); b.w = dpp_lo(p1.w, p0.w);
    p0 = a; p1 = b;
}
__device__ __forceinline__ void xrow8f(f32x4& a0, f32x4& a1, f32x4& b0, f32x4& b1) {
    u32x4 p = __builtin_bit_cast(u32x4, a0), q = __builtin_bit_cast(u32x4, b0); xrow8(p, q); a0 = __builtin_bit_cast(f32x4, p); b0 = __builtin_bit_cast(f32x4, q);
    p = __builtin_bit_cast(u32x4, a1); q = __builtin_bit_cast(u32x4, b1); xrow8(p, q); a1 = __builtin_bit_cast(f32x4, p); b1 = __builtin_bit_cast(f32x4, q);
}
struct EpiInProj {
    static constexpr bool PERM = true, AFTER_DRAIN = false; Bufs B;
    __device__ __forceinline__ void operator()(const pg8::f32x4 (&acc)[2][2][4][2], const pg8::Unit& u, int wr, int wc, int fr, int fq) const {
        const int seg = u.pn >> 2, tp = u.pn & 3, row0 = u.pm * 256 + wr * 64 + fr;
        const int rowx = u.pm * 256 + wr * 64 + (fr & 7), pc8 = 8 * (4 * (fr >> 3) + fq);
        if (seg == 2 || seg == 3) {
            const float sc = (seg == 2) ? QSCALE : 1.0f;
            const bool hm = (seg == 3);
#pragma unroll
            for (int ai = 0; ai < 2; ++ai)
#pragma unroll
                for (int m = 0; m < 4; ++m) { const int row = row0 + ai * 128 + m * 16, pos = row & (SEQ - 1), rx = rowx + ai * 128 + m * 16;
                    const f32x4* cp = (const f32x4*)(B.ropec + pos * 32 + 8 * fq); const f32x4* sp = (const f32x4*)(B.ropes + pos * 32 + 8 * fq);
                    const f32x4 c0 = cp[0], c1 = cp[1], s0 = sp[0], s1 = sp[1];
                    const f32x4 a0 = acc[ai][0][m][0], a1 = acc[ai][0][m][1], b0 = acc[ai][1][m][0], b1 = acc[ai][1][m][1];
                    const f32x4 o0 = (a0 * c0 - b0 * s0) * sc, o1 = (a1 * c1 - b1 * s1) * sc, p0 = (b0 * c0 + a0 * s0) * sc, p1 = (b1 * c1 + a1 * s1) * sc;
                    u32x4 w0 = pack8(o0, o1), w1 = pack8(p0, p1); xrow8(w0, w1);
                    bf16_t* rp = hm ? B.K + ((size_t)((rx >> 11) * 8 + 2 * tp + (wc >> 1)) * SEQ + (rx & (SEQ - 1))) * 128 + (wc & 1) * 64 + pc8 : B.Q + (size_t)rx * D + (4 * tp + wc) * 64 + pc8;
                    *(u32x4*)rp = w0; *(u32x4*)(rp + (hm ? 8 * 128 : 8 * D)) = w1; }
        } else if (seg >= 5) {
            unsigned char* gb = ((seg == 5) ? B.SR : B.SA) + tp * 256 + wc * 64 + 16 * fq;
#pragma unroll
            for (int ai = 0; ai < 2; ++ai)
#pragma unroll
                for (int m = 0; m < 4; ++m) { unsigned char* rp = gb + (size_t)(row0 + ai * 128 + m * 16) * D;
                    *(u32x4*)rp = (u32x4){pack_sig_u8(acc[ai][0][m][0]), pack_sig_u8(acc[ai][0][m][1]), pack_sig_u8(acc[ai][1][m][0]), pack_sig_u8(acc[ai][1][m][1])}; }
        } else if (seg == 4) {
#pragma unroll
            for (int ai = 0; ai < 2; ++ai)
#pragma unroll
                for (int m = 0; m < 4; ++m) { const int rx = rowx + ai * 128 + m * 16;
                    u32x4 w0 = pack8(acc[ai][0][m][0], acc[ai][0][m][1]), w1 = pack8(acc[ai][1][m][0], acc[ai][1][m][1]); xrow8(w0, w1);
                    bf16_t* rp = B.V + ((size_t)((rx >> 11) * 8 + 2 * tp + (wc >> 1)) * SEQ + (rx & (SEQ - 1))) * 128 + (wc & 1) * 64 + pc8;
                    *(u32x4*)rp = w0; *(u32x4*)(rp + 8 * 128) = w1; }
        } else {
            bf16_t* base = ((seg == 0) ? B.UX : B.GG) + tp * 256 + wc * 64 + pc8;
#pragma unroll
            for (int ai = 0; ai < 2; ++ai)
#pragma unroll
                for (int m = 0; m < 4; ++m) { bf16_t* rp = base + (size_t)(rowx + ai * 128 + m * 16) * D;
                    f32x4 a0 = acc[ai][0][m][0], a1 = acc[ai][0][m][1], b0 = acc[ai][1][m][0], b1 = acc[ai][1][m][1];
                    if (seg == 1) { a0 = map_gelu(a0); a1 = map_gelu(a1); b0 = map_gelu(b0); b1 = map_gelu(b1); }
                    u32x4 w0 = pack8(a0, a1), w1 = pack8(b0, b1); xrow8(w0, w1);
                    *(u32x4*)rp = w0; *(u32x4*)(rp + 8 * D) = w1; }
        }
    }
};
struct EpiBrA {
    static constexpr bool PERM = true, AFTER_DRAIN = false; Bufs B;
    __device__ __forceinline__ void operator()(const pg8::f32x4 (&acc)[2][2][4][2], const pg8::Unit& u, int wr, int wc, int fr, int fq) const {
        const int rowx = u.pm * 256 + wr * 64 + (fr & 7), col0 = u.pn * 256 + wc * 64 + 8 * (4 * (fr >> 3) + fq);
#pragma unroll
        for (int ai = 0; ai < 2; ++ai)
#pragma unroll
            for (int m = 0; m < 4; ++m) { const size_t o = (size_t)(rowx + ai * 128 + m * 16) * D + col0;
                const u32x2 ga = *(const u32x2*)(B.SR + o), gb = *(const u32x2*)(B.SR + o + 8 * D);
                f32x4 a0 = acc[ai][0][m][0], a1 = acc[ai][0][m][1], b0 = acc[ai][1][m][0], b1 = acc[ai][1][m][1]; xrow8f(a0, a1, b0, b1);
                *(u32x4*)(B.T + o) = pack8(unpack_u8(ga.x) * a0, unpack_u8(ga.y) * a1); *(u32x4*)(B.T + o + 8 * D) = pack8(unpack_u8(gb.x) * b0, unpack_u8(gb.y) * b1); }
    }
};
struct EpiBrB {
    static constexpr bool PERM = true, AFTER_DRAIN = false; Bufs B;
    __device__ __forceinline__ void operator()(const pg8::f32x4 (&acc)[2][2][4][2], const pg8::Unit& u, int wr, int wc, int fr, int fq) const {
        const int rowx = u.pm * 256 + wr * 64 + (fr & 7), col0 = u.pn * 256 + wc * 64 + 8 * (4 * (fr >> 3) + fq);
#pragma unroll
        for (int ai = 0; ai < 2; ++ai)
#pragma unroll
            for (int m = 0; m < 4; ++m) { const size_t o = (size_t)(rowx + ai * 128 + m * 16) * D + col0;
                const u32x2 ga = *(const u32x2*)(B.SA + o), gb = *(const u32x2*)(B.SA + o + 8 * D); const u32x4 ta = *(const u32x4*)(B.T + o), tb = *(const u32x4*)(B.T + o + 8 * D);
                f32x4 a0 = acc[ai][0][m][0], a1 = acc[ai][0][m][1], b0 = acc[ai][1][m][0], b1 = acc[ai][1][m][1]; xrow8f(a0, a1, b0, b1);
                f32x4 t0, t1; unpack8(ta, t0, t1); *(u32x4*)(B.MG + o) = pack8(t0 + unpack_u8(ga.x) * a0, t1 + unpack_u8(ga.y) * a1);
                unpack8(tb, t0, t1); *(u32x4*)(B.MG + o + 8 * D) = pack8(t0 + unpack_u8(gb.x) * b0, t1 + unpack_u8(gb.y) * b1); }
    }
};
struct EpiOut {
    static constexpr bool PERM = true, AFTER_DRAIN = false; Bufs B;
    __device__ __forceinline__ void operator()(const pg8::f32x4 (&acc)[2][2][4][2], const pg8::Unit& u, int wr, int wc, int fr, int fq) const {
        const int rowx = u.pm * 256 + wr * 64 + (fr & 7), col0 = u.pn * 256 + wc * 64 + 8 * (4 * (fr >> 3) + fq);
#pragma unroll
        for (int ai = 0; ai < 2; ++ai)
#pragma unroll
            for (int m = 0; m < 4; ++m) { const int row = rowx + ai * 128 + m * 16; const size_t o = (size_t)row * D + col0;
                const f32x4 xa0 = *(const f32x4*)(B.x + o), xa1 = *(const f32x4*)(B.x + o + 4), xb0 = *(const f32x4*)(B.x + o + 8 * D), xb1 = *(const f32x4*)(B.x + o + 8 * D + 4);
                f32x4 a0 = acc[ai][0][m][0], a1 = acc[ai][0][m][1], b0 = acc[ai][1][m][0], b1 = acc[ai][1][m][1]; xrow8f(a0, a1, b0, b1);
                a0 += xa0; a1 += xa1; b0 += xb0; b1 += xb1;
                *(u32x4*)(B.X1B + o) = pack8(a0, a1); *(u32x4*)(B.X1B + o + 8 * D) = pack8(b0, b1);
                float sa = ((a0.x * a0.x + a0.y * a0.y) + (a0.z * a0.z + a0.w * a0.w)) + ((a1.x * a1.x + a1.y * a1.y) + (a1.z * a1.z + a1.w * a1.w));
                float sb = ((b0.x * b0.x + b0.y * b0.y) + (b0.z * b0.z + b0.w * b0.w)) + ((b1.x * b1.x + b1.y * b1.y) + (b1.z * b1.z + b1.w * b1.w));
                sa += __shfl_xor(sa, 8); sb += __shfl_xor(sb, 8); sa += __shfl_xor(sa, 16); sb += __shfl_xor(sb, 16); sa += __shfl_xor(sa, 32); sb += __shfl_xor(sb, 32);
                if (fq == 0) atomicAdd(B.ss1 + row + (fr & 8), (fr & 8) ? sb : sa); }
    }
};
struct EpiMlp1 {
    static constexpr bool PERM = true, AFTER_DRAIN = false; Bufs B;
    __device__ __forceinline__ void operator()(const pg8::f32x4 (&acc)[2][2][4][2], const pg8::Unit& u, int wr, int wc, int fr, int fq) const {
        const int row0 = u.pm * 256 + wr * 64 + (fr & 7), col0 = u.pn * 256 + wc * 64 + 8 * (4 * (fr >> 3) + fq);
        const f32x4 z4 = {0.f, 0.f, 0.f, 0.f};
#pragma unroll
        for (int ai = 0; ai < 2; ++ai)
#pragma unroll
            for (int m = 0; m < 4; ++m) { bf16_t* rp = B.HID + (size_t)(row0 + ai * 128 + m * 16) * DFF + col0;
                const f32x4 a0 = __builtin_elementwise_max(acc[ai][0][m][0], z4), a1 = __builtin_elementwise_max(acc[ai][0][m][1], z4), b0 = __builtin_elementwise_max(acc[ai][1][m][0], z4), b1 = __builtin_elementwise_max(acc[ai][1][m][1], z4);
                u32x4 p0 = pack8(a0 * a0, a1 * a1), p1 = pack8(b0 * b0, b1 * b1); xrow8(p0, p1);
                *(u32x4*)rp = p0; *(u32x4*)(rp + 8 * DFF) = p1; }
    }
};
struct EpiMlp2 {
    static constexpr bool PERM = true, AFTER_DRAIN = false; Bufs B; const float* gfin; unsigned* tmo;
    __device__ __forceinline__ void operator()(pg8::f32x4 (&acc)[2][2][4][2], const pg8::Unit& u, int wr, int wc, int fr, int fq) const {
        const int rowx = u.pm * 256 + wr * 64 + (fr & 7), col0 = u.pn * 256 + wc * 64 + 8 * (4 * (fr >> 3) + fq);
#pragma unroll
        for (int ai = 0; ai < 2; ++ai)
#pragma unroll
            for (int m = 0; m < 4; ++m) { const int row = rowx + ai * 128 + m * 16; const size_t o = (size_t)row * D + col0;
                const float ra = __builtin_amdgcn_rcpf(__hip_atomic_load(B.ss1 + row, __ATOMIC_RELAXED, __HIP_MEMORY_SCOPE_AGENT) * (1.0f / D) + NORM_EPS);
                const float rb = __builtin_amdgcn_rcpf(__hip_atomic_load(B.ss1 + row + 8, __ATOMIC_RELAXED, __HIP_MEMORY_SCOPE_AGENT) * (1.0f / D) + NORM_EPS);
                const u32x4 xa = *(const u32x4*)(B.X1B + o), xb = *(const u32x4*)(B.X1B + o + 8 * D);
                f32x4 &a0 = acc[ai][0][m][0], &a1 = acc[ai][0][m][1], &b0 = acc[ai][1][m][0], &b1 = acc[ai][1][m][1]; xrow8f(a0, a1, b0, b1);
                f32x4 x0, x1; unpack8(xa, x0, x1); a0 = x0 + a0 * ra; a1 = x1 + a1 * ra; unpack8(xb, x0, x1); b0 = x0 + b0 * rb; b1 = x1 + b1 * rb;
                float sa = ((a0.x * a0.x + a0.y * a0.y) + (a0.z * a0.z + a0.w * a0.w)) + ((a1.x * a1.x + a1.y * a1.y) + (a1.z * a1.z + a1.w * a1.w));
                float sb = ((b0.x * b0.x + b0.y * b0.y) + (b0.z * b0.z + b0.w * b0.w)) + ((b1.x * b1.x + b1.y * b1.y) + (b1.z * b1.z + b1.w * b1.w));
                sa += __shfl_xor(sa, 8); sb += __shfl_xor(sb, 8); sa += __shfl_xor(sa, 16); sb += __shfl_xor(sb, 16); sa += __shfl_xor(sa, 32); sb += __shfl_xor(sb, 32);
                if (fq == 0) atomicAdd(B.ss2 + row + (fr & 8), (fr & 8) ? sb : sa); }
        asm volatile("s_waitcnt vmcnt(0)" ::: "memory");
        __syncthreads();
        if (threadIdx.x == 0) { unsigned* c = B.pcnt + u.pm * 16;
            (void)__hip_atomic_fetch_add(c, 1u, __ATOMIC_RELAXED, __HIP_MEMORY_SCOPE_AGENT);
            unsigned sp = 0;
            while (__hip_atomic_load(c, __ATOMIC_RELAXED, __HIP_MEMORY_SCOPE_AGENT) < 4u) { __builtin_amdgcn_s_sleep(1);
                if ((++sp & 255u) == 0u) { if (__hip_atomic_load(tmo, __ATOMIC_RELAXED, __HIP_MEMORY_SCOPE_AGENT)) break; if (sp > (1u << 18)) { atomicAdd(tmo, 1u); break; } } } }
        __syncthreads();
        const f32x4 g0 = *(const f32x4*)(gfin + col0), g1 = *(const f32x4*)(gfin + col0 + 4);
        const int colf = u.pn * 256 + wc * 64 + 8 * fq + 4 * (fr >> 3);
#pragma unroll
        for (int ai = 0; ai < 2; ++ai)
#pragma unroll
            for (int m = 0; m < 4; ++m) { const int row = rowx + ai * 128 + m * 16; const size_t o = (size_t)row * D + col0;
                const float qa = __builtin_amdgcn_rsqf(__hip_atomic_load(B.ss2 + row, __ATOMIC_RELAXED, __HIP_MEMORY_SCOPE_AGENT) * (1.0f / D) + NORM_EPS);
                const float qb = __builtin_amdgcn_rsqf(__hip_atomic_load(B.ss2 + row + 8, __ATOMIC_RELAXED, __HIP_MEMORY_SCOPE_AGENT) * (1.0f / D) + NORM_EPS);
                u32x4 s1 = __builtin_bit_cast(u32x4, acc[ai][0][m][0] * qa * g0), s2 = __builtin_bit_cast(u32x4, acc[ai][0][m][1] * qa * g1); xrow8(s1, s2);
                u32x4 t1 = __builtin_bit_cast(u32x4, acc[ai][1][m][0] * qb * g0), t2 = __builtin_bit_cast(u32x4, acc[ai][1][m][1] * qb * g1); xrow8(t1, t2);
                float* op = B.out + (size_t)row * D + colf;
                *(u32x4*)op = s1; *(u32x4*)(op + 32) = s2; *(u32x4*)(op + 8 * D) = t1; *(u32x4*)(op + 8 * D + 32) = t2; }
    }
};
struct ReverseOrder {
    pg8::StaticOrder S; int nM;
    __device__ __forceinline__ bool next(int i, pg8::Unit& u) const { if (!S.next(i, u)) return false; u.pm ^= 15; return true; }
    __device__ __forceinline__ void a_ready(const pg8::Unit&) const {}
    __device__ __forceinline__ void done(const pg8::Unit&) const {}
};
template <class Epi> __device__ __forceinline__ void gemm_run_rev(LAS unsigned char* lds, const bf16_t* A, const bf16_t* Bt, int Mr, int N, int K, const Epi& E, int cu) {
    pg8::Gemm g{A, Bt, Mr, N, K}; ReverseOrder S; S.S.init(Mr, N, (int)gridDim.x, cu); S.nM = Mr / 256;
    pg8::gemm_phase<Epi, ReverseOrder, true, true>(lds, g, S, E);
}
template <class Epi> __device__ __forceinline__ void gemm_run(LAS unsigned char* lds, const bf16_t* A, const bf16_t* Bt, int Mr, int N, int K, const Epi& E, int cu) {
    pg8::Gemm g{A, Bt, Mr, N, K}; pg8::StaticOrder S; S.init(Mr, N, (int)gridDim.x, cu);
    pg8::gemm_phase<Epi, pg8::StaticOrder, true, true>(lds, g, S, E);
}

#define RLX_AGENT __ATOMIC_RELAXED, __HIP_MEMORY_SCOPE_AGENT
#define XB_TMO      128
#define XB_XCNT(j)  (256  + 64 * (j))
#define XB_XSUB(j)  (1280 + 64 * (j))
#define XB_XGEN(j)  (2304 + 64 * (j))
#define XB_TOP      3328
#define XB_TOPGEN   3392
#define XB_EVT      3456
#define XCD_BAR_WORDS 3456
#define XB_SPIN_CAP (1u << 18)

__device__ __forceinline__ unsigned xb_ld(unsigned* p)              { return __hip_atomic_load(p, __ATOMIC_RELAXED, __HIP_MEMORY_SCOPE_AGENT); }
__device__ __forceinline__ unsigned xb_add(unsigned* p, unsigned v) { return __hip_atomic_fetch_add(p, v, __ATOMIC_RELAXED, __HIP_MEMORY_SCOPE_AGENT); }
__device__ __forceinline__ unsigned xb_xcc_id() { return (unsigned)__builtin_amdgcn_s_getreg((3 << 11) | 20) & 0xFu; }
#define XB_SPIN(cond, bar) do { unsigned _sp = 0; while (cond) { __builtin_amdgcn_s_sleep(1); \
    if ((++_sp & 255u) == 0u) { if (xb_ld(&(bar)[XB_TMO])) break; if (_sp > XB_SPIN_CAP) { atomicAdd(&(bar)[XB_TMO], 1u); break; } } } } while (0)

struct XcdBarrier {
    unsigned* bar; unsigned x;
    volatile LAS unsigned* st;
};

__device__ __forceinline__ XcdBarrier xcd_barrier_post(unsigned* bar, volatile LAS unsigned* st) {
    XcdBarrier b; b.bar = bar; b.x = xb_xcc_id(); b.st = st;
    if (threadIdx.x == 0) (void)xb_add(&bar[XB_XCNT(b.x)], 1u);
    return b;
}
__device__ __forceinline__ void xcd_barrier_complete(unsigned* bar, unsigned x, unsigned& nloc, unsigned& nx) {
    const unsigned G = gridDim.x * gridDim.y * gridDim.z;
    unsigned sum, cnt, mine, sp = 0u;
    for (;;) {
        sum = 0u; cnt = 0u; mine = 0u;
#pragma unroll
        for (unsigned j = 0; j < 16; ++j) { const unsigned c = xb_ld(&bar[XB_XCNT(j)]); sum += c; cnt += (c > 0u) ? 1u : 0u; mine = (j == x) ? c : mine; }
        if (sum == G) break;
        __builtin_amdgcn_s_sleep(1);
        if ((++sp & 255u) == 0u) { if (xb_ld(&bar[XB_TMO])) break; if (sp > XB_SPIN_CAP) { atomicAdd(&bar[XB_TMO], 1u); break; } }
    }
    nloc = mine > 0u ? mine : 1u; nx = cnt > 0u ? cnt : 1u;
}

__device__ __forceinline__ void xcd_barrier(const XcdBarrier& b) {
    asm volatile("s_waitcnt vmcnt(0)" ::: "memory");
    __syncthreads();
    if (threadIdx.x == 0) {
        unsigned* bar = b.bar;
        __builtin_amdgcn_s_waitcnt(0);
        unsigned nloc = b.st[0], nx = b.st[1];
        if (nloc == 0u) { xcd_barrier_complete(bar, b.x, nloc, nx); b.st[0] = nloc; b.st[1] = nx; }
        const unsigned old = xb_add(&bar[XB_XSUB(b.x)], 1u);
        const unsigned gen = old / nloc;
        if (old + 1u == (gen + 1u) * nloc) {
            __builtin_amdgcn_fence(__ATOMIC_RELEASE, "agent");
            asm volatile("s_waitcnt vmcnt(0)" ::: "memory");
            const unsigned og = xb_add(&bar[XB_TOP], 1u);
            const unsigned tg = og / nx;
            if (og + 1u == (tg + 1u) * nx) xb_add(&bar[XB_TOPGEN], 1u);
            else XB_SPIN(xb_ld(&bar[XB_TOPGEN]) == tg, bar);
            __builtin_amdgcn_fence(__ATOMIC_ACQUIRE, "agent");
            xb_add(&bar[XB_XGEN(b.x)], 1u);
            asm volatile("s_waitcnt vmcnt(0)" ::: "memory");
        } else {
            XB_SPIN(xb_ld(&bar[XB_XGEN(b.x)]) == gen, bar);
            __builtin_amdgcn_fence(__ATOMIC_ACQUIRE, "agent");
            asm volatile("s_waitcnt vmcnt(0)" ::: "memory");
        }
    }
    __syncthreads();
}

__device__ __forceinline__ void xcd_barrier_local(const XcdBarrier& b, int mode) {
    asm volatile("s_waitcnt vmcnt(0)" ::: "memory");
    __syncthreads();
    if (threadIdx.x == 0) {
        unsigned* bar = b.bar;
        __builtin_amdgcn_s_waitcnt(0);
        unsigned nloc = b.st[0], nx = b.st[1];
        if (nloc == 0u) { xcd_barrier_complete(bar, b.x, nloc, nx); b.st[0] = nloc; b.st[1] = nx; }
        const unsigned old = xb_add(&bar[XB_XSUB(b.x)], 1u);
        const unsigned gen = old / nloc;
        if (old + 1u == (gen + 1u) * nloc) {
            if (mode == 2) XB_SPIN(xb_ld(&bar[XB_EVT]) < nx, bar);
            xb_add(&bar[XB_XGEN(b.x)], 1u);
            if (mode == 1) { __builtin_amdgcn_fence(__ATOMIC_RELEASE, "agent"); asm volatile("s_waitcnt vmcnt(0)" ::: "memory"); xb_add(&bar[XB_EVT], 1u); }
        } else XB_SPIN(xb_ld(&bar[XB_XGEN(b.x)]) == gen, bar);
        __builtin_amdgcn_fence(__ATOMIC_ACQUIRE, "agent");
        asm volatile("s_waitcnt vmcnt(0)" ::: "memory");
    }
    __syncthreads();
}

constexpr int LDS_BYTES = 155648;
constexpr int LDS_BARW = LDS_BYTES - 64;
constexpr int CW_BAR = 4096, CW_CEN = 8192;
constexpr int N_PHASES = 8;
__global__ void __launch_bounds__(NTHREADS, 2) fwd_kernel(Args a) {
    extern __shared__ __attribute__((aligned(16))) unsigned char lds_raw[];
    LAS unsigned char* lds = (LAS unsigned char*)lds_raw;
    const Bufs B = make_bufs(a);
    const int lo = a.ph_lo, hi = a.ph_hi;
    volatile LAS unsigned* barw = (volatile LAS unsigned*)(lds + LDS_BARW);
    if (threadIdx.x < 4) barw[threadIdx.x] = 0u;
    __syncthreads();
    XcdBarrier bar = xcd_barrier_post((unsigned*)(a.ws + WS_CTL) + CW_BAR, barw);
    unsigned* cen = (unsigned*)(a.ws + WS_CTL) + CW_CEN;
    int my_rank = 0; { unsigned r = 0; if (threadIdx.x == 0) r = atomicAdd(cen + 64 * bar.x, 1u); my_rank = (int)__builtin_amdgcn_readfirstlane(r); }
    if (threadIdx.x == 0) barw[2] = (unsigned)my_rank;
    __syncthreads();
    my_rank = (int)barw[2];
#define IN(k) (lo <= (k) && (k) < hi)
#define SEAM(k) do { if (IN(k) && IN((k) + 1)) xcd_barrier(bar); } while (0)
#define SEAM_X(k, mode) do { if (IN(k) && IN((k) + 1)) { if (xmode) xcd_barrier_local(bar, mode); else xcd_barrier(bar); } } while (0)
    if (IN(0)) { phase_prep(a, B, lds); } SEAM(0);
    int xmap = (int)(blockIdx.x & 7) | ((int)(blockIdx.x >> 3) << 3); bool xmode = false;
    if (hi - lo > 1) {
        int npop = 0, below = 0; bool ok = true;
        for (int q = 0; q < 16; ++q) { const unsigned c = __hip_atomic_load(cen + 64 * q, __ATOMIC_RELAXED, __HIP_MEMORY_SCOPE_AGENT); if (c) { ++npop; ok = ok && (c == 32u); if (q < (int)bar.x) ++below; } }
        if (ok && npop == 8 && gridDim.x == 256 && lo == 0 && hi == N_PHASES) { xmap = below | (my_rank << 3); xmode = true; }
    }
    const int cu = (gridDim.x == 256) ? xmap : (int)blockIdx.x;
    if (IN(1)) { EpiInProj E{B}; gemm_run(lds, B.H, B.Win, M, NIN, D, E, cu); }
    rnn::Consts rc; if (IN(2)) rnn::rnn_setup(a, rnn_blk(xmap), rc);
    SEAM_X(1, 0);
    if (IN(2)) { rnn::rnn_item(a, B, lds, rnn_batch(xmap), rnn_blk(xmap), B.GG, rc); __syncthreads();
        phase_attn_flash(a, B, lds, B.Q, xmap);
    } SEAM_X(2, 0);
    if (IN(3)) { EpiBrA E{B}; gemm_run(lds, B.GG, B.Wbr, M, D, D, E, cu); }
    if (IN(4)) { EpiBrB E{B}; gemm_run(lds, B.Q, B.Wba, M, D, D, E, cu); } SEAM_X(4, 1);
    if (IN(5)) { EpiOut E{B}; gemm_run(lds, B.MG, B.Wout, M, D, D, E, cu); } SEAM_X(5, 2);
    if (IN(6)) { EpiMlp1 E{B}; gemm_run(lds, B.X1B, B.W1, M, DFF, D, E, cu); } SEAM_X(6, 0);
    if (IN(7)) { EpiMlp2 E{B, a.in[21], (unsigned*)(a.ws + WS_CTL) + CW_BAR + XB_TMO}; gemm_run_rev(lds, B.HID, B.W2, M, D, DFF, E, cu); }
#undef SEAM_X
#undef IN
#undef SEAM
}

extern "C" void kernel_launch(void* const* d_in, const int* in_sizes, int n_in, void* d_out, int out_size, void* d_ws, size_t ws_size, hipStream_t stream) {
    static int grid = 0;
    if (grid == 0) {
        if (n_in != 22 || in_sizes[0] != M * D || out_size != M * D || ws_size < WS_END) { fprintf(stderr, "kernel_launch: unexpected shapes (n_in %d, in0 %d, out %d, ws %zu); nothing launched\n", n_in, n_in > 0 ? in_sizes[0] : -1, out_size, ws_size); grid = -1; return; }
        int dev = 0, cus = 0, per_cu = 0;
        if (hipGetDevice(&dev) != hipSuccess || hipDeviceGetAttribute(&cus, hipDeviceAttributeMultiprocessorCount, dev) != hipSuccess) { grid = -1; return; }
        if (hipFuncSetAttribute((const void*)fwd_kernel, hipFuncAttributeMaxDynamicSharedMemorySize, LDS_BYTES) != hipSuccess) { fprintf(stderr, "kernel_launch: hipFuncSetAttribute failed\n"); grid = -1; return; }
        if (hipOccupancyMaxActiveBlocksPerMultiprocessor(&per_cu, (const void*)fwd_kernel, NTHREADS, LDS_BYTES) != hipSuccess || per_cu < 1) { fprintf(stderr, "kernel_launch: occupancy query says %d blocks per CU\n", per_cu); (void)hipGetLastError(); per_cu = 1; }
        if (cus != 256) { fprintf(stderr, "kernel_launch: %d CUs; the static work orders (and the four-workgroup rendezvous of the last phase) are laid out for 256\n", cus); grid = -1; return; }
        grid = cus;
    }
    if (grid < 0) return;
    (void)hipMemsetAsync((char*)d_ws + WS_CTL, 0, CTL_ZERO_BYTES, stream);
    Args a{};
    for (int i = 0; i < 22; ++i) a.in[i] = (const float*)d_in[i];
    a.out = (float*)d_out; a.ws = (unsigned char*)d_ws;
#if MK_N_LAUNCHES == 1
    a.ph_lo = 0; a.ph_hi = N_PHASES;
    hipLaunchKernelGGL(fwd_kernel, dim3(grid), dim3(NTHREADS), LDS_BYTES, stream, a);
#else
    for (int p = 0; p < N_PHASES; ++p) { a.ph_lo = p; a.ph_hi = p + 1; hipLaunchKernelGGL(fwd_kernel, dim3(grid), dim3(NTHREADS), LDS_BYTES, stream, a); }
#endif
}
```

```cpp
#include <hip/hip_runtime.h>
#include <cstdio>
#include <cstdint>

#ifndef MK_N_LAUNCHES
#define MK_N_LAUNCHES 1
#endif

namespace pg8 {
#define PG8_LAS __attribute__((address_space(3)))
typedef unsigned short bf16_t;
typedef short bf16x8 __attribute__((ext_vector_type(8)));
typedef float f32x4 __attribute__((ext_vector_type(4)));
typedef unsigned u32x4 __attribute__((ext_vector_type(4)));
constexpr int BM = 256, BK = 64, HALF = 128, HTB = HALF * BK * 2  , STAGE_BYTES = 8 * HTB, NXCD = 8, WGM = 8;

__host__ __device__ __forceinline__ int lds_byte(int r, int c) { const int st = (r >> 4) * 2 + (c >> 5), rr = r & 15, cc = c & 31, ob = rr * 64 + cc * 2; return st * 1024 + (ob ^ (((ob >> 9) & 1) << 5)); }
__host__ __device__ __forceinline__ void stage_rc(int b, int& R, int& C) { const int st = b / 1024, sb = b % 1024, swz = sb ^ (((sb >> 9) & 1) << 5); R = (st >> 1) * 16 + swz / 64; C = (st & 1) * 32 + (swz % 64) / 2; }
__host__ __device__ __forceinline__ int perm32(int rho) { const int n = rho >> 4, i = rho & 15; return 8 * (i >> 2) + 4 * n + (i & 3); }

struct Unit { int pm, pn; };
struct Gemm { const bf16_t* A; const bf16_t* Bt; int M, N, K; };

struct StaticOrder {
    int nM, nN, nwg, G, c;
    __host__ __device__ __forceinline__ void init(int M, int N, int G_, int c_) { nM = M / BM; nN = N / BM; nwg = nM * nN; G = G_; c = c_; }
    __host__ __device__ __forceinline__ bool next(int i, Unit& u) const {
        const long L = (long)i * G + c; if (L >= nwg) return false;
        int wgid = (int)L; { const int q = nwg / NXCD, r = nwg % NXCD, xcd = wgid % NXCD, off = wgid / NXCD; wgid = (xcd < r ? xcd * (q + 1) : r * (q + 1) + (xcd - r) * q) + off; }
        const int nig = WGM * nN, gid = wgid / nig, fm = gid * WGM, gsz = (nM - fm) < WGM ? (nM - fm) : WGM;
        u.pm = fm + ((wgid % nig) % gsz); u.pn = (wgid % nig) / gsz; return true;
    }
    __device__ __forceinline__ void a_ready(const Unit&) const {}
    __device__ __forceinline__ void done(const Unit&) const {}
};
template <class Epi, class Sched, bool ALIGN_EPI = false, bool SP2 = false>
__device__ __forceinline__ void gemm_phase(PG8_LAS unsigned char* lds, const Gemm g, const Sched& S, const Epi& E) {
    const int tid = threadIdx.x, wid = __builtin_amdgcn_readfirstlane(tid >> 6), lane = tid & 63, wr = wid >> 2, wc = wid & 3, fr = lane & 15, fq = lane >> 4;
    const int K = g.K, nt = K / BK;
    unsigned voffA[2], voffB[2];
#pragma unroll
    for (int i = 0; i < 2; ++i) { int R, C; stage_rc(tid * 16 + i * 8192, R, C); const int Rb = Epi::PERM ? ((R & ~31) + perm32(R & 31)) : R;
        voffA[i] = (unsigned)(R * K + C) * 2u; voffB[i] = (unsigned)(Rb * K + C) * 2u; }
    const size_t kstep = (size_t)(BK * 2);
    const size_t hstep = (size_t)HALF * K * 2;
    const size_t tstep = 2 * hstep;
    const unsigned ldsw = (unsigned)wid * 1024u;
    const int aoff = lds_byte(wr * 64 + fr, fq * 8), boff = lds_byte(wc * 32 + fr, fq * 8);
#define PG8_SA(b, h) (((b) * 2 + (h)) * HTB)
#define PG8_SB(b, h) ((4 + (b) * 2 + (h)) * HTB)
#define PG8_STAGE(bufoff, gbase, voff) do { _Pragma("unroll") for (int _i = 0; _i < 2; ++_i) \
        __builtin_amdgcn_global_load_lds((const unsigned*)((const char*)(gbase) + (voff)[_i]), (PG8_LAS unsigned*)(lds + (bufoff) + ldsw + _i * 8192), 16, 0, 0); } while (0)
#define PG8_LDA(dst, b, h) do { _Pragma("unroll") for (int m = 0; m < 4; ++m) _Pragma("unroll") for (int k = 0; k < 2; ++k) dst[m][k] = *(const PG8_LAS bf16x8*)(lds + PG8_SA(b, h) + aoff + m * 2048 + k * 1024); } while (0)
#define PG8_LDB(dst, b, h) do { _Pragma("unroll") for (int n = 0; n < 2; ++n) _Pragma("unroll") for (int k = 0; k < 2; ++k) dst[n][k] = *(const PG8_LAS bf16x8*)(lds + PG8_SB(b, h) + boff + n * 2048 + k * 1024); } while (0)
#define PG8_MMA(ai, bj, At, Bt) do { __builtin_amdgcn_s_setprio(1); _Pragma("unroll") for (int m = 0; m < 4; ++m) _Pragma("unroll") for (int n = 0; n < 2; ++n) _Pragma("unroll") for (int k = 0; k < 2; ++k) \
        acc[ai][bj][m][n] = __builtin_amdgcn_mfma_f32_16x16x32_bf16(Bt[n][k], At[m][k], acc[ai][bj][m][n], 0, 0, 0); __builtin_amdgcn_s_setprio(0); } while (0)
#define PG8_WAIT_V(n) asm volatile("s_waitcnt vmcnt(" #n ")" ::: "memory")
#define PG8_WAIT_L(n) asm volatile("s_waitcnt lgkmcnt(" #n ")" ::: "memory")
#define PG8_BAR __builtin_amdgcn_s_barrier()
#define PG8_SCHED __builtin_amdgcn_sched_barrier(0)
    Unit cur, nxt; int ui = 0;
    if (!S.next(0, cur)) return;
    f32x4 acc[2][2][4][2];
#pragma unroll
    for (int a = 0; a < 2; ++a)
#pragma unroll
        for (int b = 0; b < 2; ++b)
#pragma unroll
            for (int m = 0; m < 4; ++m)
#pragma unroll
                for (int n = 0; n < 2; ++n) acc[a][b][m][n] = (f32x4){0.f, 0.f, 0.f, 0.f};
    bf16x8 At[4][2], B0[2][2], B1[2][2];
    const char* cA = (const char*)g.A + (size_t)cur.pm * tstep; const char* cB = (const char*)g.Bt + (size_t)cur.pn * tstep;
    S.a_ready(cur);
    if constexpr (SP2) {
        PG8_STAGE(PG8_SB(0, 0), cB, voffB); PG8_STAGE(PG8_SB(0, 1), cB + hstep, voffB); PG8_STAGE(PG8_SA(0, 0), cA, voffA); PG8_STAGE(PG8_SA(0, 1), cA + hstep, voffA);
        if (wr == 1) PG8_BAR;
        PG8_WAIT_V(2); PG8_BAR;
        PG8_STAGE(PG8_SB(1, 0), cB + kstep, voffB); PG8_STAGE(PG8_SA(1, 0), cA + kstep, voffA); PG8_STAGE(PG8_SB(1, 1), cB + hstep + kstep, voffB);
        PG8_WAIT_V(6); PG8_BAR;
    } else {
        PG8_STAGE(PG8_SB(0, 0), cB, voffB); PG8_STAGE(PG8_SA(0, 0), cA, voffA); PG8_STAGE(PG8_SB(0, 1), cB + hstep, voffB); PG8_STAGE(PG8_SA(0, 1), cA + hstep, voffA);
        if (wr == 1) PG8_BAR;
        PG8_WAIT_V(4); PG8_BAR;
        PG8_STAGE(PG8_SB(1, 0), cB + kstep, voffB); PG8_STAGE(PG8_SA(1, 0), cA + kstep, voffA); PG8_STAGE(PG8_SB(1, 1), cB + hstep + kstep, voffB);
        PG8_WAIT_V(6); PG8_BAR;
    }
    for (;;) {
        const bool has_next = S.next(ui + 1, nxt);
        const char* nA = has_next ? (const char*)g.A + (size_t)nxt.pm * tstep : cA; const char* nB = has_next ? (const char*)g.Bt + (size_t)nxt.pn * tstep : cB;
        for (int t = 0; t < nt; t += 2) {
            const bool last = (t == nt - 2);
            const char* a1 = cA + (size_t)(t + 1) * kstep;
            const char* a2 = last ? nA : cA + (size_t)(t + 2) * kstep; const char* b2 = last ? nB : cB + (size_t)(t + 2) * kstep;
            const char* a3 = a2 + kstep; const char* b3 = b2 + kstep;
            if (last && has_next) S.a_ready(nxt);
            if constexpr (SP2) {
            PG8_LDB(B0, 0, 0); PG8_LDB(B1, 0, 1); PG8_SCHED; PG8_LDA(At, 0, 0); PG8_STAGE(PG8_SA(1, 1), a1 + hstep, voffA);
            PG8_WAIT_V(8); PG8_WAIT_L(0); PG8_BAR; PG8_MMA(0, 0, At, B0); PG8_MMA(0, 1, At, B1); PG8_BAR; PG8_SCHED;
            PG8_LDA(At, 0, 1); PG8_STAGE(PG8_SB(0, 0), b2, voffB); PG8_STAGE(PG8_SB(0, 1), b2 + hstep, voffB); PG8_STAGE(PG8_SA(0, 0), a2, voffA);
            PG8_WAIT_V(8); PG8_WAIT_L(0); PG8_BAR; PG8_MMA(1, 0, At, B0); PG8_MMA(1, 1, At, B1); PG8_BAR; PG8_SCHED;
            PG8_LDB(B0, 1, 0); PG8_LDB(B1, 1, 1); PG8_SCHED; PG8_LDA(At, 1, 0); PG8_STAGE(PG8_SA(0, 1), a2 + hstep, voffA);
            PG8_WAIT_V(8); PG8_WAIT_L(0); PG8_BAR; PG8_MMA(0, 0, At, B0); PG8_MMA(0, 1, At, B1); PG8_BAR; PG8_SCHED;
            PG8_LDA(At, 1, 1); PG8_STAGE(PG8_SB(1, 0), b3, voffB); PG8_STAGE(PG8_SB(1, 1), b3 + hstep, voffB); PG8_STAGE(PG8_SA(1, 0), a3, voffA);
            PG8_WAIT_V(8); PG8_WAIT_L(0); PG8_BAR; PG8_MMA(1, 0, At, B0); PG8_MMA(1, 1, At, B1); PG8_BAR; PG8_SCHED;
            } else {
            PG8_LDB(B0, 0, 0); PG8_SCHED; PG8_LDA(At, 0, 0); PG8_STAGE(PG8_SA(1, 1), a1 + hstep, voffA);
            PG8_WAIT_L(8); PG8_BAR; PG8_WAIT_L(0); PG8_MMA(0, 0, At, B0); PG8_BAR; PG8_SCHED;
            PG8_LDB(B1, 0, 1); PG8_STAGE(PG8_SB(0, 0), b2, voffB);
            PG8_BAR; PG8_WAIT_L(0); PG8_MMA(0, 1, At, B1); PG8_BAR;
            PG8_LDA(At, 0, 1); PG8_STAGE(PG8_SA(0, 0), a2, voffA);
            PG8_BAR; PG8_WAIT_L(0); PG8_MMA(1, 0, At, B0); PG8_BAR; PG8_SCHED;
            PG8_STAGE(PG8_SB(0, 1), b2 + hstep, voffB);
            PG8_WAIT_V(6); PG8_BAR; PG8_MMA(1, 1, At, B1); PG8_BAR;
            PG8_LDB(B0, 1, 0); PG8_SCHED; PG8_LDA(At, 1, 0); PG8_STAGE(PG8_SA(0, 1), a2 + hstep, voffA);
            PG8_WAIT_L(8); PG8_BAR; PG8_WAIT_L(0); PG8_MMA(0, 0, At, B0); PG8_BAR; PG8_SCHED;
            PG8_LDB(B1, 1, 1); PG8_STAGE(PG8_SB(1, 0), b3, voffB);
            PG8_BAR; PG8_WAIT_L(0); PG8_MMA(0, 1, At, B1); PG8_BAR;
            PG8_LDA(At, 1, 1); PG8_STAGE(PG8_SA(1, 0), a3, voffA);
            PG8_BAR; PG8_WAIT_L(0); PG8_MMA(1, 0, At, B0); PG8_BAR; PG8_SCHED;
            PG8_STAGE(PG8_SB(1, 1), b3 + hstep, voffB);
            PG8_WAIT_V(6); PG8_BAR; PG8_MMA(1, 1, At, B1); PG8_BAR;
            }
        }
        if constexpr (ALIGN_EPI) { if (wr == 0) PG8_BAR; }
        if constexpr (!Epi::AFTER_DRAIN) { E(acc, cur, wr, wc, fr, fq); S.done(cur); }
        if (!has_next) break;
#pragma unroll
        for (int a = 0; a < 2; ++a)
#pragma unroll
            for (int b = 0; b < 2; ++b)
#pragma unroll
                for (int m = 0; m < 4; ++m)
#pragma unroll
                    for (int n = 0; n < 2; ++n) acc[a][b][m][n] = (f32x4){0.f, 0.f, 0.f, 0.f};
        cur = nxt; cA = nA; cB = nB; ++ui;
        if constexpr (ALIGN_EPI) { if (wr == 1) PG8_BAR; }
    }
    PG8_WAIT_V(0);
    if constexpr (!ALIGN_EPI) { if (wr == 0) PG8_BAR; }
    PG8_BAR;
    if constexpr (Epi::AFTER_DRAIN) { E.fused(acc, cur, wr, wc, fr, fq, lds, wid, lane); S.done(cur); }
#undef PG8_SA
#undef PG8_SB
#undef PG8_STAGE
#undef PG8_LDA
#undef PG8_LDB
#undef PG8_MMA
#undef PG8_WAIT_V
#undef PG8_WAIT_L
#undef PG8_BAR
#undef PG8_SCHED
}
}

constexpr int BATCH = 16, SEQ = 2048, D = 1024, M = BATCH * SEQ, NIN = 7168, DFF = 4096;
constexpr int NWAVES = 8, NTHREADS = 512;
constexpr float NORM_EPS = 1e-6f, SUBLN_EPS = 1e-5f;
constexpr float LOG2E = 1.4426950408889634f;
constexpr float QSCALE = 0.18033688011112042f;
constexpr float LAM_INIT = 0.2f;
constexpr float OUT_SCALE = 1.0f - LAM_INIT;

#define LAS __attribute__((address_space(3)))
typedef unsigned short bf16_t;
typedef short bf16x8 __attribute__((ext_vector_type(8)));
typedef float f32x4 __attribute__((ext_vector_type(4)));
typedef float f32x16 __attribute__((ext_vector_type(16)));
typedef unsigned u32x4 __attribute__((ext_vector_type(4)));
typedef unsigned u32x2 __attribute__((ext_vector_type(2)));

constexpr size_t MiB = 1u << 20;
constexpr size_t WS_CTL = 0, CTL_ZERO_BYTES = 64 * 1024;
constexpr size_t WS_SS1 = 512 * 1024;
constexpr size_t WS_SS2 = 640 * 1024;
constexpr int CW_PANEL = 10240;
constexpr size_t WS_ROPE = 1 * MiB;
constexpr size_t WS_WIN = 2 * MiB, WS_WBR = 16 * MiB, WS_WBA = 18 * MiB, WS_WOUT = 20 * MiB, WS_W1 = 22 * MiB, WS_W2 = 30 * MiB;
constexpr size_t WS_B0 = 48 * MiB, WS_B1 = 112 * MiB, WS_B2 = 176 * MiB, WS_B3 = 240 * MiB, WS_B4 = 304 * MiB, WS_B5 = 368 * MiB, WS_END = 432 * MiB;

struct Args { const float* in[22]; float* out; unsigned char* ws; int ph_lo, ph_hi; };

struct Bufs {
    const float* x; float* out;
    bf16_t *Win, *Wbr, *Wba, *Wout, *W1, *W2;
    bf16_t *H, *UX, *GG, *Q, *K, *V, *MG, *X1B, *HID; unsigned char *SR, *SA;
    float *ss1, *ss2, *ropec, *ropes; bf16_t* T; unsigned* pcnt;
};
__device__ __forceinline__ Bufs make_bufs(const Args& a) {
    Bufs b; unsigned char* ws = a.ws;
    b.x = a.in[0]; b.out = a.out;
    b.Win = (bf16_t*)(ws + WS_WIN); b.Wbr = (bf16_t*)(ws + WS_WBR); b.Wba = (bf16_t*)(ws + WS_WBA); b.Wout = (bf16_t*)(ws + WS_WOUT); b.W1 = (bf16_t*)(ws + WS_W1); b.W2 = (bf16_t*)(ws + WS_W2);
    b.H = (bf16_t*)(ws + WS_B0); b.UX = (bf16_t*)(ws + WS_B1); b.GG = (bf16_t*)(ws + WS_B2); b.Q = (bf16_t*)(ws + WS_B3); b.K = (bf16_t*)(ws + WS_B4); b.V = (bf16_t*)(ws + WS_B5);
    b.SR = (unsigned char*)a.out; b.SA = (unsigned char*)a.out + (size_t)M * D;
    b.MG = (bf16_t*)(ws + WS_B0); b.X1B = (bf16_t*)(ws + WS_B1); b.HID = (bf16_t*)(ws + WS_B2);
    b.T = (bf16_t*)(ws + WS_B4); b.ss1 = (float*)(ws + WS_SS1); b.ss2 = (float*)(ws + WS_SS2); b.pcnt = (unsigned*)(ws + WS_CTL) + CW_PANEL; b.ropec = (float*)(ws + WS_ROPE); b.ropes = b.ropec + 2048 * 32;
    return b;
}

__device__ __forceinline__ unsigned f2bf(float f) { unsigned u = __builtin_bit_cast(unsigned, f); return (u + 0x7fffu + ((u >> 16) & 1u)) >> 16; }
typedef float pk_f32x2_t __attribute__((ext_vector_type(2))); typedef __bf16 pk_bf16x2_t __attribute__((ext_vector_type(2)));
__device__ __forceinline__ unsigned pk2(float lo, float hi) { const pk_f32x2_t v = {lo, hi}; return __builtin_bit_cast(unsigned, __builtin_convertvector(v, pk_bf16x2_t)); }
__device__ __forceinline__ float bf2f(unsigned b) { return __builtin_bit_cast(float, b << 16); }
__device__ __forceinline__ float fexp2(float x) { return __builtin_amdgcn_exp2f(x); }
__device__ __forceinline__ float sigmoid_f(float v) { return 1.0f / (1.0f + fexp2(-v * LOG2E)); }
__device__ __forceinline__ float gelu_tanh_f(float v) { const float y = 0.7978845608028654f * (v + 0.044715f * v * v * v); return v / (1.0f + fexp2(-2.0f * LOG2E * y)); }
__device__ __forceinline__ float wave_sum(float v) {
#pragma unroll
    for (int o = 1; o < 64; o <<= 1) v += __shfl_xor(v, o);
    return v;
}
__device__ __forceinline__ float wave_max(float v) {
#pragma unroll
    for (int o = 1; o < 64; o <<= 1) v = fmaxf(v, __shfl_xor(v, o));
    return v;
}
#define LDS_WAIT() asm volatile("s_waitcnt lgkmcnt(0)" ::: "memory")

__device__ __forceinline__ void transpose_item(const float* W, int K, int N, bf16_t* WT, int item, LAS float* scr, int lane, int permqk, const float* kscale) {
    const int nblk = N / 32, kb = item / nblk, nb = item % nblk, k0 = 64 * kb, n0 = 32 * nb;
    int s0 = n0;
    int cs = 0;
    if (permqk) { const int l = n0 & 255, bj = l >> 7, wc = (l >> 5) & 3; s0 = (n0 & ~255) + 64 * wc + 32 * bj; if (permqk > 1 && n0 >= 5120) { s0 = (n0 & ~255) + 64 * wc + 8 * bj; cs = 1; } }
#pragma unroll
    for (int i = 0; i < 8; ++i) { const int kk = 8 * i + (lane >> 3), c4 = (lane & 7) * 4; f32x4 v = *(const f32x4*)(W + (size_t)(k0 + kk) * N + s0 + (cs ? 16 * (c4 >> 3) + (c4 & 7) : c4));
        if (kscale) v = v * kscale[k0 + kk];
        if (cs) v = v * -LOG2E;
        LAS float* d = scr + kk * 33 + c4; d[0] = v.x; d[1] = v.y; d[2] = v.z; d[3] = v.w; }
    LDS_WAIT();
    const int c = lane & 7;
#pragma unroll
    for (int j = 0; j < 4; ++j) { const int n = (lane >> 3) + 8 * j; const LAS float* s = scr + (8 * c) * 33 + n;
        u32x4 o; o.x = pk2(s[0 * 33], s[1 * 33]); o.y = pk2(s[2 * 33], s[3 * 33]); o.z = pk2(s[4 * 33], s[5 * 33]); o.w = pk2(s[6 * 33], s[7 * 33]);
        *(u32x4*)(WT + (size_t)(n0 + n) * K + k0 + 8 * c) = o; }
    LDS_WAIT();
}
__constant__ double ROPE_INVF[32] = {1.0, 0.7498942093324559, 0.5623413251903491, 0.4216965034285822, 0.31622776601683794, 0.23713737056616552, 0.1778279410038923, 0.1333521432163324, 0.1, 0.07498942093324558,
    0.05623413251903491, 0.042169650342858224, 0.03162277660168379, 0.023713737056616554, 0.01778279410038923, 0.01333521432163324, 0.01, 0.007498942093324558, 0.005623413251903491, 0.004216965034285823,
    0.0031622776601683794, 0.0023713737056616554, 0.0017782794100389228, 0.001333521432163324, 0.001, 0.0007498942093324559, 0.0005623413251903491, 0.00042169650342858224, 0.00031622776601683794,
    0.00023713737056616554, 0.00017782794100389227, 0.0001333521432163324};
__device__ __forceinline__ void sincos_f64(double a, double& s, double& c) {
    const double k = __builtin_rint(a * 6.36619772367581382433e-01);
    double r = a - k * 1.57079632673412561417e+00; r = r - k * 6.07710050650619224932e-11;
    const double z = r * r;
    const double ps = r + r * z * (-1.66666666666666324348e-01 + z * (8.33333333332248946124e-03 + z * (-1.98412698298579493134e-04 + z * (2.75573137070700676789e-06 + z * (-2.50507602534068634195e-08 + z * 1.58969099521155010221e-10)))));
    const double pc = 1.0 - 0.5 * z + z * z * (4.16666666666666019037e-02 + z * (-1.38888888888741095749e-03 + z * (2.48015872894767294178e-05 + z * (-2.75573143513906633035e-07 + z * (2.08757232129817482790e-09 + z * -1.13596475577881948265e-11)))));
    const int q = (int)k & 3;
    s = (q == 0) ? ps : (q == 1) ? pc : (q == 2) ? -ps : -pc;
    c = (q == 0) ? pc : (q == 1) ? -ps : (q == 2) ? -pc : ps;
}
__device__ __forceinline__ void phase_prep(const Args& a, const Bufs& B, LAS unsigned char* lds) {
    const int tid = threadIdx.x, lane = tid & 63, wave = __builtin_amdgcn_readfirstlane(tid >> 6);
    LAS float* scr = (LAS float*)(lds + wave * 16384);
    const int gw = blockIdx.x * NWAVES + wave, NGW = gridDim.x * NWAVES;
    constexpr int I_IN = (D / 64) * (NIN / 32), I_SQ = (D / 64) * (D / 32), I_1 = (D / 64) * (DFF / 32), I_2 = (DFF / 64) * (D / 32);
    constexpr int NITEMS = I_IN + 3 * I_SQ + I_1 + I_2;
    for (int it = gw; it < NITEMS; it += NGW) {
        int r = it;
        if (r < I_IN) { transpose_item(a.in[2], D, NIN, B.Win, r, scr, lane, 2, nullptr); continue; } r -= I_IN;
        if (r < I_SQ) { transpose_item(a.in[15], D, D, B.Wbr, r, scr, lane, 1, nullptr); continue; } r -= I_SQ;
        if (r < I_SQ) { transpose_item(a.in[16], D, D, B.Wba, r, scr, lane, 1, nullptr); continue; } r -= I_SQ;
        if (r < I_SQ) { transpose_item(a.in[17], D, D, B.Wout, r, scr, lane, 1, nullptr); continue; } r -= I_SQ;
        if (r < I_1) { transpose_item(a.in[19], D, DFF, B.W1, r, scr, lane, 1, a.in[18]); continue; } r -= I_1;
        transpose_item(a.in[20], DFF, D, B.W2, r, scr, lane, 1, nullptr);
    }
    const f32x4* g4 = (const f32x4*)a.in[1];
    for (int m = 2 * gw; m < M; m += 2 * NGW) {
        const f32x4* xr = (const f32x4*)(B.x + (size_t)m * D) + lane;
        f32x4 v[2][4]; float s0 = 0.f, s1 = 0.f;
#pragma unroll
        for (int j = 0; j < 4; ++j) { v[0][j] = xr[64 * j]; v[1][j] = xr[256 + 64 * j]; }
#pragma unroll
        for (int j = 0; j < 4; ++j) { s0 += (v[0][j].x * v[0][j].x + v[0][j].y * v[0][j].y) + (v[0][j].z * v[0][j].z + v[0][j].w * v[0][j].w);
                                      s1 += (v[1][j].x * v[1][j].x + v[1][j].y * v[1][j].y) + (v[1][j].z * v[1][j].z + v[1][j].w * v[1][j].w); }
        const float rs0 = 1.0f / sqrtf(wave_sum(s0) * (1.0f / D) + NORM_EPS), rs1 = 1.0f / sqrtf(wave_sum(s1) * (1.0f / D) + NORM_EPS);
        u32x2* o = (u32x2*)(B.H + (size_t)m * D) + lane;
#pragma unroll
        for (int j = 0; j < 4; ++j) { const f32x4 g = g4[lane + 64 * j]; u32x2 w;
            w.x = pk2(v[0][j].x * rs0 * g.x, v[0][j].y * rs0 * g.y); w.y = pk2(v[0][j].z * rs0 * g.z, v[0][j].w * rs0 * g.w); o[64 * j] = w;
            w.x = pk2(v[1][j].x * rs1 * g.x, v[1][j].y * rs1 * g.y); w.y = pk2(v[1][j].z * rs1 * g.z, v[1][j].w * rs1 * g.w); o[256 + 64 * j] = w; }
    }
    for (int i = blockIdx.x * NTHREADS + tid; i < M; i += gridDim.x * NTHREADS) { B.ss1[i] = 0.f; B.ss2[i] = 0.f; }
    for (int idx = blockIdx.x * NTHREADS + tid; idx < 2048 * 32; idx += gridDim.x * NTHREADS) {
        const int pos = idx >> 5, j = idx & 31; double s, c; sincos_f64((double)pos * ROPE_INVF[j], s, c);
        B.ropec[idx] = (float)c; B.ropes[idx] = (float)s;
    }
}

namespace att {
constexpr int KV_STAGE = 32768, LDS_XCH = 2 * KV_STAGE, XCH_PAIR = 17408, LDS_WSF = LDS_XCH + 4 * XCH_PAIR;
constexpr float THR = 8.0f;
typedef short v4i16_t __attribute__((ext_vector_type(4)));
typedef float f32x2_t __attribute__((ext_vector_type(2))); typedef __bf16 bf16x2_t __attribute__((ext_vector_type(2)));
__device__ __forceinline__ float max3f(float a, float b, float c) { float r; asm("v_max3_f32 %0, %1, %2, %3" : "=v"(r) : "v"(a), "v"(b), "v"(c)); return r; }
__device__ __forceinline__ int crow(int r, int hi) { return (r & 3) + 8 * (r >> 2) + 4 * hi; }
__device__ __forceinline__ unsigned cvtpk(float lo, float hi) { f32x2_t v = {lo, hi}; bf16x2_t b = __builtin_convertvector(v, bf16x2_t); return __builtin_bit_cast(unsigned, b); }
__device__ __forceinline__ v4i16_t vtr(const LAS unsigned char* p) { return __builtin_amdgcn_ds_read_tr16_b64_v4i16((LAS v4i16_t*)p); }
__device__ __forceinline__ void swap32(unsigned& a, unsigned& b) { asm volatile("s_nop 1\n\tv_permlane32_swap_b32 %0, %1\n\ts_nop 1" : "+v"(a), "+v"(b)); }
__device__ __forceinline__ float swap_max(float m) { unsigned a = __builtin_bit_cast(unsigned, m), b = a; swap32(a, b); return fmaxf(__builtin_bit_cast(float, a), __builtin_bit_cast(float, b)); }
__device__ __forceinline__ float swap_sum(float m) { unsigned a = __builtin_bit_cast(unsigned, m), b = a; swap32(a, b); return __builtin_bit_cast(float, a) + __builtin_bit_cast(float, b); }

__device__ __forceinline__ void glds16(const void* gsrc, unsigned lds_dst) { unsigned keep;
    asm volatile("s_mov_b32 %0, m0\n\ts_mov_b32 m0, %2\n\ts_nop 0\n\tglobal_load_lds_dwordx4 %1, off\n\ts_mov_b32 m0, %0" : "=&s"(keep) : "v"(gsrc), "s"(lds_dst) : "memory"); }
#define ATT_SB() __builtin_amdgcn_sched_barrier(0)
__device__ __forceinline__ unsigned scale_pk(unsigned w, float f) { return cvtpk(bf2f(w & 0xffffu) * f, bf2f(w >> 16) * f); }
__device__ __forceinline__ void pv_plain(f32x16 (&o)[4], const LAS unsigned char* vb, const u32x4 (&pw)[4]) {
#pragma unroll
    for (int d0 = 0; d0 < 4; ++d0)
#pragma unroll
        for (int ks = 0; ks < 4; ++ks) { const v4i16_t lo = vtr(vb + d0 * 4096 + ks * 1024), hh = vtr(vb + d0 * 4096 + ks * 1024 + 512);
            const bf16x8 vf = {lo[0], lo[1], lo[2], lo[3], hh[0], hh[1], hh[2], hh[3]};
            o[d0] = __builtin_amdgcn_mfma_f32_32x32x16_bf16(__builtin_bit_cast(bf16x8, pw[ks]), vf, o[d0], 0, 0, 0); }
}
constexpr int LDS_K = 0, LDS_V = 49152, LDS_X2 = 114688, LDS_WSF2 = LDS_X2 + 32768;
template <int RB, bool OWN0> __device__ __forceinline__ void attn_tail_half(f32x16 (&o)[4], LAS unsigned* XR, float lam, const float* subg, bf16_t* Orow, int lane, int r32, int hi) {
    float ssq[8];
#pragma unroll
    for (int r = 0; r < 8; ++r) ssq[r] = 0.f;
#pragma unroll
    for (int d0 = 0; d0 < 4; ++d0)
#pragma unroll
        for (int rr = 0; rr < 4; ++rr) { const unsigned w = XR[(d0 * 4 + rr) * 64 + lane]; const float b0 = bf2f(w & 0xffffu), b1 = bf2f(w >> 16);
            const float v0 = OWN0 ? o[d0][RB + 2 * rr] - lam * b0 : b0 - lam * o[d0][RB + 2 * rr], v1 = OWN0 ? o[d0][RB + 2 * rr + 1] - lam * b1 : b1 - lam * o[d0][RB + 2 * rr + 1];
            o[d0][RB + 2 * rr] = v0; o[d0][RB + 2 * rr + 1] = v1; ssq[2 * rr] += v0 * v0; ssq[2 * rr + 1] += v1 * v1; }
#define ATT_DPPF(v, ctrl) __builtin_bit_cast(float, __builtin_amdgcn_update_dpp(0, __builtin_bit_cast(int, v), ctrl, 0xF, 0xF, false))
#pragma unroll
    for (int r = 0; r < 8; ++r) { float v = ssq[r]; v += ATT_DPPF(v, 0xB1); v += ATT_DPPF(v, 0x4E); v += ATT_DPPF(v, 0x124); v += ATT_DPPF(v, 0x128); ssq[r] = v + __shfl_xor(v, 16); }
#undef ATT_DPPF
    float g[4];
#pragma unroll
    for (int d0 = 0; d0 < 4; ++d0) g[d0] = subg[32 * d0 + r32] * OUT_SCALE;
    LAS bf16_t* Xo = (LAS bf16_t*)XR + r32;
#pragma unroll
    for (int r = 0; r < 8; r += 2) {
        const float rn0 = __builtin_amdgcn_rsqf(ssq[r] * (1.0f / 128.0f) + SUBLN_EPS), rn1 = __builtin_amdgcn_rsqf(ssq[r + 1] * (1.0f / 128.0f) + SUBLN_EPS);
        LAS bf16_t* xp = Xo + ((r & 3) + 8 * (r >> 2) + 4 * hi) * 128;
#pragma unroll
        for (int d0 = 0; d0 < 4; ++d0) { const unsigned w = pk2(o[d0][RB + r] * rn0 * g[d0], o[d0][RB + r + 1] * rn1 * g[d0]); xp[32 * d0] = (bf16_t)w; xp[128 + 32 * d0] = (bf16_t)(w >> 16); } }
    LDS_WAIT();
    bf16_t* ob = Orow + (size_t)(lane >> 4) * D + (lane & 15) * 8; const LAS unsigned char* xr = (const LAS unsigned char*)XR + lane * 16;
#pragma unroll
    for (int i = 0; i < 4; ++i) *(u32x4*)(ob + (size_t)(4 * i) * D) = *(const LAS u32x4*)(xr + i * 1024);
}
constexpr int LDS_QS = LDS_V + 32768;
__device__ __forceinline__ void attn_open(int b, int h, int qb, const bf16_t* Q, const bf16_t* K, const bf16_t* V, LAS unsigned char* lds) {
    const int tid = threadIdx.x, lane = tid & 63;
    const int wid = __builtin_amdgcn_readfirstlane(tid >> 6), ch = wid >> 2, s = (wid >> 1) & 1, qh = wid & 1;
    const int q0 = qb * 128 + ch * 64 + qh * 32;
    const size_t hb = ((size_t)(b * 8 + h) * SEQ) * 128;
    const bf16_t* ksrc = K + hb + (8 * ((2 * wid) & 7) + (lane >> 3)) * 128 + (wid >> 2) * 64 + ((lane & 7) ^ (lane >> 3)) * 8;
    const bf16_t* vsrc = V + hb + (32 * (wid & 1) + (lane >> 2)) * 128 + 32 * (wid >> 1) + (lane & 3) * 8;
    const bf16_t* qsrc = Q + ((size_t)b * SEQ + q0 + (lane >> 3)) * D + h * 128 + s * 64 + ((lane & 7) ^ (lane >> 3)) * 8;
    const unsigned ldsb = (unsigned)(uintptr_t)lds;
    const unsigned kdst = (unsigned)__builtin_amdgcn_readfirstlane(ldsb + LDS_K + (wid >> 2) * 8192 + ((2 * wid) & 7) * 1024), vdst = (unsigned)__builtin_amdgcn_readfirstlane(ldsb + LDS_V + (wid >> 1) * 4096 + (2 * (wid & 1)) * 1024);
    const unsigned qdst = (unsigned)__builtin_amdgcn_readfirstlane(ldsb + LDS_QS + wid * 4096);
#pragma unroll
    for (int p = 0; p < 4; ++p) glds16(qsrc + (size_t)(8 * p) * D, qdst + p * 1024);
#pragma unroll
    for (int t = 0; t < 2; ++t) { const size_t o = (size_t)t * 64 * 128;
        glds16(ksrc + o, kdst + t * 16384); glds16(ksrc + o + 8 * 128, kdst + t * 16384 + 1024); glds16(vsrc + o, vdst + t * 16384); glds16(vsrc + o + 16 * 128, vdst + t * 16384 + 1024); }
}
__device__ __forceinline__ void attn_unit(int b, int h, int qb, const bf16_t* Q, const bf16_t* K, const bf16_t* V, bf16_t* O, LAS unsigned char* lds, float lam, const float* subg, bool has_next, int nb, int nh, int nqb) {
    const int tid = threadIdx.x, lane = tid & 63, r32 = lane & 31, hi = lane >> 5;
    const int wid = __builtin_amdgcn_readfirstlane(tid >> 6), ch = wid >> 2, s = (wid >> 1) & 1, qh = wid & 1, pair = ch * 2 + qh;
    const int NT = 2 * qb + 2, ntw = 2 * qb + 1 + ch;
    const size_t rowb = (size_t)b * SEQ;
    const int q0 = qb * 128 + ch * 64 + qh * 32;
    const size_t hb = ((size_t)(b * 8 + h) * SEQ) * 128;
    const bf16_t* ksrc = K + hb + (8 * ((2 * wid) & 7) + (lane >> 3)) * 128 + (wid >> 2) * 64 + ((lane & 7) ^ (lane >> 3)) * 8;
    const bf16_t* vsrc = V + hb + (32 * (wid & 1) + (lane >> 2)) * 128 + 32 * (wid >> 1) + (lane & 3) * 8;
    const unsigned ldsb = (unsigned)(uintptr_t)lds;
    const unsigned kdst = ldsb + LDS_K + (wid >> 2) * 8192 + ((2 * wid) & 7) * 1024, vdst = ldsb + LDS_V + (wid >> 1) * 4096 + (2 * (wid & 1)) * 1024;
#define ATT_DMA(t, ks_, vs_) do { const size_t _o = (size_t)(t) * 64 * 128; \
        glds16(ksrc + _o, (unsigned)__builtin_amdgcn_readfirstlane(kdst + (ks_))); glds16(ksrc + _o + 8 * 128, (unsigned)__builtin_amdgcn_readfirstlane(kdst + (ks_) + 1024)); \
        glds16(vsrc + _o, (unsigned)__builtin_amdgcn_readfirstlane(vdst + (vs_))); glds16(vsrc + _o + 16 * 128, (unsigned)__builtin_amdgcn_readfirstlane(vdst + (vs_) + 1024)); } while (0)
    asm volatile("s_waitcnt vmcnt(8)" ::: "memory");
    bf16x8 qr[4];
    { const LAS unsigned char* qb_ = lds + LDS_QS + wid * 4096 + r32 * 128;
#pragma unroll
      for (int k = 0; k < 4; ++k) qr[k] = *(const LAS bf16x8*)(qb_ + (((2 * k + hi) ^ (r32 & 7)) << 4)); }
    LDS_WAIT();
    f32x16 o[4];
#pragma unroll
    for (int r = 0; r < 16; ++r) { o[0][r] = 0.f; o[1][r] = 0.f; o[2][r] = 0.f; o[3][r] = 0.f; }
    f32x16 osum;
#pragma unroll
    for (int r = 0; r < 16; ++r) osum[r] = 0.f;
    bf16x8 ones; { const short one = (short)0x3F80;
#pragma unroll
        for (int e = 0; e < 8; ++e) ones[e] = one; }
    bool refset = false;
    float mhat = 0.f;
    u32x4 pw[4];
#pragma unroll
    for (int k = 0; k < 4; ++k) pw[k] = (u32x4){0u, 0u, 0u, 0u};
    LAS float* wsf = (LAS float*)(lds + LDS_WSF2) + wid * 64;
    const LAS unsigned char* kbase = lds + LDS_K + s * 8192 + r32 * 128;
    const int kx7 = r32 & 7;
    const LAS unsigned char* vbase = lds + LDS_V + ((lane >> 4) & 1) * 32 + (lane & 3) * 8 + (4 * hi + ((lane & 15) >> 2)) * 64;
    int ks_cur = 0, ks_n2 = 32768;
    int vs_prev = 49152, vs_n2 = 32768;
    for (int t = 0; t < NT; ++t) {
        if (t + 1 < NT) asm volatile("s_waitcnt vmcnt(4)" ::: "memory"); else asm volatile("s_waitcnt vmcnt(0)" ::: "memory");
        __syncthreads();
        if (t + 2 < NT) ATT_DMA(t + 2, ks_n2, vs_n2);
        if (t < ntw) {
            const LAS unsigned char* kb = kbase + ks_cur; const LAS unsigned char* vb = vbase + vs_prev;
            bf16x8 kf[8];
#pragma unroll
            for (int d0 = 0; d0 < 4; ++d0) { const int kx = ((2 * d0 + hi) ^ kx7) << 4; kf[2 * d0] = *(const LAS bf16x8*)(kb + kx); kf[2 * d0 + 1] = *(const LAS bf16x8*)(kb + kx + 4096); }
            ATT_SB();
            v4i16_t va_l[4], va_h[4], vb_l[4], vb_h[4];
#define ATT_VR1(L_, H_, off_, k_) do { if (t > 0) { L_[k_] = vtr(vb + (off_) + (k_) * 1024); H_[k_] = vtr(vb + (off_) + (k_) * 1024 + 512); } } while (0)
            f32x16 p0, p1;
            if (!refset) {
                const f32x16 z = {0.f, 0.f, 0.f, 0.f, 0.f, 0.f, 0.f, 0.f, 0.f, 0.f, 0.f, 0.f, 0.f, 0.f, 0.f, 0.f};
                p0 = __builtin_amdgcn_mfma_f32_32x32x16_bf16(kf[0], qr[0], z, 0, 0, 0); p1 = __builtin_amdgcn_mfma_f32_32x32x16_bf16(kf[1], qr[0], z, 0, 0, 0);
            } else { const float nm = -mhat;
#pragma unroll
                for (int r = 0; r < 16; ++r) { p0[r] = nm; p1[r] = nm; }
                p0 = __builtin_amdgcn_mfma_f32_32x32x16_bf16(kf[0], qr[0], p0, 0, 0, 0); p1 = __builtin_amdgcn_mfma_f32_32x32x16_bf16(kf[1], qr[0], p1, 0, 0, 0); }
            ATT_VR1(va_l, va_h, 0, 0); ATT_VR1(va_l, va_h, 0, 1); ATT_SB();
            p0 = __builtin_amdgcn_mfma_f32_32x32x16_bf16(kf[2], qr[1], p0, 0, 0, 0); ATT_VR1(va_l, va_h, 0, 2); ATT_SB(); p1 = __builtin_amdgcn_mfma_f32_32x32x16_bf16(kf[3], qr[1], p1, 0, 0, 0); ATT_VR1(va_l, va_h, 0, 3); ATT_SB();
            p0 = __builtin_amdgcn_mfma_f32_32x32x16_bf16(kf[4], qr[2], p0, 0, 0, 0); ATT_VR1(vb_l, vb_h, 4096, 0); ATT_SB(); p1 = __builtin_amdgcn_mfma_f32_32x32x16_bf16(kf[5], qr[2], p1, 0, 0, 0); ATT_VR1(vb_l, vb_h, 4096, 1); ATT_SB();
            p0 = __builtin_amdgcn_mfma_f32_32x32x16_bf16(kf[6], qr[3], p0, 0, 0, 0); ATT_VR1(vb_l, vb_h, 4096, 2); ATT_SB(); p1 = __builtin_amdgcn_mfma_f32_32x32x16_bf16(kf[7], qr[3], p1, 0, 0, 0); ATT_VR1(vb_l, vb_h, 4096, 3); ATT_SB();
#undef ATT_VR1
#define ATT_MF(d0_, ks_, L_, H_) do { const bf16x8 vf_ = {L_[ks_][0], L_[ks_][1], L_[ks_][2], L_[ks_][3], H_[ks_][0], H_[ks_][1], H_[ks_][2], H_[ks_][3]}; \
                o[d0_] = __builtin_amdgcn_mfma_f32_32x32x16_bf16(__builtin_bit_cast(bf16x8, pw[ks_]), vf_, o[d0_], 0, 0, 0); } while (0)
            float rm, rm2;
            if (t > 0) {
#define ATT_V2(ks_) do { va_l[ks_] = vtr(vb + 8192 + (ks_) * 1024); va_h[ks_] = vtr(vb + 8192 + (ks_) * 1024 + 512); } while (0)
#define ATT_OS(ks_) osum = __builtin_amdgcn_mfma_f32_32x32x16_bf16(__builtin_bit_cast(bf16x8, pw[ks_]), ones, osum, 0, 0, 0)
                ATT_MF(0, 0, va_l, va_h); ATT_SB(); ATT_MF(0, 1, va_l, va_h); ATT_V2(0); ATT_SB(); ATT_MF(0, 2, va_l, va_h); ATT_V2(1); ATT_SB(); ATT_MF(0, 3, va_l, va_h); ATT_V2(2); ATT_SB();
#define ATT_MX(r_) do { rm = max3f(rm, p0[r_], p1[r_]); rm2 = max3f(rm2, p0[(r_) + 1], p1[(r_) + 1]); } while (0)
                ATT_OS(0); ATT_V2(3); rm = max3f(p0[0], p1[0], p0[1]); rm2 = max3f(p1[1], p0[2], p1[2]); ATT_MX(3); ATT_SB();
                ATT_OS(1); ATT_MX(5); ATT_MX(7); ATT_SB(); ATT_OS(2); ATT_MX(9); ATT_MX(11); ATT_SB(); ATT_OS(3); ATT_MX(13); rm = max3f(rm, rm2, p0[15]); rm = max3f(rm, p1[15], p1[15]); ATT_SB();
#undef ATT_OS
#undef ATT_V2
            } else {
                rm = max3f(p0[0], p1[0], p0[1]); rm2 = max3f(p1[1], p0[2], p1[2]);
                ATT_MX(3); ATT_MX(5); ATT_MX(7); ATT_MX(9); ATT_MX(11); ATT_MX(13);
                rm = max3f(rm, rm2, p0[15]); rm = max3f(rm, p1[15], p1[15]);
            }
#undef ATT_MX
            rm = swap_max(rm);
            if (__builtin_expect(__any(rm > THR), 0)) {
                const float dl = fmaxf(rm, 0.f); mhat += dl; refset = true;
#pragma unroll
                for (int r = 0; r < 16; ++r) { p0[r] -= dl; p1[r] -= dl; }
                const float f = fexp2(-dl);
#pragma unroll
                for (int k = 0; k < 4; ++k) { pw[k].x = scale_pk(pw[k].x, f); pw[k].y = scale_pk(pw[k].y, f); pw[k].z = scale_pk(pw[k].z, f); pw[k].w = scale_pk(pw[k].w, f); }
                if (hi == 0) wsf[r32] = f;
                LDS_WAIT();
#pragma unroll
                for (int r = 0; r < 16; ++r) { const float fr = wsf[crow(r, hi)]; o[0][r] *= fr; o[1][r] *= fr; o[2][r] *= fr; o[3][r] *= fr; osum[r] *= fr; }
                LDS_WAIT();
            }
            ATT_SB();
            u32x4 pn[4];
#define ATT_GAP(i) do { const float e0_ = fexp2((i) < 8 ? p0[2 * ((i) & 7)] : p1[2 * ((i) & 7)]), e1_ = fexp2((i) < 8 ? p0[2 * ((i) & 7) + 1] : p1[2 * ((i) & 7) + 1]); \
                unsigned w_ = cvtpk(e0_, e1_); asm volatile("" : "+v"(w_)); pn[(i) >> 2][(i) & 3] = w_; } while (0)
            if (t > 0) {
#define ATT_V3(ks_) do { vb_l[ks_] = vtr(vb + 12288 + (ks_) * 1024); vb_h[ks_] = vtr(vb + 12288 + (ks_) * 1024 + 512); } while (0)
                ATT_MF(1, 0, vb_l, vb_h); ATT_GAP(0); ATT_SB(); ATT_MF(1, 1, vb_l, vb_h); ATT_GAP(1); ATT_V3(0); ATT_SB(); ATT_MF(1, 2, vb_l, vb_h); ATT_GAP(2); ATT_V3(1); ATT_SB(); ATT_MF(1, 3, vb_l, vb_h); ATT_GAP(3); ATT_V3(2); ATT_SB();
                ATT_MF(2, 0, va_l, va_h); ATT_GAP(4); ATT_GAP(5); ATT_V3(3); ATT_SB();
#undef ATT_V3
                ATT_MF(2, 1, va_l, va_h); ATT_GAP(6); ATT_SB(); ATT_MF(2, 2, va_l, va_h); ATT_GAP(7); ATT_GAP(8); ATT_SB(); ATT_MF(2, 3, va_l, va_h); ATT_GAP(9); ATT_SB();
                ATT_MF(3, 0, vb_l, vb_h); ATT_GAP(10); ATT_GAP(11); ATT_SB(); ATT_MF(3, 1, vb_l, vb_h); ATT_GAP(12); ATT_SB(); ATT_MF(3, 2, vb_l, vb_h); ATT_GAP(13); ATT_GAP(14); ATT_SB(); ATT_MF(3, 3, vb_l, vb_h); ATT_GAP(15); ATT_SB();
            } else {
                ATT_GAP(0); ATT_GAP(1); ATT_GAP(2); ATT_GAP(3); ATT_GAP(4); ATT_GAP(5); ATT_GAP(6); ATT_GAP(7);
                ATT_GAP(8); ATT_GAP(9); ATT_GAP(10); ATT_GAP(11); ATT_GAP(12); ATT_GAP(13); ATT_GAP(14); ATT_GAP(15);
            }
#undef ATT_GAP
#undef ATT_MF
#pragma unroll
            for (int k = 0; k < 4; ++k) pw[k] = pn[k];
        } else {
            pv_plain(o, vbase + vs_prev, pw); { _Pragma("unroll") for (int ks = 0; ks < 4; ++ks) osum = __builtin_amdgcn_mfma_f32_32x32x16_bf16(__builtin_bit_cast(bf16x8, pw[ks]), ones, osum, 0, 0, 0); }
        }
        ks_cur = (ks_cur == 32768) ? 0 : ks_cur + 16384; ks_n2 = (ks_n2 == 32768) ? 0 : ks_n2 + 16384;
        vs_prev = (vs_prev == 49152) ? 0 : vs_prev + 16384; vs_n2 = (vs_n2 == 49152) ? 0 : vs_n2 + 16384;
    }
    if (ntw == NT) { pv_plain(o, vbase + vs_prev, pw); _Pragma("unroll") for (int ks = 0; ks < 4; ++ks) osum = __builtin_amdgcn_mfma_f32_32x32x16_bf16(__builtin_bit_cast(bf16x8, pw[ks]), ones, osum, 0, 0, 0); }
#undef ATT_DMA
#pragma unroll
    for (int r = 0; r < 16; ++r) { const float fr = __builtin_amdgcn_rcpf(osum[r]); o[0][r] *= fr; o[1][r] *= fr; o[2][r] *= fr; o[3][r] *= fr; }
    LAS unsigned* X = (LAS unsigned*)(lds + LDS_X2 + pair * 8192);
    if (s == 0) {
#pragma unroll
        for (int d0 = 0; d0 < 4; ++d0)
#pragma unroll
            for (int rr = 0; rr < 4; ++rr) X[(d0 * 4 + rr) * 64 + lane] = cvtpk(o[d0][8 + 2 * rr], o[d0][8 + 2 * rr + 1]);
    } else {
#pragma unroll
        for (int d0 = 0; d0 < 4; ++d0)
#pragma unroll
            for (int rr = 0; rr < 4; ++rr) X[1024 + (d0 * 4 + rr) * 64 + lane] = cvtpk(o[d0][2 * rr], o[d0][2 * rr + 1]);
    }
    __syncthreads();
    if (has_next) attn_open(nb, nh, nqb, Q, K, V, lds);
    bf16_t* Ob = O + (rowb + q0) * D + h * 128;
    if (s == 0) attn_tail_half<0, true>(o, X + 1024, lam, subg, Ob, lane, r32, hi);
    else attn_tail_half<8, false>(o, X, lam, subg, Ob + (size_t)16 * D, lane, r32, hi);
}
}
__device__ __forceinline__ void phase_attn_flash(const Args& a, const Bufs& B, LAS unsigned char* lds, bf16_t* YOUT, int xmap) {
    const int lane = threadIdx.x & 63;
    const float lam = expf(wave_sum(a.in[10][lane] * a.in[11][lane])) - expf(wave_sum(a.in[12][lane] * a.in[13][lane])) + LAM_INIT;
    const int G = gridDim.x, bx = blockIdx.x;
    if (G == 256) {
        const int x = xmap & 7, j32 = xmap >> 3, half = j32 >> 4, j = j32 & 15;
        { const int bh0 = x * 16 + half; att::attn_open(bh0 >> 3, bh0 & 7, j, B.Q, B.K, B.V, lds); }
        for (int i = 0; i < 8; ++i) { const int bh = x * 16 + 2 * i + half, qb = (i & 1) ? (15 - j) : j, bhn = bh + 2, qbn = (i & 1) ? j : (15 - j);
            att::attn_unit(bh >> 3, bh & 7, qb, B.Q, B.K, B.V, YOUT, lds, lam, a.in[14], i < 7, bhn >> 3, bhn & 7, qbn); }
    } else {
        for (int u = bx; u < BATCH * 8 * 16; u += G) { att::attn_open(u >> 7, (u >> 4) & 7, u & 15, B.Q, B.K, B.V, lds); att::attn_unit(u >> 7, (u >> 4) & 7, u & 15, B.Q, B.K, B.V, YOUT, lds, lam, a.in[14], false, 0, 0, 0); }
    }
}


namespace rnn {
constexpr int XR_STRIDE = 68, TILE_BYTES = 32 * XR_STRIDE * 4 + 32 * 64 * 4  , LDS_TOT = 8 * TILE_BYTES  , LDS_CIN = LDS_TOT + 8192;
struct Consts { bf16x8 bfr[2][2][4]; float ba[2], bx[2], c8sp[2]; };
__device__ __forceinline__ void rnn_setup(const Args& a, int blk, Consts& C) {
    const int lane = threadIdx.x & 63, r32 = lane & 31, hi = lane >> 5, c0 = blk * 64;
#pragma unroll
    for (int g = 0; g < 2; ++g) { const float* W = a.in[g == 0 ? 5 : 7] + (size_t)blk * 4096;
#pragma unroll
        for (int nt = 0; nt < 2; ++nt)
#pragma unroll
            for (int ks = 0; ks < 4; ++ks) { const float* wp = W + (16 * ks + 8 * hi) * 64 + 32 * nt + r32; u32x4 pk;
                pk.x = pk2(-LOG2E * wp[0], -LOG2E * wp[64]); pk.y = pk2(-LOG2E * wp[128], -LOG2E * wp[192]); pk.z = pk2(-LOG2E * wp[256], -LOG2E * wp[320]); pk.w = pk2(-LOG2E * wp[384], -LOG2E * wp[448]);
                C.bfr[g][nt][ks] = __builtin_bit_cast(bf16x8, pk); } }
#pragma unroll
    for (int nt = 0; nt < 2; ++nt) { const int j = c0 + 32 * nt + r32; C.ba[nt] = -LOG2E * a.in[6][j]; C.bx[nt] = -LOG2E * a.in[8][j]; C.c8sp[nt] = 8.0f * log1pf(expf(-a.in[9][j])) * LOG2E; }
}
__device__ __forceinline__ void rnn_item(const Args& a, const Bufs& B, LAS unsigned char* lds, int b, int blk, bf16_t* YOUT, const Consts& C) {
    const int tid = threadIdx.x, lane = tid & 63, r32 = lane & 31, hi = lane >> 5, cg = lane & 7, tr = lane >> 3;
    const int w = __builtin_amdgcn_readfirstlane(tid >> 6), c0 = blk * 64;
    LAS float* XR = (LAS float*)(lds + w * TILE_BYTES);
    LAS float* AT = XR + 32 * XR_STRIDE;
    LAS float* TOT = (LAS float*)(lds + LDS_TOT);
    LAS float* CIN = (LAS float*)(lds + LDS_CIN) + w * 64;
    float carry = 0.f;
    const size_t rowb = (size_t)b * SEQ;
    u32x4 v[7];
#pragma unroll
    for (int k = 0; k < 7; ++k) { const int t = 32 * w + 4 * tr - 3 + k; v[k] = (u32x4){0u, 0u, 0u, 0u}; if (t >= 0) v[k] = *(const u32x4*)(B.UX + (rowb + t) * D + c0 + 8 * cg); }
    for (int it = 0; it < 8; ++it) {
        const int T0 = it * 256 + 32 * w;
        {
            const float* cwp = a.in[3]; const float* cbp = a.in[4];
            asm volatile("" : "+s"(cwp), "+s"(cbp));
            f32x4 w4[4][2], b4[2];
#pragma unroll
            for (int j = 0; j < 4; ++j) { w4[j][0] = *(const f32x4*)(cwp + j * D + c0 + 8 * cg); w4[j][1] = *(const f32x4*)(cwp + j * D + c0 + 8 * cg + 4); }
            b4[0] = *(const f32x4*)(cbp + c0 + 8 * cg); b4[1] = *(const f32x4*)(cbp + c0 + 8 * cg + 4);
#pragma unroll
            for (int i = 0; i < 4; ++i) { f32x4 xo[2] = {b4[0], b4[1]};
#pragma unroll
                for (int j = 0; j < 4; ++j) { const u32x4 q = v[i + j];
                    xo[0].x += w4[j][0].x * bf2f(q.x & 0xffffu); xo[0].y += w4[j][0].y * bf2f(q.x >> 16); xo[0].z += w4[j][0].z * bf2f(q.y & 0xffffu); xo[0].w += w4[j][0].w * bf2f(q.y >> 16);
                    xo[1].x += w4[j][1].x * bf2f(q.z & 0xffffu); xo[1].y += w4[j][1].y * bf2f(q.z >> 16); xo[1].z += w4[j][1].z * bf2f(q.w & 0xffffu); xo[1].w += w4[j][1].w * bf2f(q.w >> 16); }
                LAS f32x4* xp = (LAS f32x4*)(XR + (4 * tr + i) * XR_STRIDE + 8 * cg); xp[0] = xo[0]; xp[1] = xo[1]; }
        }
        if (it < 7) {
#pragma unroll
            for (int k = 0; k < 7; ++k) v[k] = *(const u32x4*)(B.UX + (rowb + T0 + 256 + 4 * tr - 3 + k) * D + c0 + 8 * cg);
        }
        LDS_WAIT();
        f32x16 acc[2][2];
#pragma unroll
        for (int g = 0; g < 2; ++g)
#pragma unroll
            for (int nt = 0; nt < 2; ++nt)
#pragma unroll
                for (int r = 0; r < 16; ++r) acc[g][nt][r] = 0.f;
#pragma unroll
        for (int ks = 0; ks < 4; ++ks) { const LAS f32x4* ap = (const LAS f32x4*)(XR + r32 * XR_STRIDE + 16 * ks + 8 * hi); const f32x4 x0 = ap[0], x1 = ap[1];
            u32x4 pk; pk.x = att::cvtpk(x0.x, x0.y); pk.y = att::cvtpk(x0.z, x0.w); pk.z = att::cvtpk(x1.x, x1.y); pk.w = att::cvtpk(x1.z, x1.w);
            const bf16x8 af = __builtin_bit_cast(bf16x8, pk);
#pragma unroll
            for (int g = 0; g < 2; ++g)
#pragma unroll
                for (int nt = 0; nt < 2; ++nt) acc[g][nt] = __builtin_amdgcn_mfma_f32_32x32x16_bf16(af, C.bfr[g][nt][ks], acc[g][nt], 0, 0, 0); }
#pragma unroll
        for (int nt = 0; nt < 2; ++nt)
#pragma unroll
            for (int r = 0; r < 16; ++r) { const int t = att::crow(r, hi), j = 32 * nt + r32;
                const float rg = __builtin_amdgcn_rcpf(1.0f + fexp2(acc[0][nt][r] + C.ba[nt])), ig = __builtin_amdgcn_rcpf(1.0f + fexp2(acc[1][nt][r] + C.bx[nt]));
                const float av = fexp2(-C.c8sp[nt] * rg);
                const float om = __builtin_fmaf(-av, av, 1.0f);
                const float xr = XR[t * XR_STRIDE + j];
                XR[t * XR_STRIDE + j] = __builtin_amdgcn_sqrtf(om) * ig * xr; AT[t * 64 + j] = av; }
        LDS_WAIT();
        u32x4 gv[4];
#pragma unroll
        for (int i = 0; i < 4; ++i) gv[i] = *(const u32x4*)(B.GG + (rowb + T0 + 4 * tr + i) * D + c0 + 8 * cg);
        { float h = 0.f, pc = 1.f;
#pragma unroll
            for (int tb = 0; tb < 32; tb += 8) { float av[8], uv[8];
#pragma unroll
                for (int t = 0; t < 8; ++t) { av[t] = AT[(tb + t) * 64 + lane]; uv[t] = XR[(tb + t) * XR_STRIDE + lane]; }
#pragma unroll
                for (int t = 0; t < 8; ++t) { h = av[t] * h + uv[t]; pc *= av[t]; uv[t] = h; av[t] = pc; }
#pragma unroll
                for (int t = 0; t < 8; ++t) { XR[(tb + t) * XR_STRIDE + lane] = uv[t]; AT[(tb + t) * 64 + lane] = av[t]; } }
            LAS float* tp = TOT + ((it & 1) * 8 + w) * 128; tp[lane] = pc; tp[64 + lane] = h; }
        __syncthreads();
        { float c = carry, cin = 0.f;
#pragma unroll
            for (int ww = 0; ww < 8; ++ww) { const LAS float* tp = TOT + ((it & 1) * 8 + ww) * 128; if (ww == w) cin = c; c = tp[lane] * c + tp[64 + lane]; }
            carry = c; CIN[lane] = cin; }
        LDS_WAIT();
        { const LAS f32x4* cp = (const LAS f32x4*)(CIN + 8 * cg); const f32x4 c0v = cp[0], c1v = cp[1];
#pragma unroll
            for (int i = 0; i < 4; ++i) { const int row = 4 * tr + i;
                const LAS f32x4* hp = (const LAS f32x4*)(XR + row * XR_STRIDE + 8 * cg); const LAS f32x4* pp = (const LAS f32x4*)(AT + row * 64 + 8 * cg);
                const f32x4 h0 = hp[0], h1 = hp[1], p0 = pp[0], p1 = pp[1];
                const size_t go = (rowb + T0 + row) * D + c0 + 8 * cg; const u32x4 g4 = gv[i];
                u32x4 o;
                o.x = pk2((h0.x + p0.x * c0v.x) * bf2f(g4.x & 0xffffu), (h0.y + p0.y * c0v.y) * bf2f(g4.x >> 16));
                o.y = pk2((h0.z + p0.z * c0v.z) * bf2f(g4.y & 0xffffu), (h0.w + p0.w * c0v.w) * bf2f(g4.y >> 16));
                o.z = pk2((h1.x + p1.x * c1v.x) * bf2f(g4.z & 0xffffu), (h1.y + p1.y * c1v.y) * bf2f(g4.z >> 16));
                o.w = pk2((h1.z + p1.z * c1v.z) * bf2f(g4.w & 0xffffu), (h1.w + p1.w * c1v.w) * bf2f(g4.w >> 16));
                *(u32x4*)(YOUT + go) = o; }
        }
        LDS_WAIT();
    }
}
}
__device__ __forceinline__ int rnn_batch(int xmap) { return 2 * (xmap & 7) + (xmap >> 7); }
__device__ __forceinline__ int rnn_blk(int xmap) { return (xmap >> 3) & 15; }

__device__ __forceinline__ void unpack8(const u32x4& w, f32x4& a, f32x4& b) {
    a = (f32x4){bf2f(w.x & 0xffffu), bf2f(w.x >> 16), bf2f(w.y & 0xffffu), bf2f(w.y >> 16)}; b = (f32x4){bf2f(w.z & 0xffffu), bf2f(w.z >> 16), bf2f(w.w & 0xffffu), bf2f(w.w >> 16)}; }
__device__ __forceinline__ u32x4 pack8(const f32x4& a, const f32x4& b) { u32x4 w; w.x = att::cvtpk(a.x, a.y); w.y = att::cvtpk(a.z, a.w); w.z = att::cvtpk(b.x, b.y); w.w = att::cvtpk(b.z, b.w); return w; }
__device__ __forceinline__ f32x4 unpack_u8(unsigned w) { return (f32x4){(float)(w & 0xffu), (float)((w >> 8) & 0xffu), (float)((w >> 16) & 0xffu), (float)(w >> 24)} * (1.0f / 255.0f); }
__device__ __forceinline__ float gelu_fast(float v) { constexpr float C0 = -2.0f * LOG2E * 0.7978845608028654f, C1 = C0 * 0.044715f; return v * __builtin_amdgcn_rcpf(1.0f + fexp2(v * __builtin_fmaf(v * v, C1, C0))); }
__device__ __forceinline__ float sig255_pre(float acc) { return __builtin_amdgcn_rcpf(__builtin_fmaf(fexp2(acc), 1.0f / 255.0f, 1.0f / 255.0f)); }
__device__ __forceinline__ unsigned pack_sig_u8(const f32x4& g) {
    unsigned w = __builtin_amdgcn_cvt_pk_u8_f32(sig255_pre(g.x), 0u, 0u); w = __builtin_amdgcn_cvt_pk_u8_f32(sig255_pre(g.y), 1u, w); w = __builtin_amdgcn_cvt_pk_u8_f32(sig255_pre(g.z), 2u, w); return __builtin_amdgcn_cvt_pk_u8_f32(sig255_pre(g.w), 3u, w); }
__device__ __forceinline__ f32x4 map_gelu(const f32x4& v) { return (f32x4){gelu_fast(v.x), gelu_fast(v.y), gelu_fast(v.z), gelu_fast(v.w)}; }

__device__ __forceinline__ unsigned dpp_hi(unsigned keep, unsigned src) { return (unsigned)__builtin_amdgcn_update_dpp((int)keep, (int)src, 0x128, 0xF, 0xC, false); }
__device__ __forceinline__ unsigned dpp_lo(unsigned keep, unsigned src) { return (unsigned)__builtin_amdgcn_update_dpp((int)keep, (int)src, 0x128, 0xF, 0x3, false); }
__device__ __forceinline__ void xrow8(u32x4& p0, u32x4& p1) {
    u32x4 a, b;
    a.x = dpp_hi(p0.x, p1.x); a.y = dpp_hi(p0.y, p1.y); a.z = dpp_hi(p0.z, p1.z); a.w = dpp_hi(p0.w, p1.w);
    b.x = dpp_lo(p1.x, p0.x); b.y = dpp_lo(p1.y, p0.y); b.z = dpp_lo(p1.z, p0.z); b.w = dpp_lo(p1.w, p0.w);
    p0 = a; p1 = b;
}
__device__ __forceinline__ void xrow8f(f32x4& a0, f32x4& a1, f32x4& b0, f32x4& b1) {
    u32x4 p = __builtin_bit_cast(u32x4, a0), q = __builtin_bit_cast(u32x4, b0); xrow8(p, q); a0 = __builtin_bit_cast(f32x4, p); b0 = __builtin_bit_cast(f32x4, q);
    p = __builtin_bit_cast(u32x4, a1); q = __builtin_bit_cast(u32x4, b1); xrow8(p, q); a1 = __builtin_bit_cast(f32x4, p); b1 = __builtin_bit_cast(f32x4, q);
}
struct EpiInProj {
    static constexpr bool PERM = true, AFTER_DRAIN = false; Bufs B;
    __device__ __forceinline__ void operator()(const pg8::f32x4 (&acc)[2][2][4][2], const pg8::Unit& u, int wr, int wc, int fr, int fq) const {
        const int seg = u.pn >> 2, tp = u.pn & 3, row0 = u.pm * 256 + wr * 64 + fr;
        const int rowx = u.pm * 256 + wr * 64 + (fr & 7), pc8 = 8 * (4 * (fr >> 3) + fq);
        if (seg == 2 || seg == 3) {
            const float sc = (seg == 2) ? QSCALE : 1.0f;
            const bool hm = (seg == 3);
#pragma unroll
            for (int ai = 0; ai < 2; ++ai)
#pragma unroll
                for (int m = 0; m < 4; ++m) { const int row = row0 + ai * 128 + m * 16, pos = row & (SEQ - 1), rx = rowx + ai * 128 + m * 16;
                    const f32x4* cp = (const f32x4*)(B.ropec + pos * 32 + 8 * fq); const f32x4* sp = (const f32x4*)(B.ropes + pos * 32 + 8 * fq);
                    const f32x4 c0 = cp[0], c1 = cp[1], s0 = sp[0], s1 = sp[1];
                    const f32x4 a0 = acc[ai][0][m][0], a1 = acc[ai][0][m][1], b0 = acc[ai][1][m][0], b1 = acc[ai][1][m][1];
                    const f32x4 o0 = (a0 * c0 - b0 * s0) * sc, o1 = (a1 * c1 - b1 * s1) * sc, p0 = (b0 * c0 + a0 * s0) * sc, p1 = (b1 * c1 + a1 * s1) * sc;
                    u32x4 w0 = pack8(o0, o1), w1 = pack8(p0, p1); xrow8(w0, w1);
                    bf16_t* rp = hm ? B.K + ((size_t)((rx >> 11) * 8 + 2 * tp + (wc >> 1)) * SEQ + (rx & (SEQ - 1))) * 128 + (wc & 1) * 64 + pc8 : B.Q + (size_t)rx * D + (4 * tp + wc) * 64 + pc8;
                    *(u32x4*)rp = w0; *(u32x4*)(rp + (hm ? 8 * 128 : 8 * D)) = w1; }
        } else if (seg >= 5) {
            unsigned char* gb = ((seg == 5) ? B.SR : B.SA) + tp * 256 + wc * 64 + 16 * fq;
#pragma unroll
            for (int ai = 0; ai < 2; ++ai)
#pragma unroll
                for (int m = 0; m < 4; ++m) { unsigned char* rp = gb + (size_t)(row0 + ai * 128 + m * 16) * D;
                    *(u32x4*)rp = (u32x4){pack_sig_u8(acc[ai][0][m][0]), pack_sig_u8(acc[ai][0][m][1]), pack_sig_u8(acc[ai][1][m][0]), pack_sig_u8(acc[ai][1][m][1])}; }
        } else if (seg == 4) {
#pragma unroll
            for (int ai = 0; ai < 2; ++ai)
#pragma unroll
                for (int m = 0; m < 4; ++m) { const int rx = rowx + ai * 128 + m * 16;
                    u32x4 w0 = pack8(acc[ai][0][m][0], acc[ai][0][m][1]), w1 = pack8(acc[ai][1][m][0], acc[ai][1][m][1]); xrow8(w0, w1);
                    bf16_t* rp = B.V + ((size_t)((rx >> 11) * 8 + 2 * tp + (wc >> 1)) * SEQ + (rx & (SEQ - 1))) * 128 + (wc & 1) * 64 + pc8;
                    *(u32x4*)rp = w0; *(u32x4*)(rp + 8 * 128) = w1; }
        } else {
            bf16_t* base = ((seg == 0) ? B.UX : B.GG) + tp * 256 + wc * 64 + pc8;
#pragma unroll
            for (int ai = 0; ai < 2; ++ai)
#pragma unroll
                for (int m = 0; m < 4; ++m) { bf16_t* rp = base + (size_t)(rowx + ai * 128 + m * 16) * D;
                    f32x4 a0 = acc[ai][0][m][0], a1 = acc[ai][0][m][1], b0 = acc[ai][1][m][0], b1 = acc[ai][1][m][1];
                    if (seg == 1) { a0 = map_gelu(a0); a1 = map_gelu(a1); b0 = map_gelu(b0); b1 = map_gelu(b1); }
                    u32x4 w0 = pack8(a0, a1), w1 = pack8(b0, b1); xrow8(w0, w1);
                    *(u32x4*)rp = w0; *(u32x4*)(rp + 8 * D) = w1; }
        }
    }
};
struct EpiBrA {
    static constexpr bool PERM = true, AFTER_DRAIN = false; Bufs B;
    __device__ __forceinline__ void operator()(const pg8::f32x4 (&acc)[2][2][4][2], const pg8::Unit& u, int wr, int wc, int fr, int fq) const {
        const int rowx = u.pm * 256 + wr * 64 + (fr & 7), col0 = u.pn * 256 + wc * 64 + 8 * (4 * (fr >> 3) + fq);
#pragma unroll
        for (int ai = 0; ai < 2; ++ai)
#pragma unroll
            for (int m = 0; m < 4; ++m) { const size_t o = (size_t)(rowx + ai * 128 + m * 16) * D + col0;
                const u32x2 ga = *(const u32x2*)(B.SR + o), gb = *(const u32x2*)(B.SR + o + 8 * D);
                f32x4 a0 = acc[ai][0][m][0], a1 = acc[ai][0][m][1], b0 = acc[ai][1][m][0], b1 = acc[ai][1][m][1]; xrow8f(a0, a1, b0, b1);
                *(u32x4*)(B.T + o) = pack8(unpack_u8(ga.x) * a0, unpack_u8(ga.y) * a1); *(u32x4*)(B.T + o + 8 * D) = pack8(unpack_u8(gb.x) * b0, unpack_u8(gb.y) * b1); }
    }
};
struct EpiBrB {
    static constexpr bool PERM = true, AFTER_DRAIN = false; Bufs B;
    __device__ __forceinline__ void operator()(const pg8::f32x4 (&acc)[2][2][4][2], const pg8::Unit& u, int wr, int wc, int fr, int fq) const {
        const int rowx = u.pm * 256 + wr * 64 + (fr & 7), col0 = u.pn * 256 + wc * 64 + 8 * (4 * (fr >> 3) + fq);
#pragma unroll
        for (int ai = 0; ai < 2; ++ai)
#pragma unroll
            for (int m = 0; m < 4; ++m) { const size_t o = (size_t)(rowx + ai * 128 + m * 16) * D + col0;
                const u32x2 ga = *(const u32x2*)(B.SA + o), gb = *(const u32x2*)(B.SA + o + 8 * D); const u32x4 ta = *(const u32x4*)(B.T + o), tb = *(const u32x4*)(B.T + o + 8 * D);
                f32x4 a0 = acc[ai][0][m][0], a1 = acc[ai][0][m][1], b0 = acc[ai][1][m][0], b1 = acc[ai][1][m][1]; xrow8f(a0, a1, b0, b1);
                f32x4 t0, t1; unpack8(ta, t0, t1); *(u32x4*)(B.MG + o) = pack8(t0 + unpack_u8(ga.x) * a0, t1 + unpack_u8(ga.y) * a1);
                unpack8(tb, t0, t1); *(u32x4*)(B.MG + o + 8 * D) = pack8(t0 + unpack_u8(gb.x) * b0, t1 + unpack_u8(gb.y) * b1); }
    }
};
struct EpiOut {
    static constexpr bool PERM = true, AFTER_DRAIN = false; Bufs B;
    __device__ __forceinline__ void operator()(const pg8::f32x4 (&acc)[2][2][4][2], const pg8::Unit& u, int wr, int wc, int fr, int fq) const {
        const int rowx = u.pm * 256 + wr * 64 + (fr & 7), col0 = u.pn * 256 + wc * 64 + 8 * (4 * (fr >> 3) + fq);
#pragma unroll
        for (int ai = 0; ai < 2; ++ai)
#pragma unroll
            for (int m = 0; m < 4; ++m) { const int row = rowx + ai * 128 + m * 16; const size_t o = (size_t)row * D + col0;
                const f32x4 xa0 = *(const f32x4*)(B.x + o), xa1 = *(const f32x4*)(B.x + o + 4), xb0 = *(const f32x4*)(B.x + o + 8 * D), xb1 = *(const f32x4*)(B.x + o + 8 * D + 4);
                f32x4 a0 = acc[ai][0][m][0], a1 = acc[ai][0][m][1], b0 = acc[ai][1][m][0], b1 = acc[ai][1][m][1]; xrow8f(a0, a1, b0, b1);
                a0 += xa0; a1 += xa1; b0 += xb0; b1 += xb1;
                *(u32x4*)(B.X1B + o) = pack8(a0, a1); *(u32x4*)(B.X1B + o + 8 * D) = pack8(b0, b1);
                float sa = ((a0.x * a0.x + a0.y * a0.y) + (a0.z * a0.z + a0.w * a0.w)) + ((a1.x * a1.x + a1.y * a1.y) + (a1.z * a1.z + a1.w * a1.w));
                float sb = ((b0.x * b0.x + b0.y * b0.y) + (b0.z * b0.z + b0.w * b0.w)) + ((b1.x * b1.x + b1.y * b1.y) + (b1.z * b1.z + b1.w * b1.w));
                sa += __shfl_xor(sa, 8); sb += __shfl_xor(sb, 8); sa += __shfl_xor(sa, 16); sb += __shfl_xor(sb, 16); sa += __shfl_xor(sa, 32); sb += __shfl_xor(sb, 32);
                if (fq == 0) atomicAdd(B.ss1 + row + (fr & 8), (fr & 8) ? sb : sa); }
    }
};
struct EpiMlp1 {
    static constexpr bool PERM = true, AFTER_DRAIN = false; Bufs B;
    __device__ __forceinline__ void operator()(const pg8::f32x4 (&acc)[2][2][4][2], const pg8::Unit& u, int wr, int wc, int fr, int fq) const {
        const int row0 = u.pm * 256 + wr * 64 + (fr & 7), col0 = u.pn * 256 + wc * 64 + 8 * (4 * (fr >> 3) + fq);
        const f32x4 z4 = {0.f, 0.f, 0.f, 0.f};
#pragma unroll
        for (int ai = 0; ai < 2; ++ai)
#pragma unroll
            for (int m = 0; m < 4; ++m) { bf16_t* rp = B.HID + (size_t)(row0 + ai * 128 + m * 16) * DFF + col0;
                const f32x4 a0 = __builtin_elementwise_max(acc[ai][0][m][0], z4), a1 = __builtin_elementwise_max(acc[ai][0][m][1], z4), b0 = __builtin_elementwise_max(acc[ai][1][m][0], z4), b1 = __builtin_elementwise_max(acc[ai][1][m][1], z4);
                u32x4 p0 = pack8(a0 * a0, a1 * a1), p1 = pack8(b0 * b0, b1 * b1); xrow8(p0, p1);
                *(u32x4*)rp = p0; *(u32x4*)(rp + 8 * DFF) = p1; }
    }
};
struct EpiMlp2 {
    static constexpr bool PERM = true, AFTER_DRAIN = false; Bufs B; const float* gfin; unsigned* tmo;
    __device__ __forceinline__ void operator()(pg8::f32x4 (&acc)[2][2][4][2], const pg8::Unit& u, int wr, int wc, int fr, int fq) const {
        const int rowx = u.pm * 256 + wr * 64 + (fr & 7), col0 = u.pn * 256 + wc * 64 + 8 * (4 * (fr >> 3) + fq);
#pragma unroll
        for (int ai = 0; ai < 2; ++ai)
#pragma unroll
            for (int m = 0; m < 4; ++m) { const int row = rowx + ai * 128 + m * 16; const size_t o = (size_t)row * D + col0;
                const float ra = __builtin_amdgcn_rcpf(__hip_atomic_load(B.ss1 + row, __ATOMIC_RELAXED, __HIP_MEMORY_SCOPE_AGENT) * (1.0f / D) + NORM_EPS);
                const float rb = __builtin_amdgcn_rcpf(__hip_atomic_load(B.ss1 + row + 8, __ATOMIC_RELAXED, __HIP_MEMORY_SCOPE_AGENT) * (1.0f / D) + NORM_EPS);
                const u32x4 xa = *(const u32x4*)(B.X1B + o), xb = *(const u32x4*)(B.X1B + o + 8 * D);
                f32x4 &a0 = acc[ai][0][m][0], &a1 = acc[ai][0][m][1], &b0 = acc[ai][1][m][0], &b1 = acc[ai][1][m][1]; xrow8f(a0, a1, b0, b1);
                f32x4 x0, x1; unpack8(xa, x0, x1); a0 = x0 + a0 * ra; a1 = x1 + a1 * ra; unpack8(xb, x0, x1); b0 = x0 + b0 * rb; b1 = x1 + b1 * rb;
                float sa = ((a0.x * a0.x + a0.y * a0.y) + (a0.z * a0.z + a0.w * a0.w)) + ((a1.x * a1.x + a1.y * a1.y) + (a1.z * a1.z + a1.w * a1.w));
                float sb = ((b0.x * b0.x + b0.y * b0.y) + (b0.z * b0.z + b0.w * b0.w)) + ((b1.x * b1.x + b1.y * b1.y) + (b1.z * b1.z + b1.w * b1.w));
                sa += __shfl_xor(sa, 8); sb += __shfl_xor(sb, 8); sa += __shfl_xor(sa, 16); sb += __shfl_xor(sb, 16); sa += __shfl_xor(sa, 32); sb += __shfl_xor(sb, 32);
                if (fq == 0) atomicAdd(B.ss2 + row + (fr & 8), (fr & 8) ? sb : sa); }
        asm volatile("s_waitcnt vmcnt(0)" ::: "memory");
        __syncthreads();
        if (threadIdx.x == 0) { unsigned* c = B.pcnt + u.pm * 16;
            (void)__hip_atomic_fetch_add(c, 1u, __ATOMIC_RELAXED, __HIP_MEMORY_SCOPE_AGENT);
            unsigned sp = 0;
            while (__hip_atomic_load(c, __ATOMIC_RELAXED, __HIP_MEMORY_SCOPE_AGENT) < 4u) { __builtin_amdgcn_s_sleep(1);
                if ((++sp & 255u) == 0u) { if (__hip_atomic_load(tmo, __ATOMIC_RELAXED, __HIP_MEMORY_SCOPE_AGENT)) break; if (sp > (1u << 18)) { atomicAdd(tmo, 1u); break; } } } }
        __syncthreads();
        const f32x4 g0 = *(const f32x4*)(gfin + col0), g1 = *(const f32x4*)(gfin + col0 + 4);
#pragma unroll
        for (int ai = 0; ai < 2; ++ai)
#pragma unroll
            for (int m = 0; m < 4; ++m) { const int row = rowx + ai * 128 + m * 16; const size_t o = (size_t)row * D + col0;
                const float qa = __builtin_amdgcn_rsqf(__hip_atomic_load(B.ss2 + row, __ATOMIC_RELAXED, __HIP_MEMORY_SCOPE_AGENT) * (1.0f / D) + NORM_EPS);
                const float qb = __builtin_amdgcn_rsqf(__hip_atomic_load(B.ss2 + row + 8, __ATOMIC_RELAXED, __HIP_MEMORY_SCOPE_AGENT) * (1.0f / D) + NORM_EPS);
                *(f32x4*)(B.out + o) = acc[ai][0][m][0] * qa * g0; *(f32x4*)(B.out + o + 4) = acc[ai][0][m][1] * qa * g1;
                *(f32x4*)(B.out + o + 8 * D) = acc[ai][1][m][0] * qb * g0; *(f32x4*)(B.out + o + 8 * D + 4) = acc[ai][1][m][1] * qb * g1; }
    }
};
struct ReverseOrder {
    pg8::StaticOrder S; int nM;
    __device__ __forceinline__ bool next(int i, pg8::Unit& u) const { if (!S.next(i, u)) return false; u.pm ^= 15; return true; }
    __device__ __forceinline__ void a_ready(const pg8::Unit&) const {}
    __device__ __forceinline__ void done(const pg8::Unit&) const {}
};
template <class Epi> __device__ __forceinline__ void gemm_run_rev(LAS unsigned char* lds, const bf16_t* A, const bf16_t* Bt, int Mr, int N, int K, const Epi& E, int cu) {
    pg8::Gemm g{A, Bt, Mr, N, K}; ReverseOrder S; S.S.init(Mr, N, (int)gridDim.x, cu); S.nM = Mr / 256;
    pg8::gemm_phase<Epi, ReverseOrder, true, true>(lds, g, S, E);
}
template <class Epi> __device__ __forceinline__ void gemm_run(LAS unsigned char* lds, const bf16_t* A, const bf16_t* Bt, int Mr, int N, int K, const Epi& E, int cu) {
    pg8::Gemm g{A, Bt, Mr, N, K}; pg8::StaticOrder S; S.init(Mr, N, (int)gridDim.x, cu);
    pg8::gemm_phase<Epi, pg8::StaticOrder, true, true>(lds, g, S, E);
}

#define RLX_AGENT __ATOMIC_RELAXED, __HIP_MEMORY_SCOPE_AGENT
#define XB_TMO      128
#define XB_XCNT(j)  (256  + 64 * (j))
#define XB_XSUB(j)  (1280 + 64 * (j))
#define XB_XGEN(j)  (2304 + 64 * (j))
#define XB_TOP      3328
#define XB_TOPGEN   3392
#define XB_EVT      3456
#define XCD_BAR_WORDS 3456
#define XB_SPIN_CAP (1u << 18)

__device__ __forceinline__ unsigned xb_ld(unsigned* p)              { return __hip_atomic_load(p, __ATOMIC_RELAXED, __HIP_MEMORY_SCOPE_AGENT); }
__device__ __forceinline__ unsigned xb_add(unsigned* p, unsigned v) { return __hip_atomic_fetch_add(p, v, __ATOMIC_RELAXED, __HIP_MEMORY_SCOPE_AGENT); }
__device__ __forceinline__ unsigned xb_xcc_id() { return (unsigned)__builtin_amdgcn_s_getreg((3 << 11) | 20) & 0xFu; }
#define XB_SPIN(cond, bar) do { unsigned _sp = 0; while (cond) { __builtin_amdgcn_s_sleep(1); \
    if ((++_sp & 255u) == 0u) { if (xb_ld(&(bar)[XB_TMO])) break; if (_sp > XB_SPIN_CAP) { atomicAdd(&(bar)[XB_TMO], 1u); break; } } } } while (0)

struct XcdBarrier {
    unsigned* bar; unsigned x;
    volatile LAS unsigned* st;
};

__device__ __forceinline__ XcdBarrier xcd_barrier_post(unsigned* bar, volatile LAS unsigned* st) {
    XcdBarrier b; b.bar = bar; b.x = xb_xcc_id(); b.st = st;
    if (threadIdx.x == 0) (void)xb_add(&bar[XB_XCNT(b.x)], 1u);
    return b;
}
__device__ __forceinline__ void xcd_barrier_complete(unsigned* bar, unsigned x, unsigned& nloc, unsigned& nx) {
    const unsigned G = gridDim.x * gridDim.y * gridDim.z;
    unsigned sum, cnt, mine, sp = 0u;
    for (;;) {
        sum = 0u; cnt = 0u; mine = 0u;
#pragma unroll
        for (unsigned j = 0; j < 16; ++j) { const unsigned c = xb_ld(&bar[XB_XCNT(j)]); sum += c; cnt += (c > 0u) ? 1u : 0u; mine = (j == x) ? c : mine; }
        if (sum == G) break;
        __builtin_amdgcn_s_sleep(1);
        if ((++sp & 255u) == 0u) { if (xb_ld(&bar[XB_TMO])) break; if (sp > XB_SPIN_CAP) { atomicAdd(&bar[XB_TMO], 1u); break; } }
    }
    nloc = mine > 0u ? mine : 1u; nx = cnt > 0u ? cnt : 1u;
}

__device__ __forceinline__ void xcd_barrier(const XcdBarrier& b) {
    asm volatile("s_waitcnt vmcnt(0)" ::: "memory");
    __syncthreads();
    if (threadIdx.x == 0) {
        unsigned* bar = b.bar;
        __builtin_amdgcn_s_waitcnt(0);
        unsigned nloc = b.st[0], nx = b.st[1];
        if (nloc == 0u) { xcd_barrier_complete(bar, b.x, nloc, nx); b.st[0] = nloc; b.st[1] = nx; }
        const unsigned old = xb_add(&bar[XB_XSUB(b.x)], 1u);
        const unsigned gen = old / nloc;
        if (old + 1u == (gen + 1u) * nloc) {
            __builtin_amdgcn_fence(__ATOMIC_RELEASE, "agent");
            asm volatile("s_waitcnt vmcnt(0)" ::: "memory");
            const unsigned og = xb_add(&bar[XB_TOP], 1u);
            const unsigned tg = og / nx;
            if (og + 1u == (tg + 1u) * nx) xb_add(&bar[XB_TOPGEN], 1u);
            else XB_SPIN(xb_ld(&bar[XB_TOPGEN]) == tg, bar);
            __builtin_amdgcn_fence(__ATOMIC_ACQUIRE, "agent");
            xb_add(&bar[XB_XGEN(b.x)], 1u);
            asm volatile("s_waitcnt vmcnt(0)" ::: "memory");
        } else {
            XB_SPIN(xb_ld(&bar[XB_XGEN(b.x)]) == gen, bar);
            __builtin_amdgcn_fence(__ATOMIC_ACQUIRE, "agent");
            asm volatile("s_waitcnt vmcnt(0)" ::: "memory");
        }
    }
    __syncthreads();
}

__device__ __forceinline__ void xcd_barrier_local(const XcdBarrier& b, int mode) {
    asm volatile("s_waitcnt vmcnt(0)" ::: "memory");
    __syncthreads();
    if (threadIdx.x == 0) {
        unsigned* bar = b.bar;
        __builtin_amdgcn_s_waitcnt(0);
        unsigned nloc = b.st[0], nx = b.st[1];
        if (nloc == 0u) { xcd_barrier_complete(bar, b.x, nloc, nx); b.st[0] = nloc; b.st[1] = nx; }
        const unsigned old = xb_add(&bar[XB_XSUB(b.x)], 1u);
        const unsigned gen = old / nloc;
        if (old + 1u == (gen + 1u) * nloc) {
            if (mode == 2) XB_SPIN(xb_ld(&bar[XB_EVT]) < nx, bar);
            xb_add(&bar[XB_XGEN(b.x)], 1u);
            if (mode == 1) { __builtin_amdgcn_fence(__ATOMIC_RELEASE, "agent"); asm volatile("s_waitcnt vmcnt(0)" ::: "memory"); xb_add(&bar[XB_EVT], 1u); }
        } else XB_SPIN(xb_ld(&bar[XB_XGEN(b.x)]) == gen, bar);
        __builtin_amdgcn_fence(__ATOMIC_ACQUIRE, "agent");
        asm volatile("s_waitcnt vmcnt(0)" ::: "memory");
    }
    __syncthreads();
}

constexpr int LDS_BYTES = 155648;
constexpr int LDS_BARW = LDS_BYTES - 64;
constexpr int CW_BAR = 4096, CW_CEN = 8192;
constexpr int N_PHASES = 8;
__global__ void __launch_bounds__(NTHREADS, 2) fwd_kernel(Args a) {
    extern __shared__ __attribute__((aligned(16))) unsigned char lds_raw[];
    LAS unsigned char* lds = (LAS unsigned char*)lds_raw;
    const Bufs B = make_bufs(a);
    const int lo = a.ph_lo, hi = a.ph_hi;
    volatile LAS unsigned* barw = (volatile LAS unsigned*)(lds + LDS_BARW);
    if (threadIdx.x < 4) barw[threadIdx.x] = 0u;
    __syncthreads();
    XcdBarrier bar = xcd_barrier_post((unsigned*)(a.ws + WS_CTL) + CW_BAR, barw);
    unsigned* cen = (unsigned*)(a.ws + WS_CTL) + CW_CEN;
    int my_rank = 0; { unsigned r = 0; if (threadIdx.x == 0) r = atomicAdd(cen + 64 * bar.x, 1u); my_rank = (int)__builtin_amdgcn_readfirstlane(r); }
    if (threadIdx.x == 0) barw[2] = (unsigned)my_rank;
    __syncthreads();
    my_rank = (int)barw[2];
#define IN(k) (lo <= (k) && (k) < hi)
#define SEAM(k) do { if (IN(k) && IN((k) + 1)) xcd_barrier(bar); } while (0)
#define SEAM_X(k, mode) do { if (IN(k) && IN((k) + 1)) { if (xmode) xcd_barrier_local(bar, mode); else xcd_barrier(bar); } } while (0)
    if (IN(0)) { phase_prep(a, B, lds); } SEAM(0);
    int xmap = (int)(blockIdx.x & 7) | ((int)(blockIdx.x >> 3) << 3); bool xmode = false;
    if (hi - lo > 1) {
        int npop = 0, below = 0; bool ok = true;
        for (int q = 0; q < 16; ++q) { const unsigned c = __hip_atomic_load(cen + 64 * q, __ATOMIC_RELAXED, __HIP_MEMORY_SCOPE_AGENT); if (c) { ++npop; ok = ok && (c == 32u); if (q < (int)bar.x) ++below; } }
        if (ok && npop == 8 && gridDim.x == 256 && lo == 0 && hi == N_PHASES) { xmap = below | (my_rank << 3); xmode = true; }
    }
    const int cu = (gridDim.x == 256) ? xmap : (int)blockIdx.x;
    if (IN(1)) { EpiInProj E{B}; gemm_run(lds, B.H, B.Win, M, NIN, D, E, cu); }
    rnn::Consts rc; if (IN(2)) rnn::rnn_setup(a, rnn_blk(xmap), rc);
    SEAM_X(1, 0);
    if (IN(2)) { rnn::rnn_item(a, B, lds, rnn_batch(xmap), rnn_blk(xmap), B.GG, rc); __syncthreads();
        phase_attn_flash(a, B, lds, B.Q, xmap);
    } SEAM_X(2, 0);
    if (IN(3)) { EpiBrA E{B}; gemm_run(lds, B.GG, B.Wbr, M, D, D, E, cu); }
    if (IN(4)) { EpiBrB E{B}; gemm_run(lds, B.Q, B.Wba, M, D, D, E, cu); } SEAM_X(4, 1);
    if (IN(5)) { EpiOut E{B}; gemm_run(lds, B.MG, B.Wout, M, D, D, E, cu); } SEAM_X(5, 2);
    if (IN(6)) { EpiMlp1 E{B}; gemm_run(lds, B.X1B, B.W1, M, DFF, D, E, cu); } SEAM_X(6, 0);
    if (IN(7)) { EpiMlp2 E{B, a.in[21], (unsigned*)(a.ws + WS_CTL) + CW_BAR + XB_TMO}; gemm_run_rev(lds, B.HID, B.W2, M, D, DFF, E, cu); }
#undef SEAM_X
#undef IN
#undef SEAM
}

extern "C" void kernel_launch(void* const* d_in, const int* in_sizes, int n_in, void* d_out, int out_size, void* d_ws, size_t ws_size, hipStream_t stream) {
    static int grid = 0;
    if (grid == 0) {
        if (n_in != 22 || in_sizes[0] != M * D || out_size != M * D || ws_size < WS_END) { fprintf(stderr, "kernel_launch: unexpected shapes (n_in %d, in0 %d, out %d, ws %zu); nothing launched\n", n_in, n_in > 0 ? in_sizes[0] : -1, out_size, ws_size); grid = -1; return; }
        int dev = 0, cus = 0, per_cu = 0;
        if (hipGetDevice(&dev) != hipSuccess || hipDeviceGetAttribute(&cus, hipDeviceAttributeMultiprocessorCount, dev) != hipSuccess) { grid = -1; return; }
        if (hipFuncSetAttribute((const void*)fwd_kernel, hipFuncAttributeMaxDynamicSharedMemorySize, LDS_BYTES) != hipSuccess) { fprintf(stderr, "kernel_launch: hipFuncSetAttribute failed\n"); grid = -1; return; }
        if (hipOccupancyMaxActiveBlocksPerMultiprocessor(&per_cu, (const void*)fwd_kernel, NTHREADS, LDS_BYTES) != hipSuccess || per_cu < 1) { fprintf(stderr, "kernel_launch: occupancy query says %d blocks per CU\n", per_cu); (void)hipGetLastError(); per_cu = 1; }
        if (cus != 256) { fprintf(stderr, "kernel_launch: %d CUs; the static work orders (and the four-workgroup rendezvous of the last phase) are laid out for 256\n", cus); grid = -1; return; }
        grid = cus;
    }
    if (grid < 0) return;
    (void)hipMemsetAsync((char*)d_ws + WS_CTL, 0, CTL_ZERO_BYTES, stream);
    Args a{};
    for (int i = 0; i < 22; ++i) a.in[i] = (const float*)d_in[i];
    a.out = (float*)d_out; a.ws = (unsigned char*)d_ws;
#if MK_N_LAUNCHES == 1
    a.ph_lo = 0; a.ph_hi = N_PHASES;
    hipLaunchKernelGGL(fwd_kernel, dim3(grid), dim3(NTHREADS), LDS_BYTES, stream, a);
#else
    for (int p = 0; p < N_PHASES; ++p) { a.ph_lo = p; a.ph_hi = p + 1; hipLaunchKernelGGL(fwd_kernel, dim3(grid), dim3(NTHREADS), LDS_BYTES, stream, a); }
#endif
}
```
